# Optimizing an MI355X kernel written in HIP

```python
import math
import jax, jax.numpy as jnp
from jax import lax
import numpy as np

D_MODEL = 2048
BATCH = 4
SEQ = 4096
DEPTH = 1

CHUNK = 64
MIX_WIDTH = D_MODEL
ATTN_WIDTH = MIX_WIDTH // 2
GMLP_WIDTH = MIX_WIDTH - ATTN_WIDTH
DIFF_HEAD_DIM = 64
DIFF_HEADS = ATTN_WIDTH // (2 * DIFF_HEAD_DIM)
Q_BLOCK = 128
GMLP_BLOCK = 128
GMLP_GROUPS = 8
GMLP_GROUP_DIM = GMLP_WIDTH // GMLP_GROUPS
IN_WIDTH = 3 * ATTN_WIDTH + 2 * GMLP_WIDTH
D_FF = 4 * D_MODEL
N_MOD = 6
DEEPNORM_ALPHA = (2.0 * DEPTH) ** 0.25
DEEPNORM_BETA = (8.0 * DEPTH) ** -0.25
LN_EPS = 1e-5

kernel_name = "hybrid_diffattn_gmlp_deepnorm_adaln"


def _ln(x):
    xf = x.astype(jnp.float32)
    mu = jnp.mean(xf, axis=-1, keepdims=True)
    var = jnp.mean(jnp.square(xf - mu), axis=-1, keepdims=True)
    return (xf - mu) * lax.rsqrt(var + LN_EPS)


def _rms(x):
    xf = x.astype(jnp.float32)
    return xf * lax.rsqrt(jnp.mean(jnp.square(xf), axis=-1, keepdims=True) + LN_EPS)


def diff_attention(q, k, v, lam, subln_g, lambda_init):
    b, s, h, _, dh = q.shape
    nblk = s // Q_BLOCK
    scale = dh ** -0.5
    kf = k.astype(jnp.float32)
    vf = v.astype(jnp.float32)
    k_chunk = jnp.arange(s) // CHUNK
    qb = q.astype(jnp.float32).reshape(b, nblk, Q_BLOCK, h, 2, dh).transpose(1, 0, 2, 3, 4, 5)
    neg = jnp.finfo(jnp.float32).min

    def one_block(args):
        q_blk, i = args
        q_chunk = (i * Q_BLOCK + jnp.arange(Q_BLOCK)) // CHUNK
        mask = k_chunk[None, :] <= q_chunk[:, None]
        sc = jnp.einsum('bqhcd,bkhcd->bhcqk', q_blk, kf) * scale
        p = jax.nn.softmax(jnp.where(mask, sc, neg), axis=-1)
        w = p[:, :, 0] - lam * p[:, :, 1]
        return jnp.einsum('bhqk,bkhe->bqhe', w, vf)

    out = lax.map(one_block, (qb, jnp.arange(nblk)))
    out = out.transpose(1, 0, 2, 3, 4).reshape(b, s, h, 2 * dh)
    out = _rms(out) * subln_g * (1.0 - lambda_init)
    return out.reshape(b, s, h * 2 * dh)


def gmlp_spatial_gate(u, vg, ln_g, ln_b, ws, bs):
    b, s, g, dg = u.shape
    nb = s // GMLP_BLOCK
    vn = _ln(vg) * ln_g + ln_b
    vb = vn.reshape(b, nb, GMLP_BLOCK, g, dg)
    pos = jnp.arange(GMLP_BLOCK)
    mask = (pos[:, None] // CHUNK) >= (pos[None, :] // CHUNK)
    wm = jnp.where(mask[None], ws.astype(jnp.float32), 0.0)
    mixed = jnp.einsum('gts,bnsgd->bntgd', wm, vb) + bs.T.astype(jnp.float32)[None, None, :, :, None]
    return (u.astype(jnp.float32) * mixed.reshape(b, s, g, dg)).reshape(b, s, g * dg)


def setup_inputs(seed: int = 0) -> dict:
    key = jax.random.key(seed)
    ks = jax.random.split(key, 24)
    f32 = jnp.float32
    n = lambda k, shape, s: jax.random.normal(k, shape, f32) * s
    L = DEPTH
    return {
        "x": jax.random.normal(ks[0], (BATCH, SEQ, D_MODEL), f32),
        "c": jax.random.normal(ks[1], (BATCH, D_MODEL), f32),
        "w_ada": n(ks[2], (L, D_MODEL, N_MOD * D_MODEL), 0.1 * D_MODEL ** -0.5),
        "b_ada": n(ks[3], (L, N_MOD * D_MODEL), 0.01),
        "w_in": n(ks[4], (L, D_MODEL, IN_WIDTH), D_MODEL ** -0.5),
        "lambda_q1": n(ks[5], (L, DIFF_HEAD_DIM), 0.1),
        "lambda_k1": n(ks[6], (L, DIFF_HEAD_DIM), 0.1),
        "lambda_q2": n(ks[7], (L, DIFF_HEAD_DIM), 0.1),
        "lambda_k2": n(ks[8], (L, DIFF_HEAD_DIM), 0.1),
        "subln_g": 1.0 + n(ks[9], (L, 2 * DIFF_HEAD_DIM), 0.02),
        "gmlp_ln_g": 1.0 + n(ks[10], (L, GMLP_GROUPS, GMLP_GROUP_DIM), 0.02),
        "gmlp_ln_b": n(ks[11], (L, GMLP_GROUPS, GMLP_GROUP_DIM), 0.02),
        "gmlp_ws": n(ks[12], (L, GMLP_GROUPS, GMLP_BLOCK, GMLP_BLOCK), GMLP_BLOCK ** -0.5),
        "gmlp_bs": 1.0 + n(ks[13], (L, GMLP_GROUPS, GMLP_BLOCK), 0.02),
        "w_out": n(ks[14], (L, MIX_WIDTH, D_MODEL), DEEPNORM_BETA * MIX_WIDTH ** -0.5),
        "ln1_g": 1.0 + n(ks[15], (L, D_MODEL), 0.02),
        "ln1_b": n(ks[16], (L, D_MODEL), 0.02),
        "w_ff1": n(ks[17], (L, D_MODEL, D_FF), D_MODEL ** -0.5),
        "w_ff2": n(ks[18], (L, D_FF, D_MODEL), DEEPNORM_BETA * D_FF ** -0.5),
        "ln2_g": 1.0 + n(ks[19], (L, D_MODEL), 0.02),
        "ln2_b": n(ks[20], (L, D_MODEL), 0.02),
    }


def reference(x, c, w_ada, b_ada, w_in, lambda_q1, lambda_k1, lambda_q2, lambda_k2, subln_g,
              gmlp_ln_g, gmlp_ln_b, gmlp_ws, gmlp_bs, w_out, ln1_g, ln1_b, w_ff1, w_ff2, ln2_g, ln2_b):
    b, s, d = x.shape
    out_dtype = x.dtype
    h_stream = x.astype(jnp.float32)
    c_act = jax.nn.silu(c.astype(jnp.float32))
    for l in range(DEPTH):
        mod = (c_act @ w_ada[l] + b_ada[l]).reshape(b, N_MOD, d)
        sh1, sc1, g1, sh2, sc2, g2 = [mod[:, i][:, None, :] for i in range(N_MOD)]

        a_in = _ln(h_stream) * (1.0 + sc1) + sh1
        proj = a_in @ w_in[l]
        q, k, v, u, vg = jnp.split(proj, [ATTN_WIDTH, 2 * ATTN_WIDTH, 3 * ATTN_WIDTH,
                                          3 * ATTN_WIDTH + GMLP_WIDTH], axis=-1)
        q = q.reshape(b, s, DIFF_HEADS, 2, DIFF_HEAD_DIM)
        k = k.reshape(b, s, DIFF_HEADS, 2, DIFF_HEAD_DIM)
        v = v.reshape(b, s, DIFF_HEADS, 2 * DIFF_HEAD_DIM)
        lambda_init = 0.8 - 0.6 * math.exp(-0.3 * l)
        lam = (jnp.exp(jnp.sum(lambda_q1[l] * lambda_k1[l]))
               - jnp.exp(jnp.sum(lambda_q2[l] * lambda_k2[l])) + lambda_init)
        attn_out = diff_attention(q, k, v, lam, subln_g[l], lambda_init)

        u = jax.nn.gelu(u).reshape(b, s, GMLP_GROUPS, GMLP_GROUP_DIM)
        vg = jax.nn.gelu(vg).reshape(b, s, GMLP_GROUPS, GMLP_GROUP_DIM)
        gmlp_out = gmlp_spatial_gate(u, vg, gmlp_ln_g[l], gmlp_ln_b[l], gmlp_ws[l], gmlp_bs[l])

        mix = jnp.concatenate([attn_out, gmlp_out], axis=-1) @ w_out[l]
        h_stream = _ln(DEEPNORM_ALPHA * h_stream + (1.0 + g1) * mix) * ln1_g[l] + ln1_b[l]

        m_in = _ln(h_stream) * (1.0 + sc2) + sh2
        ff = jnp.square(jax.nn.relu(m_in @ w_ff1[l])) @ w_ff2[l]
        h_stream = _ln(DEEPNORM_ALPHA * h_stream + (1.0 + g2) * ff) * ln2_g[l] + ln2_b[l]
    return h_stream.astype(out_dtype)
```

```cpp
#include <hip/hip_runtime.h>
#include <hip/hip_bf16.h>
#include <cstdio>
#include <cstdint>
#include <cmath>
__device__ __forceinline__ int fresh_tid() { int t = threadIdx.x; asm volatile("" : "+v"(t)); return t; }
namespace pg8 {
#define PG8_LAS __attribute__((address_space(3)))
typedef unsigned short bf16_t;
typedef short bf16x8 __attribute__((ext_vector_type(8)));
typedef float f32x4 __attribute__((ext_vector_type(4)));
typedef unsigned u32x4 __attribute__((ext_vector_type(4)));
constexpr int BM = 256, BK = 64, HALF = 128, HTB = HALF * BK * 2  , STAGE_BYTES = 8 * HTB, NXCD = 8, WGM = 8;

__host__ __device__ __forceinline__ int lds_byte(int r, int c) { const int st = (r >> 4) * 2 + (c >> 5), rr = r & 15, cc = c & 31, ob = rr * 64 + cc * 2; return st * 1024 + (ob ^ (((ob >> 9) & 1) << 5)); }
__host__ __device__ __forceinline__ void stage_rc(int b, int& R, int& C) { const int st = b / 1024, sb = b % 1024, swz = sb ^ (((sb >> 9) & 1) << 5); R = (st >> 1) * 16 + swz / 64; C = (st & 1) * 32 + (swz % 64) / 2; }
__host__ __device__ __forceinline__ int perm32(int rho) { const int n = rho >> 4, i = rho & 15; return 8 * (i >> 2) + 4 * n + (i & 3); }

struct Unit { int pm, pn; };
struct Gemm { const bf16_t* A; const bf16_t* Bt; int M, N, K; };

struct StaticOrder {
    int nM, nN, nwg, G, c;
    __host__ __device__ void init(int M, int N, int G_, int c_) { nM = M / BM; nN = N / BM; nwg = nM * nN; G = G_; c = c_; }
    __host__ __device__ bool next(int i, Unit& u) const {
        const long L = (long)i * G + c; if (L >= nwg) return false;
        int wgid = (int)L; { const int q = nwg / NXCD, r = nwg % NXCD, xcd = wgid % NXCD, off = wgid / NXCD; wgid = (xcd < r ? xcd * (q + 1) : r * (q + 1) + (xcd - r) * q) + off; }
        const int nig = WGM * nN, gid = wgid / nig, fm = gid * WGM, gsz = (nM - fm) < WGM ? (nM - fm) : WGM;
        u.pm = fm + ((wgid % nig) % gsz); u.pn = (wgid % nig) / gsz; return true;
    }
    __device__ __forceinline__ void a_ready(const Unit&) const {}
    __device__ __forceinline__ void done(const Unit&) const {}
};


typedef float f32x2 __attribute__((ext_vector_type(2)));
typedef __bf16 bf16x2_t __attribute__((ext_vector_type(2)));
__device__ __forceinline__ unsigned cvt_pk_bf16(float lo, float hi) { f32x2 v = {lo, hi}; bf16x2_t b = __builtin_convertvector(v, bf16x2_t); return __builtin_bit_cast(unsigned, b); }
__device__ __forceinline__ float gelu_tanh(float x) {
    const float c1 = 2.0f * 0.7978845608028654f * 1.4426950408889634f, c2 = c1 * 0.044715f;
    const float z2 = x * (c1 + c2 * x * x);
    const float e = __builtin_amdgcn_exp2f(-z2);
    return x * __builtin_amdgcn_rcpf(1.0f + e);
}
constexpr float ATT_C2 = 0.125f * 1.4426950408889634f;

struct EpiProj {
    static constexpr bool PERM = true, AFTER_DRAIN = false;
    bf16_t* O; int ldc;
    __device__ __forceinline__ void operator()(const f32x4 (&acc)[2][2][4][2], const Unit& u, int wr, int wc, int fr, int fq) const {
        const int row0 = u.pm * BM + wr * 64 + fr, col0 = u.pn * BM + wc * 32 + 8 * fq;
        const int mode = u.pn < 4 ? 0 : (u.pn < 12 ? 1 : 2);
#pragma unroll
        for (int ai = 0; ai < 2; ++ai)
#pragma unroll
            for (int m = 0; m < 4; ++m) { bf16_t* rowp = O + (size_t)(row0 + ai * HALF + m * 16) * ldc + col0;
#pragma unroll
                for (int bj = 0; bj < 2; ++bj) { f32x4 v0 = acc[ai][bj][m][0], v1 = acc[ai][bj][m][1];
                    if (mode == 0) { v0 = v0 * ATT_C2; v1 = v1 * ATT_C2; }
                    else if (mode == 2) {
#pragma unroll
                        for (int j = 0; j < 4; ++j) { v0[j] = gelu_tanh(v0[j]); v1[j] = gelu_tanh(v1[j]); } }
                    u32x4 w; w.x = cvt_pk_bf16(v0[0], v0[1]); w.y = cvt_pk_bf16(v0[2], v0[3]); w.z = cvt_pk_bf16(v1[0], v1[1]); w.w = cvt_pk_bf16(v1[2], v1[3]);
                    *(u32x4*)(rowp + bj * HALF) = w; } }
    }
};
struct EpiRelu2 {
    static constexpr bool PERM = true, AFTER_DRAIN = false;
    bf16_t* O; int ldc;
    __device__ __forceinline__ void operator()(const f32x4 (&acc)[2][2][4][2], const Unit& u, int wr, int wc, int fr, int fq) const {
        const int row0 = u.pm * BM + wr * 64 + fr, col0 = u.pn * BM + wc * 32 + 8 * fq;
#pragma unroll
        for (int ai = 0; ai < 2; ++ai)
#pragma unroll
            for (int m = 0; m < 4; ++m) { bf16_t* rowp = O + (size_t)(row0 + ai * HALF + m * 16) * ldc + col0;
#pragma unroll
                for (int bj = 0; bj < 2; ++bj) { f32x4 v0 = acc[ai][bj][m][0], v1 = acc[ai][bj][m][1];
#pragma unroll
                    for (int j = 0; j < 4; ++j) { const float a = __builtin_fmaxf(v0[j], 0.f), b = __builtin_fmaxf(v1[j], 0.f); v0[j] = a * a; v1[j] = b * b; }
                    u32x4 w; w.x = cvt_pk_bf16(v0[0], v0[1]); w.y = cvt_pk_bf16(v0[2], v0[3]); w.z = cvt_pk_bf16(v1[0], v1[1]); w.w = cvt_pk_bf16(v1[2], v1[3]);
                    *(u32x4*)(rowp + bj * HALF) = w; } }
    }
};
struct EpiRes {
    static constexpr bool PERM = false, AFTER_DRAIN = false;
    const float* base; float* out; const float* gate; int gate_stride; float alpha; int ldc;
    __device__ __forceinline__ void operator()(const f32x4 (&acc)[2][2][4][2], const Unit& u, int wr, int wc, int fr, int fq) const {
        const int row0 = u.pm * BM + wr * 64 + fr, col0 = u.pn * BM + wc * 32 + 4 * fq;
        const float* gp = gate + (size_t)(u.pm >> 4) * gate_stride + col0;
        f32x4 gv[2][2];
#pragma unroll
        for (int bj = 0; bj < 2; ++bj)
#pragma unroll
            for (int n = 0; n < 2; ++n) gv[bj][n] = *(const f32x4*)(gp + bj * HALF + n * 16) + 1.0f;
        f32x4 cur[2][2], nxt[2][2];
#pragma unroll
        for (int bj = 0; bj < 2; ++bj)
#pragma unroll
            for (int n = 0; n < 2; ++n) cur[bj][n] = *(const f32x4*)(base + (size_t)row0 * ldc + col0 + bj * HALF + n * 16);
#pragma unroll
        for (int idx = 0; idx < 8; ++idx) { const int ai = idx >> 2, m = idx & 3; const size_t off = (size_t)(row0 + ai * HALF + m * 16) * ldc + col0;
            if (idx + 1 < 8) { const size_t offn = (size_t)(row0 + ((idx + 1) >> 2) * HALF + ((idx + 1) & 3) * 16) * ldc + col0;
#pragma unroll
                for (int bj = 0; bj < 2; ++bj)
#pragma unroll
                    for (int n = 0; n < 2; ++n) nxt[bj][n] = *(const f32x4*)(base + offn + bj * HALF + n * 16); }
#pragma unroll
            for (int bj = 0; bj < 2; ++bj)
#pragma unroll
                for (int n = 0; n < 2; ++n) { *(f32x4*)(out + off + bj * HALF + n * 16) = cur[bj][n] * alpha + gv[bj][n] * acc[ai][bj][m][n]; cur[bj][n] = nxt[bj][n]; }
        }
    }
};

template <class Epi, class Sched, bool ALIGN_EPI = false, bool SP2 = false>
__device__ __forceinline__ void gemm_phase(PG8_LAS unsigned char* lds, const Gemm g, const Sched& S, const Epi& E) {
    const int tid = fresh_tid(), wid = __builtin_amdgcn_readfirstlane(tid >> 6), lane = tid & 63, wr = wid >> 2, wc = wid & 3, fr = lane & 15, fq = lane >> 4;
    const int K = g.K, nt = K / BK;
    unsigned voffA[2], voffB[2];
#pragma unroll
    for (int i = 0; i < 2; ++i) { int R, C; stage_rc(tid * 16 + i * 8192, R, C); const int Rb = Epi::PERM ? ((R & ~31) + perm32(R & 31)) : R;
        voffA[i] = (unsigned)(R * K + C) * 2u; voffB[i] = (unsigned)(Rb * K + C) * 2u; }
    const size_t kstep = (size_t)(BK * 2);
    const size_t hstep = (size_t)HALF * K * 2;
    const size_t tstep = 2 * hstep;
    const unsigned ldsw = (unsigned)wid * 1024u;
    const int aoff = lds_byte(wr * 64 + fr, fq * 8), boff = lds_byte(wc * 32 + fr, fq * 8);
#define PG8_SA(b, h) (((b) * 2 + (h)) * HTB)
#define PG8_SB(b, h) ((4 + (b) * 2 + (h)) * HTB)
#define PG8_STAGE(bufoff, gbase, voff) do { _Pragma("unroll") for (int _i = 0; _i < 2; ++_i) \
        __builtin_amdgcn_global_load_lds((const unsigned*)((const char*)(gbase) + (voff)[_i]), (PG8_LAS unsigned*)(lds + (bufoff) + ldsw + _i * 8192), 16, 0, 0); } while (0)
#define PG8_LDA(dst, b, h) do { _Pragma("unroll") for (int m = 0; m < 4; ++m) _Pragma("unroll") for (int k = 0; k < 2; ++k) dst[m][k] = *(const PG8_LAS bf16x8*)(lds + PG8_SA(b, h) + aoff + m * 2048 + k * 1024); } while (0)
#define PG8_LDB(dst, b, h) do { _Pragma("unroll") for (int n = 0; n < 2; ++n) _Pragma("unroll") for (int k = 0; k < 2; ++k) dst[n][k] = *(const PG8_LAS bf16x8*)(lds + PG8_SB(b, h) + boff + n * 2048 + k * 1024); } while (0)
#define PG8_MMA(ai, bj, At, Bt) do { __builtin_amdgcn_s_setprio(1); _Pragma("unroll") for (int m = 0; m < 4; ++m) _Pragma("unroll") for (int n = 0; n < 2; ++n) _Pragma("unroll") for (int k = 0; k < 2; ++k) \
        acc[ai][bj][m][n] = __builtin_amdgcn_mfma_f32_16x16x32_bf16(Bt[n][k], At[m][k], acc[ai][bj][m][n], 0, 0, 0); __builtin_amdgcn_s_setprio(0); } while (0)
#define PG8_WAIT_V(n) asm volatile("s_waitcnt vmcnt(" #n ")" ::: "memory")
#define PG8_WAIT_L(n) asm volatile("s_waitcnt lgkmcnt(" #n ")" ::: "memory")
#define PG8_BAR __builtin_amdgcn_s_barrier()
#define PG8_SCHED __builtin_amdgcn_sched_barrier(0)
    Unit cur, nxt; int ui = 0;
    if (!S.next(0, cur)) return;
    f32x4 acc[2][2][4][2];
#pragma unroll
    for (int a = 0; a < 2; ++a)
#pragma unroll
        for (int b = 0; b < 2; ++b)
#pragma unroll
            for (int m = 0; m < 4; ++m)
#pragma unroll
                for (int n = 0; n < 2; ++n) acc[a][b][m][n] = (f32x4){0.f, 0.f, 0.f, 0.f};
    bf16x8 At[4][2], B0[2][2], B1[2][2];
    const char* cA = (const char*)g.A + (size_t)cur.pm * tstep; const char* cB = (const char*)g.Bt + (size_t)cur.pn * tstep;
    S.a_ready(cur);
    if constexpr (SP2) {
        PG8_STAGE(PG8_SB(0, 0), cB, voffB); PG8_STAGE(PG8_SB(0, 1), cB + hstep, voffB); PG8_STAGE(PG8_SA(0, 0), cA, voffA); PG8_STAGE(PG8_SA(0, 1), cA + hstep, voffA);
        if (wr == 1) PG8_BAR;
        PG8_WAIT_V(2); PG8_BAR;
        PG8_STAGE(PG8_SB(1, 0), cB + kstep, voffB); PG8_STAGE(PG8_SA(1, 0), cA + kstep, voffA); PG8_STAGE(PG8_SB(1, 1), cB + hstep + kstep, voffB);
        PG8_WAIT_V(6); PG8_BAR;
    } else {
        PG8_STAGE(PG8_SB(0, 0), cB, voffB); PG8_STAGE(PG8_SA(0, 0), cA, voffA); PG8_STAGE(PG8_SB(0, 1), cB + hstep, voffB); PG8_STAGE(PG8_SA(0, 1), cA + hstep, voffA);
        if (wr == 1) PG8_BAR;
        PG8_WAIT_V(4); PG8_BAR;
        PG8_STAGE(PG8_SB(1, 0), cB + kstep, voffB); PG8_STAGE(PG8_SA(1, 0), cA + kstep, voffA); PG8_STAGE(PG8_SB(1, 1), cB + hstep + kstep, voffB);
        PG8_WAIT_V(6); PG8_BAR;
    }
    for (;;) {
        const bool has_next = S.next(ui + 1, nxt);
        const char* nA = has_next ? (const char*)g.A + (size_t)nxt.pm * tstep : cA; const char* nB = has_next ? (const char*)g.Bt + (size_t)nxt.pn * tstep : cB;
        for (int t = 0; t < nt; t += 2) {
            const bool last = (t == nt - 2);
            const char* a1 = cA + (size_t)(t + 1) * kstep;
            const char* a2 = last ? nA : cA + (size_t)(t + 2) * kstep; const char* b2 = last ? nB : cB + (size_t)(t + 2) * kstep;
            const char* a3 = a2 + kstep; const char* b3 = b2 + kstep;
            if (last && has_next) S.a_ready(nxt);
            if constexpr (SP2) {
            PG8_LDB(B0, 0, 0); PG8_LDB(B1, 0, 1); PG8_SCHED; PG8_LDA(At, 0, 0); PG8_STAGE(PG8_SA(1, 1), a1 + hstep, voffA);
            PG8_WAIT_V(8); PG8_WAIT_L(0); PG8_BAR; PG8_MMA(0, 0, At, B0); PG8_MMA(0, 1, At, B1); PG8_BAR; PG8_SCHED;
            PG8_LDA(At, 0, 1); PG8_STAGE(PG8_SB(0, 0), b2, voffB); PG8_STAGE(PG8_SB(0, 1), b2 + hstep, voffB); PG8_STAGE(PG8_SA(0, 0), a2, voffA);
            PG8_WAIT_V(8); PG8_WAIT_L(0); PG8_BAR; PG8_MMA(1, 0, At, B0); PG8_MMA(1, 1, At, B1); PG8_BAR; PG8_SCHED;
            PG8_LDB(B0, 1, 0); PG8_LDB(B1, 1, 1); PG8_SCHED; PG8_LDA(At, 1, 0); PG8_STAGE(PG8_SA(0, 1), a2 + hstep, voffA);
            PG8_WAIT_V(8); PG8_WAIT_L(0); PG8_BAR; PG8_MMA(0, 0, At, B0); PG8_MMA(0, 1, At, B1); PG8_BAR; PG8_SCHED;
            PG8_LDA(At, 1, 1); PG8_STAGE(PG8_SB(1, 0), b3, voffB); PG8_STAGE(PG8_SB(1, 1), b3 + hstep, voffB); PG8_STAGE(PG8_SA(1, 0), a3, voffA);
            PG8_WAIT_V(8); PG8_WAIT_L(0); PG8_BAR; PG8_MMA(1, 0, At, B0); PG8_MMA(1, 1, At, B1); PG8_BAR; PG8_SCHED;
            } else {
            PG8_LDB(B0, 0, 0); PG8_SCHED; PG8_LDA(At, 0, 0); PG8_STAGE(PG8_SA(1, 1), a1 + hstep, voffA);
            PG8_WAIT_L(8); PG8_BAR; PG8_WAIT_L(0); PG8_MMA(0, 0, At, B0); PG8_BAR; PG8_SCHED;
            PG8_LDB(B1, 0, 1); PG8_STAGE(PG8_SB(0, 0), b2, voffB);
            PG8_BAR; PG8_WAIT_L(0); PG8_MMA(0, 1, At, B1); PG8_BAR;
            PG8_LDA(At, 0, 1); PG8_STAGE(PG8_SA(0, 0), a2, voffA);
            PG8_BAR; PG8_WAIT_L(0); PG8_MMA(1, 0, At, B0); PG8_BAR; PG8_SCHED;
            PG8_STAGE(PG8_SB(0, 1), b2 + hstep, voffB);
            PG8_WAIT_V(6); PG8_BAR; PG8_MMA(1, 1, At, B1); PG8_BAR;
            PG8_LDB(B0, 1, 0); PG8_SCHED; PG8_LDA(At, 1, 0); PG8_STAGE(PG8_SA(0, 1), a2 + hstep, voffA);
            PG8_WAIT_L(8); PG8_BAR; PG8_WAIT_L(0); PG8_MMA(0, 0, At, B0); PG8_BAR; PG8_SCHED;
            PG8_LDB(B1, 1, 1); PG8_STAGE(PG8_SB(1, 0), b3, voffB);
            PG8_BAR; PG8_WAIT_L(0); PG8_MMA(0, 1, At, B1); PG8_BAR;
            PG8_LDA(At, 1, 1); PG8_STAGE(PG8_SA(1, 0), a3, voffA);
            PG8_BAR; PG8_WAIT_L(0); PG8_MMA(1, 0, At, B0); PG8_BAR; PG8_SCHED;
            PG8_STAGE(PG8_SB(1, 1), b3 + hstep, voffB);
            PG8_WAIT_V(6); PG8_BAR; PG8_MMA(1, 1, At, B1); PG8_BAR;
            }
        }
        if constexpr (ALIGN_EPI) { if (wr == 0) PG8_BAR; }
        if constexpr (!Epi::AFTER_DRAIN) { E(acc, cur, wr, wc, fr, fq); S.done(cur); }
        if (!has_next) break;
#pragma unroll
        for (int a = 0; a < 2; ++a)
#pragma unroll
            for (int b = 0; b < 2; ++b)
#pragma unroll
                for (int m = 0; m < 4; ++m)
#pragma unroll
                    for (int n = 0; n < 2; ++n) acc[a][b][m][n] = (f32x4){0.f, 0.f, 0.f, 0.f};
        cur = nxt; cA = nA; cB = nB; ++ui;
        if constexpr (ALIGN_EPI) { if (wr == 1) PG8_BAR; }
    }
    PG8_WAIT_V(0);
    if constexpr (!ALIGN_EPI) { if (wr == 0) PG8_BAR; }
    PG8_BAR;
    if constexpr (Epi::AFTER_DRAIN) { E.fused(acc, cur, wr, wc, fr, fq, lds, wid, lane); S.done(cur); }
#undef PG8_SA
#undef PG8_SB
#undef PG8_STAGE
#undef PG8_LDA
#undef PG8_LDB
#undef PG8_MMA
#undef PG8_WAIT_V
#undef PG8_WAIT_L
#undef PG8_BAR
#undef PG8_SCHED
}
}

#define LAS __attribute__((address_space(3)))
#define GAS __attribute__((address_space(1)))
namespace mix {
typedef unsigned short bf16;
typedef short bf16x8 __attribute__((ext_vector_type(8)));
typedef short s16x4 __attribute__((ext_vector_type(4)));
typedef short v4i16_t __attribute__((ext_vector_type(4)));
typedef float f32x16 __attribute__((ext_vector_type(16)));
typedef float f32x4 __attribute__((ext_vector_type(4)));
typedef unsigned u32x4 __attribute__((ext_vector_type(4)));
typedef LAS const char* lds_cptr;
constexpr int PITCH = 5120, SEQ = 4096, MIXP = 2048;
constexpr int COL_K = 1024, COL_V = 2048, COL_U = 3072, COL_G = 4096;
__device__ __forceinline__ int crow(int r, int hi) { return (r & 3) + 8 * (r >> 2) + 4 * hi; }
__device__ __forceinline__ unsigned cvtpk(float lo, float hi) { return pg8::cvt_pk_bf16(lo, hi); }
__device__ __forceinline__ float bf2f(unsigned short v) { return __uint_as_float((unsigned)v << 16); }
__device__ __forceinline__ void glds16(const void* gsrc, unsigned lds_dst) { unsigned keep;
    asm volatile("s_mov_b32 %0, m0\n\ts_mov_b32 m0, %2\n\ts_nop 0\n\tglobal_load_lds_dwordx4 %1, off\n\ts_mov_b32 m0, %0" : "=&s"(keep) : "v"(gsrc), "s"(lds_dst) : "memory"); }
__device__ __forceinline__ s16x4 vtr(lds_cptr p) { return __builtin_bit_cast(s16x4, __builtin_amdgcn_ds_read_tr16_b64_v4i16((LAS v4i16_t*)p)); }
#define MIX_MX3(a, b, c) __builtin_fmaxf(__builtin_fmaxf((a), (b)), (c))
__device__ __forceinline__ float rowmax(const f32x16& p0, const f32x16& p1) {
    float a = MIX_MX3(p0[0], p0[1], p1[0]), b = MIX_MX3(p0[2], p0[3], p1[1]); a = MIX_MX3(a, p1[2], p1[3]);
#pragma unroll
    for (int r = 4; r < 16; r += 4) { a = MIX_MX3(a, p0[r], p0[r + 1]); b = MIX_MX3(b, p0[r + 2], p0[r + 3]); a = MIX_MX3(a, p1[r], p1[r + 1]); b = MIX_MX3(b, p1[r + 2], p1[r + 3]); }
    float m = __builtin_fmaxf(a, b); auto rr = __builtin_amdgcn_permlane32_swap(__float_as_uint(m), __float_as_uint(m), false, false);
    return __builtin_fmaxf(__uint_as_float(rr[0]), __uint_as_float(rr[1])); }
#define MIX_MFMA(a, b, c) __builtin_amdgcn_mfma_f32_32x32x16_bf16(a, b, c, 0, 0, 0)

constexpr int SLOTB = 16384, A_LDS_K = 0, A_LDS_V = 2 * SLOTB;
__device__ __forceinline__ void attn_unit(int b, int h, int qb, const bf16* P, bf16* MIXO, LAS unsigned char* lds, LAS float* wsf_all, float lam, const float* subg) {
    const int tid = fresh_tid(), lane = tid & 63, r32 = lane & 31, hi = lane >> 5; const int wid = __builtin_amdgcn_readfirstlane(tid >> 6);
    const int c = wid >> 2, g = wid & 3;
    const long rowbase = (long)b * SEQ; const int q0 = qb * 128;
    const int NT = 2 * qb + 2, my_nt = 2 * qb + 1 + (g >> 1);
    const bf16* Qw = P + (rowbase + q0 + g * 32) * PITCH + h * 128 + c * 64;
    const bf16* Kh = P + rowbase * PITCH + COL_K + h * 128;
    const bf16* Vh = P + rowbase * PITCH + COL_V + h * 128;
    const unsigned lds0 = (unsigned)(uintptr_t)lds;
    LAS float* wsf = wsf_all + wid * 64;
    const bf16* ksrc = Kh + (long)lane * PITCH + wid * 8;
    const bf16* vsrc = Vh + (long)(16 * (wid & 3) + (lane >> 2)) * PITCH + (wid >> 2) * 32 + (lane & 3) * 8;
    const unsigned kdst = lds0 + A_LDS_K + wid * 1024, vdst = lds0 + A_LDS_V + wid * 1024;
#define DMA_T(t, slot) do { const bf16* ks_ = ksrc + (long)(t) * 64 * PITCH; const bf16* vs_ = vsrc + (long)(t) * 64 * PITCH; \
        glds16(ks_, (unsigned)__builtin_amdgcn_readfirstlane(kdst + (slot))); glds16(ks_ + 64, (unsigned)__builtin_amdgcn_readfirstlane(kdst + (slot) + 8192)); \
        glds16(vs_, (unsigned)__builtin_amdgcn_readfirstlane(vdst + (slot))); glds16(vs_ + 64, (unsigned)__builtin_amdgcn_readfirstlane(vdst + (slot) + 8192)); } while (0)
    DMA_T(0, 0);
    bf16x8 qr[4];
#pragma unroll
    for (int d0 = 0; d0 < 4; ++d0) qr[d0] = *reinterpret_cast<const bf16x8*>(Qw + (long)r32 * PITCH + d0 * 16 + hi * 8);
    float m_run = 0.f, l_run = 0.f;
    f32x16 o[4];
#pragma unroll
    for (int d0 = 0; d0 < 4; ++d0) o[d0] = f32x16{};
    const lds_cptr kp0 = (lds_cptr)lds + A_LDS_K + c * 8192 + hi * 1024 + r32 * 16;
    const lds_cptr vp0 = (lds_cptr)lds + A_LDS_V + ((lane >> 4) & 1) * 32 + (lane & 3) * 8 + (4 * hi + ((lane & 15) >> 2)) * 64;
    for (int t = 0; t < NT; ++t) {
        const int so = (t & 1) * SLOTB;
        if (t + 1 < NT) { DMA_T(t + 1, so ^ SLOTB); asm volatile("s_waitcnt vmcnt(4)" ::: "memory"); }
        else asm volatile("s_waitcnt vmcnt(0)" ::: "memory");
        asm volatile("s_barrier" ::: "memory");
        if (t < my_nt) {
            const lds_cptr kb = kp0 + so;
            f32x16 p0 = f32x16{}, p1 = f32x16{};
#pragma unroll
            for (int d0 = 0; d0 < 4; ++d0) {
                const bf16x8 b0 = *(const LAS bf16x8*)(kb + d0 * 2048), b1 = *(const LAS bf16x8*)(kb + d0 * 2048 + 512);
                p0 = MIX_MFMA(b0, qr[d0], p0); p1 = MIX_MFMA(b1, qr[d0], p1); }
            const float rm = rowmax(p0, p1);
            if (t == 0) m_run = rm;
            else if (__any(rm > m_run)) {
                const float mn = __builtin_fmaxf(m_run, rm), f = __builtin_amdgcn_exp2f(m_run - mn);
                l_run *= f; m_run = mn;
                if (hi == 0) wsf[r32] = f;
                asm volatile("s_waitcnt lgkmcnt(0)" ::: "memory");
#pragma unroll
                for (int r = 0; r < 16; ++r) { const float fr_ = wsf[crow(r, hi)];
#pragma unroll
                    for (int d0 = 0; d0 < 4; ++d0) o[d0][r] *= fr_; }
                asm volatile("s_waitcnt lgkmcnt(0)" ::: "memory");
            }
            float sacc = 0.f;
#pragma unroll
            for (int r = 0; r < 16; ++r) { p0[r] = __builtin_amdgcn_exp2f(p0[r] - m_run); p1[r] = __builtin_amdgcn_exp2f(p1[r] - m_run); sacc += p0[r] + p1[r]; }
            l_run += sacc;
            u32x4 pw[4];
            pw[0] = (u32x4){cvtpk(p0[0], p0[1]), cvtpk(p0[2], p0[3]), cvtpk(p0[4], p0[5]), cvtpk(p0[6], p0[7])};
            pw[1] = (u32x4){cvtpk(p0[8], p0[9]), cvtpk(p0[10], p0[11]), cvtpk(p0[12], p0[13]), cvtpk(p0[14], p0[15])};
            pw[2] = (u32x4){cvtpk(p1[0], p1[1]), cvtpk(p1[2], p1[3]), cvtpk(p1[4], p1[5]), cvtpk(p1[6], p1[7])};
            pw[3] = (u32x4){cvtpk(p1[8], p1[9]), cvtpk(p1[10], p1[11]), cvtpk(p1[12], p1[13]), cvtpk(p1[14], p1[15])};
            const lds_cptr vp = vp0 + so;
#pragma unroll
            for (int d0 = 0; d0 < 4; ++d0) {
#pragma unroll
                for (int ks = 0; ks < 4; ++ks) {
                    const s16x4 lo = vtr(vp + d0 * 4096 + ks * 1024), hh = vtr(vp + d0 * 4096 + ks * 1024 + 512);
                    const bf16x8 vf = (bf16x8){lo[0], lo[1], lo[2], lo[3], hh[0], hh[1], hh[2], hh[3]};
                    o[d0] = MIX_MFMA(__builtin_bit_cast(bf16x8, pw[ks]), vf, o[d0]); } }
        }
        asm volatile("s_waitcnt lgkmcnt(0)\n\ts_barrier" ::: "memory");
    }
#undef DMA_T
    { auto rr = __builtin_amdgcn_permlane32_swap(__float_as_uint(l_run), __float_as_uint(l_run), false, false); l_run = __uint_as_float(rr[0]) + __uint_as_float(rr[1]); }
    if (hi == 0) wsf[32 + r32] = l_run;
    asm volatile("s_waitcnt lgkmcnt(0)" ::: "memory");
    LAS float* stg = (LAS float*)lds;
#pragma unroll
    for (int r = 0; r < 16; ++r) { const int row = 32 * g + crow(r, hi); const float rl = __builtin_amdgcn_rcpf(wsf[32 + crow(r, hi)]);
#pragma unroll
        for (int d0 = 0; d0 < 4; ++d0) { const int e = 32 * d0 + r32; stg[((c * 128 + row) * 32 + ((e >> 2) ^ (row & 7))) * 4 + (e & 3)] = o[d0][r] * rl; } }
    asm volatile("s_waitcnt lgkmcnt(0)\n\ts_barrier" ::: "memory");
    {
        const int row = tid >> 2, qd = tid & 3;
        f32x4 a[8]; float ss = 0.f;
#pragma unroll
        for (int i = 0; i < 8; ++i) { const int ph = (row * 32 + ((8 * qd + i) ^ (row & 7))) * 4;
            const f32x4 v0 = *(const LAS f32x4*)(stg + ph), v1 = *(const LAS f32x4*)(stg + 128 * 128 + ph);
            a[i] = v0 - v1 * lam; ss += (a[i][0] * a[i][0] + a[i][1] * a[i][1]) + (a[i][2] * a[i][2] + a[i][3] * a[i][3]); }
        ss += __shfl_xor(ss, 1); ss += __shfl_xor(ss, 2);
        const float rs = 0.8f / sqrtf(ss * (1.0f / 128.0f) + 1e-5f);
        bf16* op = MIXO + (rowbase + q0 + row) * MIXP + h * 128 + 32 * qd;
        const float* gp = subg + 32 * qd;
#pragma unroll
        for (int i = 0; i < 8; i += 2) { const f32x4 g0 = *(const f32x4*)(gp + 4 * i), g1 = *(const f32x4*)(gp + 4 * i + 4);
            const f32x4 x0 = a[i] * g0 * rs, x1 = a[i + 1] * g1 * rs;
            u32x4 w; w.x = cvtpk(x0[0], x0[1]); w.y = cvtpk(x0[2], x0[3]); w.z = cvtpk(x1[0], x1[1]); w.w = cvtpk(x1[2], x1[3]);
            *(u32x4*)(op + 4 * i) = w; }
    }
    asm volatile("s_waitcnt lgkmcnt(0)\n\ts_barrier" ::: "memory");
}

constexpr int G_WM = 0, G_WMP = 136, G_VN = 36864;
__device__ __forceinline__ void gmlp_load_wm(const float* ws_g, LAS unsigned char* lds) {
    const int tid = fresh_tid(), t = tid >> 2, s0 = (tid & 3) * 32;
#pragma unroll
    for (int i = 0; i < 4; ++i) { const f32x4 a = *(const f32x4*)(ws_g + t * 128 + s0 + 8 * i), b = *(const f32x4*)(ws_g + t * 128 + s0 + 8 * i + 4);
        const bool keep = (t >> 6) >= ((s0 + 8 * i) >> 6);
        u32x4 w; w.x = cvtpk(a[0], a[1]); w.y = cvtpk(a[2], a[3]); w.z = cvtpk(b[0], b[1]); w.w = cvtpk(b[2], b[3]);
        if (!keep) w = (u32x4){0u, 0u, 0u, 0u};
        *(LAS u32x4*)(lds + G_WM + (t * G_WMP + s0 + 8 * i) * 2) = w; }
}
__device__ __forceinline__ void gmlp_item(int b, int nb, int g, const bf16* P, bf16* MIXO, LAS unsigned char* lds, const float* lng, const float* lnb, const float* bsg) {
    const int tid = fresh_tid(), lane = tid & 63, r32 = lane & 31, hi = lane >> 5; const int wid = __builtin_amdgcn_readfirstlane(tid >> 6);
    const long rowbase = (long)b * SEQ + nb * 128;
    {
        const int s = tid >> 2, qd = tid & 3;
        const bf16* vp = P + (rowbase + s) * PITCH + COL_G + g * 128 + qd * 32;
        float v[32]; float sum = 0.f;
#pragma unroll
        for (int i = 0; i < 4; ++i) { const u32x4 w = *(const u32x4*)(vp + 8 * i);
#pragma unroll
            for (int j = 0; j < 4; ++j) { v[8 * i + 2 * j] = __uint_as_float(w[j] << 16); v[8 * i + 2 * j + 1] = __uint_as_float(w[j] & 0xffff0000u); } }
#pragma unroll
        for (int i = 0; i < 32; ++i) sum += v[i];
        sum += __shfl_xor(sum, 1); sum += __shfl_xor(sum, 2);
        const float mean = sum * (1.0f / 128.0f); float sq = 0.f;
#pragma unroll
        for (int i = 0; i < 32; ++i) { v[i] -= mean; sq += v[i] * v[i]; }
        sq += __shfl_xor(sq, 1); sq += __shfl_xor(sq, 2);
        const float rstd = 1.0f / sqrtf(sq * (1.0f / 128.0f) + 1e-5f);
        const float* gg = lng + g * 128 + qd * 32; const float* gb = lnb + g * 128 + qd * 32;
        LAS unsigned char* dst = lds + G_VN + ((qd * 8 + (s >> 4)) * 16 + (s & 15)) * 64;
#pragma unroll
        for (int i = 0; i < 4; ++i) { float y[8];
#pragma unroll
            for (int j = 0; j < 8; ++j) y[j] = v[8 * i + j] * rstd * gg[8 * i + j] + gb[8 * i + j];
            u32x4 w; w.x = cvtpk(y[0], y[1]); w.y = cvtpk(y[2], y[3]); w.z = cvtpk(y[4], y[5]); w.w = cvtpk(y[6], y[7]);
            *(LAS u32x4*)(dst + 16 * i) = w; }
    }
    asm volatile("s_waitcnt lgkmcnt(0)" ::: "memory"); __builtin_amdgcn_s_barrier(); asm volatile("" ::: "memory");
    const int tm = wid >> 1;
    const lds_cptr ap = (lds_cptr)lds + G_WM + ((32 * tm + r32) * G_WMP + 8 * hi) * 2;
    const lds_cptr vb = (lds_cptr)lds + G_VN + (8 * hi + ((lane & 15) >> 2)) * 64 + ((lane >> 4) & 1) * 32 + (lane & 3) * 8;
#pragma unroll
    for (int dd = 0; dd < 2; ++dd) { const int dn = (wid & 1) * 2 + dd;
        f32x16 acc = f32x16{};
#pragma unroll
        for (int ks = 0; ks < 8; ++ks) {
            const bf16x8 af = *(const LAS bf16x8*)(ap + ks * 32);
            const s16x4 lo = vtr(vb + (dn * 8 + ks) * 1024), hh = vtr(vb + (dn * 8 + ks) * 1024 + 256);
            const bf16x8 vf = (bf16x8){lo[0], lo[1], lo[2], lo[3], hh[0], hh[1], hh[2], hh[3]};
            acc = MIX_MFMA(af, vf, acc); }
        const int d = 32 * dn + r32;
#pragma unroll
        for (int r = 0; r < 16; ++r) { const int t = 32 * tm + crow(r, hi);
            const float uu = bf2f(P[(rowbase + t) * PITCH + COL_U + g * 128 + d]);
            const float val = uu * (acc[r] + bsg[g * 128 + t]);
            MIXO[(rowbase + t) * MIXP + 1024 + g * 128 + d] = (bf16)(cvtpk(val, val) & 0xffffu); }
    }
    asm volatile("s_waitcnt lgkmcnt(0)" ::: "memory"); __builtin_amdgcn_s_barrier(); asm volatile("" ::: "memory");
}
}

constexpr int NWAVES = 8;
constexpr int BATCH = 4, SEQ = 4096, D = 2048, M = BATCH * SEQ, INW = 5120, FF = 8192, NMOD = 6;
constexpr float LN_EPS = 1e-5f;
constexpr float DN_ALPHA = 1.189207115002721f;
constexpr size_t MiB = 1u << 20;
constexpr size_t WS_CTL = 0, CTL_ZERO_BYTES = 64 * 1024;
constexpr size_t WS_MOD = 1 * MiB;
constexpr size_t WS_WIN = 2 * MiB, WS_WOUT = 22 * MiB, WS_W1 = 30 * MiB, WS_W2 = 62 * MiB;
constexpr size_t WS_XN = 94 * MiB;
constexpr size_t WS_PROJ = 158 * MiB;
constexpr size_t WS_MIX = 318 * MiB;
constexpr size_t WS_HID = 158 * MiB;
constexpr size_t WS_END = 414 * MiB;
static_assert(WS_WIN + (size_t)INW * D * 2 <= WS_WOUT && WS_WOUT + (size_t)D * D * 2 <= WS_W1 && WS_W1 + (size_t)FF * D * 2 <= WS_W2 && WS_W2 + (size_t)D * FF * 2 <= WS_XN &&
              WS_XN + (size_t)M * D * 2 <= WS_PROJ && WS_PROJ + (size_t)M * INW * 2 <= WS_MIX && WS_MIX + (size_t)M * D * 2 <= WS_END && WS_HID + (size_t)M * FF * 2 <= WS_END, "d_ws map");
constexpr int CW_BAR = 4096;
constexpr int RING_OFF = 0, RING_BYTES = 131072;
constexpr int LDSCTL_OFF = RING_BYTES, MISC_OFF = LDSCTL_OFF + 320;
constexpr int WSF_OFF = RING_BYTES + 1024;
constexpr int LDS_BYTES = 147456;
static_assert(MISC_OFF + 128 <= WSF_OFF && WSF_OFF + 2048 <= LDS_BYTES, "LDS map");

typedef unsigned short bf16;
typedef unsigned v4u __attribute__((ext_vector_type(4)));
typedef float f32x4 __attribute__((ext_vector_type(4)));
typedef GAS unsigned gu32;
#define RLX_AGENT __ATOMIC_RELAXED, __HIP_MEMORY_SCOPE_AGENT
#define LDS_WAIT() asm volatile("s_waitcnt lgkmcnt(0)" ::: "memory")
#define VM_WAIT() asm volatile("s_waitcnt vmcnt(0)" ::: "memory")
__device__ __forceinline__ unsigned pk2(float lo, float hi) { return pg8::cvt_pk_bf16(lo, hi); }

#define XB_TMO      128
#define XB_XCNT(j)  (256  + 64 * (j))
#define XB_XSUB(j)  (1280 + 64 * (j))
#define XB_XGEN(j)  (2304 + 64 * (j))
#define XB_TOP      3328
#define XB_TOPGEN   3392
#define XCD_BAR_WORDS 3456
#define XB_SPIN_CAP (1u << 18)

__device__ __forceinline__ unsigned xb_ld(unsigned* p)              { return __hip_atomic_load(p, __ATOMIC_RELAXED, __HIP_MEMORY_SCOPE_AGENT); }
__device__ __forceinline__ unsigned xb_add(unsigned* p, unsigned v) { return __hip_atomic_fetch_add(p, v, __ATOMIC_RELAXED, __HIP_MEMORY_SCOPE_AGENT); }
__device__ __forceinline__ unsigned xb_xcc_id() { return (unsigned)__builtin_amdgcn_s_getreg((3 << 11) | 20) & 0xFu; }
#define XB_SPIN(cond, bar) do { unsigned _sp = 0; while (cond) { __builtin_amdgcn_s_sleep(1); \
    if ((++_sp & 255u) == 0u) { if (xb_ld(&(bar)[XB_TMO])) break; if (_sp > XB_SPIN_CAP) { atomicAdd(&(bar)[XB_TMO], 1u); break; } } } } while (0)

struct XcdBarrier {
    unsigned* bar; unsigned x;
    volatile LAS unsigned* st;
};

__device__ __forceinline__ XcdBarrier xcd_barrier_post(unsigned* bar, volatile LAS unsigned* st) {
    XcdBarrier b; b.bar = bar; b.x = xb_xcc_id(); b.st = st;
    if (threadIdx.x == 0) (void)xb_add(&bar[XB_XCNT(b.x)], 1u);
    return b;
}
__device__ __forceinline__ void xcd_barrier_complete(unsigned* bar, unsigned x, unsigned& nloc, unsigned& nx) {
    const unsigned G = gridDim.x * gridDim.y * gridDim.z;
    unsigned sum, cnt, mine, sp = 0u;
    for (;;) {
        sum = 0u; cnt = 0u; mine = 0u;
#pragma unroll
        for (unsigned j = 0; j < 16; ++j) { const unsigned c = xb_ld(&bar[XB_XCNT(j)]); sum += c; cnt += (c > 0u) ? 1u : 0u; mine = (j == x) ? c : mine; }
        if (sum == G) break;
        __builtin_amdgcn_s_sleep(1);
        if ((++sp & 255u) == 0u) { if (xb_ld(&bar[XB_TMO])) break; if (sp > XB_SPIN_CAP) { atomicAdd(&bar[XB_TMO], 1u); break; } }
    }
    nloc = mine > 0u ? mine : 1u; nx = cnt > 0u ? cnt : 1u;
}

__device__ __forceinline__ void xcd_barrier(const XcdBarrier& b) {
    asm volatile("s_waitcnt vmcnt(0)" ::: "memory");
    __syncthreads();
    if (threadIdx.x == 0) {
        unsigned* bar = b.bar;
        __builtin_amdgcn_s_waitcnt(0);
        unsigned nloc = b.st[0], nx = b.st[1];
        if (nloc == 0u) { xcd_barrier_complete(bar, b.x, nloc, nx); b.st[0] = nloc; b.st[1] = nx; }
        const unsigned old = xb_add(&bar[XB_XSUB(b.x)], 1u);
        const unsigned gen = old / nloc;
        if (old + 1u == (gen + 1u) * nloc) {
            __builtin_amdgcn_fence(__ATOMIC_RELEASE, "agent");
            asm volatile("s_waitcnt vmcnt(0)" ::: "memory");
            const unsigned og = xb_add(&bar[XB_TOP], 1u);
            const unsigned tg = og / nx;
            if (og + 1u == (tg + 1u) * nx) xb_add(&bar[XB_TOPGEN], 1u);
            else XB_SPIN(xb_ld(&bar[XB_TOPGEN]) == tg, bar);
            __builtin_amdgcn_fence(__ATOMIC_ACQUIRE, "agent");
            xb_add(&bar[XB_XGEN(b.x)], 1u);
            asm volatile("s_waitcnt vmcnt(0)" ::: "memory");
        } else {
            XB_SPIN(xb_ld(&bar[XB_XGEN(b.x)]) == gen, bar);
            __builtin_amdgcn_fence(__ATOMIC_ACQUIRE, "agent");
            asm volatile("s_waitcnt vmcnt(0)" ::: "memory");
        }
    }
    __syncthreads();
}

struct Frame {
    LAS unsigned char* lds;
    volatile LAS unsigned* MISC;
    gu32* ctl;
    int tid, lane, wave;
    int vcu, G;
    __device__ __forceinline__ void refresh() { tid = fresh_tid(); lane = tid & 63; wave = __builtin_amdgcn_readfirstlane(tid >> 6); }
};
__device__ __forceinline__ float wave_sum(float v) {
#pragma unroll
    for (int o = 1; o < 64; o <<= 1) v += __shfl_xor(v, o);
    return v;
}
__device__ __forceinline__ void p0_transpose_item(const float* W, int K, int N, bf16* WT, LAS float* scr, int item, int lane) {
    const int nblk = N / 32, kb = item / nblk, nb = item % nblk, k0 = 64 * kb, n0 = 32 * nb;
#pragma unroll 8
    for (int i = 0; i < 32; ++i) { const int kk = 2 * i + (lane >> 5); scr[kk * 33 + (lane & 31)] = W[(size_t)(k0 + kk) * N + n0 + (lane & 31)]; }
    LDS_WAIT(); asm volatile("" ::: "memory");
    const int c = lane & 7;
#pragma unroll
    for (int j = 0; j < 4; ++j) { const int n = (lane >> 3) + 8 * j; const LAS float* s = scr + (8 * c) * 33 + n;
        v4u o; o.x = pk2(s[0 * 33], s[1 * 33]); o.y = pk2(s[2 * 33], s[3 * 33]); o.z = pk2(s[4 * 33], s[5 * 33]); o.w = pk2(s[6 * 33], s[7 * 33]);
        *(GAS v4u*)(WT + (size_t)(n0 + n) * K + k0 + 8 * c) = o; }
    LDS_WAIT(); asm volatile("" ::: "memory");
}
__device__ __forceinline__ void p0_mod(Frame& F, const float* cvec, const float* w_ada, const float* b_ada, float* mod) {
    LAS float* sc = (LAS float*)(F.lds + RING_OFF);
    LAS float* red = (LAS float*)(F.lds + RING_OFF + 32768);
    for (int i = F.tid; i < BATCH * D; i += NWAVES * 64) { const float v = cvec[i]; sc[i] = v / (1.0f + __expf(-v)); }
    LDS_WAIT(); __syncthreads();
    const int col = blockIdx.x * 64 + F.lane, kbase = F.wave * 256;
    const float* wp = w_ada + (size_t)kbase * (NMOD * D) + col;
    float a0 = 0.f, a1 = 0.f, a2 = 0.f, a3 = 0.f;
#pragma unroll 16
    for (int k = 0; k < 256; ++k) { const float w = wp[(size_t)k * (NMOD * D)];
        a0 += sc[kbase + k] * w; a1 += sc[D + kbase + k] * w; a2 += sc[2 * D + kbase + k] * w; a3 += sc[3 * D + kbase + k] * w; }
    red[(F.wave * 4 + 0) * 64 + F.lane] = a0; red[(F.wave * 4 + 1) * 64 + F.lane] = a1; red[(F.wave * 4 + 2) * 64 + F.lane] = a2; red[(F.wave * 4 + 3) * 64 + F.lane] = a3;
    LDS_WAIT(); __syncthreads();
    if (F.tid < 256) { const int b = F.tid >> 6, l = F.tid & 63; float s = 0.f;
#pragma unroll
        for (int w = 0; w < 8; ++w) s += red[(w * 4 + b) * 64 + l];
        mod[(size_t)b * (NMOD * D) + blockIdx.x * 64 + l] = s + b_ada[blockIdx.x * 64 + l]; }
    LDS_WAIT(); __syncthreads();
}
struct RowStats { float mean, rstd; };
__device__ __forceinline__ RowStats row_stats(f32x4 (&v)[8]) {
    float s = 0.f;
#pragma unroll
    for (int j = 0; j < 8; ++j) s += (v[j].x + v[j].y) + (v[j].z + v[j].w);
    const float mean = wave_sum(s) * (1.f / D); float s2 = 0.f;
#pragma unroll
    for (int j = 0; j < 8; ++j) { const f32x4 d = v[j] - mean; s2 += (d.x * d.x + d.y * d.y) + (d.z * d.z + d.w * d.w); }
    RowStats r; r.mean = mean; r.rstd = 1.f / sqrtf(wave_sum(s2) * (1.f / D) + LN_EPS); return r;
}
__device__ __forceinline__ void p1_xn(Frame& F, const float* x, const float* mod, bf16* XN) {
    const int gw = F.vcu * NWAVES + F.wave, NGW = F.G * NWAVES;
    for (int m = gw; m < M; m += NGW) {
        const GAS f32x4* xr = (const GAS f32x4*)(x + (size_t)m * D) + F.lane;
        const float* mb = mod + (size_t)(m >> 12) * (NMOD * D);
        f32x4 v[8];
#pragma unroll
        for (int j = 0; j < 8; ++j) v[j] = xr[64 * j];
        const RowStats st = row_stats(v);
        GAS unsigned long long* o8 = (GAS unsigned long long*)(XN + (size_t)m * D) + F.lane;
#pragma unroll
        for (int j = 0; j < 8; ++j) { const f32x4 sh = *((const f32x4*)(mb + 0 * D) + F.lane + 64 * j), sc = *((const f32x4*)(mb + 1 * D) + F.lane + 64 * j);
            const f32x4 y = (v[j] - st.mean) * st.rstd * (sc + 1.0f) + sh;
            o8[64 * j] = (unsigned long long)pk2(y.x, y.y) | ((unsigned long long)pk2(y.z, y.w) << 32); }
    }
}
__device__ __forceinline__ void p5_ln(Frame& F, float* Y, const float* lg, const float* lb, const float* mod, bf16* XN) {
    const int gw = F.vcu * NWAVES + F.wave, NGW = F.G * NWAVES;
    for (int m = gw; m < M; m += NGW) {
        GAS f32x4* yr = (GAS f32x4*)(Y + (size_t)m * D) + F.lane;
        const float* mb = mod + (size_t)(m >> 12) * (NMOD * D);
        f32x4 v[8];
#pragma unroll
        for (int j = 0; j < 8; ++j) v[j] = yr[64 * j];
        const RowStats st = row_stats(v);
#pragma unroll
        for (int j = 0; j < 8; ++j) { const f32x4 g = *((const f32x4*)lg + F.lane + 64 * j), b = *((const f32x4*)lb + F.lane + 64 * j);
            v[j] = (v[j] - st.mean) * st.rstd * g + b; yr[64 * j] = v[j]; }
        const RowStats s2 = row_stats(v);
        GAS unsigned long long* o8 = (GAS unsigned long long*)(XN + (size_t)m * D) + F.lane;
#pragma unroll
        for (int j = 0; j < 8; ++j) { const f32x4 sh = *((const f32x4*)(mb + 3 * D) + F.lane + 64 * j), sc = *((const f32x4*)(mb + 4 * D) + F.lane + 64 * j);
            const f32x4 y = (v[j] - s2.mean) * s2.rstd * (sc + 1.0f) + sh;
            o8[64 * j] = (unsigned long long)pk2(y.x, y.y) | ((unsigned long long)pk2(y.z, y.w) << 32); }
    }
}
__device__ __forceinline__ void p8_ln(Frame& F, float* Y, const float* lg, const float* lb) {
    const int gw = F.vcu * NWAVES + F.wave, NGW = F.G * NWAVES;
    for (int m = gw; m < M; m += NGW) {
        GAS f32x4* yr = (GAS f32x4*)(Y + (size_t)m * D) + F.lane;
        f32x4 v[8];
#pragma unroll
        for (int j = 0; j < 8; ++j) v[j] = yr[64 * j];
        const RowStats st = row_stats(v);
#pragma unroll
        for (int j = 0; j < 8; ++j) { const f32x4 g = *((const f32x4*)lg + F.lane + 64 * j), b = *((const f32x4*)lb + F.lane + 64 * j);
            yr[64 * j] = (v[j] - st.mean) * st.rstd * g + b; }
    }
}

struct Args { const float* in[21]; float* out; unsigned char* ws; };
__global__ void __launch_bounds__(NWAVES * 64, 2) fwd_megakernel(Args args) {
    extern __shared__ __attribute__((aligned(16))) unsigned char lds[];
    Frame F;
    F.lds = (LAS unsigned char*)lds;
    F.MISC = (volatile LAS unsigned*)(F.lds + MISC_OFF);
    F.refresh();
    F.G = gridDim.x; { const int bx = blockIdx.x; F.vcu = (F.G % 8 == 0) ? (bx % 8) * (F.G / 8) + bx / 8 : bx; }
    unsigned char* ws = args.ws;
    F.ctl = (gu32*)(ws + WS_CTL);
    const float* x = args.in[0]; const float* cvec = args.in[1]; const float* w_ada = args.in[2]; const float* b_ada = args.in[3]; const float* w_in = args.in[4];
    const float* lq1 = args.in[5]; const float* lk1 = args.in[6]; const float* lq2 = args.in[7]; const float* lk2 = args.in[8]; const float* subg = args.in[9];
    const float* gln_g = args.in[10]; const float* gln_b = args.in[11]; const float* g_ws = args.in[12]; const float* g_bs = args.in[13]; const float* w_out = args.in[14];
    const float* ln1_g = args.in[15]; const float* ln1_b = args.in[16]; const float* w_ff1 = args.in[17]; const float* w_ff2 = args.in[18]; const float* ln2_g = args.in[19]; const float* ln2_b = args.in[20];
    float* out = args.out;
    float* MOD = (float*)(ws + WS_MOD);
    bf16* Win_t = (bf16*)(ws + WS_WIN); bf16* Wout_t = (bf16*)(ws + WS_WOUT); bf16* W1_t = (bf16*)(ws + WS_W1); bf16* W2_t = (bf16*)(ws + WS_W2);
    bf16* XN = (bf16*)(ws + WS_XN); bf16* PROJ = (bf16*)(ws + WS_PROJ); bf16* MIXB = (bf16*)(ws + WS_MIX); bf16* HID = (bf16*)(ws + WS_HID);
    for (int u = F.tid; u < (LDS_BYTES - LDSCTL_OFF) / 4; u += NWAVES * 64) ((LAS unsigned*)(F.lds + LDSCTL_OFF))[u] = 0u;
    __syncthreads();
    XcdBarrier bar = xcd_barrier_post((unsigned*)(F.ctl + CW_BAR), F.MISC + 8);
#define GRID_BAR() xcd_barrier(bar)

    {
        if (blockIdx.x < (NMOD * D) / 64) p0_mod(F, cvec, w_ada, b_ada, MOD);
        F.refresh();
        LAS float* scr = (LAS float*)(F.lds + RING_OFF + F.wave * 16384);
        const int gw = F.vcu * NWAVES + F.wave, NGW = F.G * NWAVES;
        constexpr int I_IN = (D / 64) * (INW / 32), I_O = (D / 64) * (D / 32), I_1 = (D / 64) * (FF / 32), I_2 = (FF / 64) * (D / 32);
        constexpr int NITEMS = I_IN + I_O + I_1 + I_2;
        for (int it = gw; it < NITEMS; it += NGW) {
            int r = it;
            if (r < I_IN) { p0_transpose_item(w_in, D, INW, Win_t, scr, r, F.lane); continue; } r -= I_IN;
            if (r < I_O) { p0_transpose_item(w_out, D, D, Wout_t, scr, r, F.lane); continue; } r -= I_O;
            if (r < I_1) { p0_transpose_item(w_ff1, D, FF, W1_t, scr, r, F.lane); continue; } r -= I_1;
            p0_transpose_item(w_ff2, FF, D, W2_t, scr, r, F.lane);
        }
        GRID_BAR();
    }
    F.refresh(); p1_xn(F, x, MOD, XN);
    GRID_BAR();
    {
        pg8::Gemm g{XN, Win_t, M, INW, D}; pg8::StaticOrder S; S.init(M, INW, F.G, (int)blockIdx.x);
        pg8::EpiProj E{PROJ, INW};
        pg8::gemm_phase<pg8::EpiProj, pg8::StaticOrder, true, true>(F.lds + RING_OFF, g, S, E);
        GRID_BAR();
    }
    {
        F.refresh();
        float lam;
        { const float a = lq1[F.lane] * lk1[F.lane], b = lq2[F.lane] * lk2[F.lane];
          lam = __expf(wave_sum(a)) - __expf(wave_sum(b)) + 0.2f; }
        LAS float* wsf = (LAS float*)(F.lds + WSF_OFF);
        const int bh = F.vcu >> 3, s = F.vcu & 7;
        for (int i = 0; i < 4; ++i) { const int qb = (i == 0) ? s : (i == 1) ? 15 - s : (i == 2) ? 16 + s : 31 - s;
            mix::attn_unit(bh >> 3, bh & 7, qb, PROJ, MIXB, F.lds + RING_OFF, wsf, lam, subg); }
        const int gg = F.vcu >> 5;
        mix::gmlp_load_wm(g_ws + (size_t)gg * 128 * 128, F.lds + RING_OFF);
        for (int i = 0; i < 4; ++i) { const int idx = (F.vcu & 31) * 4 + i;
            mix::gmlp_item(idx >> 5, idx & 31, gg, PROJ, MIXB, F.lds + RING_OFF, gln_g, gln_b, g_bs); }
        GRID_BAR();
    }
    {
        pg8::Gemm g{MIXB, Wout_t, M, D, D}; pg8::StaticOrder S; S.init(M, D, F.G, (int)blockIdx.x);
        pg8::EpiRes E{x, out, MOD + 2 * D, NMOD * D, DN_ALPHA, D};
        pg8::gemm_phase<pg8::EpiRes, pg8::StaticOrder, true, true>(F.lds + RING_OFF, g, S, E);
        GRID_BAR();
    }
    F.refresh(); p5_ln(F, out, ln1_g, ln1_b, MOD, XN);
    GRID_BAR();
    {
        pg8::Gemm g{XN, W1_t, M, FF, D}; pg8::StaticOrder S; S.init(M, FF, F.G, (int)blockIdx.x);
        pg8::EpiRelu2 E{HID, FF};
        pg8::gemm_phase<pg8::EpiRelu2, pg8::StaticOrder, true, true>(F.lds + RING_OFF, g, S, E);
        GRID_BAR();
    }
    {
        pg8::Gemm g{HID, W2_t, M, D, FF}; pg8::StaticOrder S; S.init(M, D, F.G, (int)blockIdx.x);
        pg8::EpiRes E{out, out, MOD + 5 * D, NMOD * D, DN_ALPHA, D};
        pg8::gemm_phase<pg8::EpiRes, pg8::StaticOrder, true, true>(F.lds + RING_OFF, g, S, E);
        GRID_BAR();
    }
    F.refresh(); p8_ln(F, out, ln2_g, ln2_b);
#undef GRID_BAR
}

extern "C" void kernel_launch(void* const* d_in, const int* in_sizes, int n_in, void* d_out, int out_size, void* d_ws, size_t ws_size, hipStream_t stream) {
    static int grid = 0;
    if (grid == 0) {
        if (n_in != 21 || in_sizes[0] != M * D || out_size != M * D || ws_size < WS_END) { fprintf(stderr, "kernel_launch: built for 21 inputs, x and out of %d floats, >= %zu bytes of workspace; got n_in %d, in0 %d, out %d, ws %zu; nothing launched\n", M * D, (size_t)WS_END, n_in, n_in > 0 ? in_sizes[0] : -1, out_size, ws_size); grid = -1; return; }
        int dev = 0, cus = 0, per_cu = 0;
        if (hipGetDevice(&dev) != hipSuccess || hipDeviceGetAttribute(&cus, hipDeviceAttributeMultiprocessorCount, dev) != hipSuccess) { fprintf(stderr, "kernel_launch: hipGetDevice / hipDeviceGetAttribute failed\n"); grid = -1; return; }
        if (hipFuncSetAttribute((const void*)fwd_megakernel, hipFuncAttributeMaxDynamicSharedMemorySize, LDS_BYTES) != hipSuccess) { fprintf(stderr, "kernel_launch: hipFuncSetAttribute failed\n"); grid = -1; return; }
        if (hipOccupancyMaxActiveBlocksPerMultiprocessor(&per_cu, (const void*)fwd_megakernel, NWAVES * 64, LDS_BYTES) != hipSuccess || per_cu < 1)
            fprintf(stderr, "kernel_launch: note: the occupancy query reports %d workgroups per CU\n", per_cu);
        (void)hipGetLastError();
        grid = cus;
        if (grid != 256) fprintf(stderr, "kernel_launch: launching %d workgroups (built for 256 CUs)\n", grid);
    }
    if (grid < 0) return;
    if (hipMemsetAsync((char*)d_ws + WS_CTL, 0, CTL_ZERO_BYTES, stream) != hipSuccess) { fprintf(stderr, "kernel_launch: hipMemsetAsync of the control words failed\n"); return; }
    Args a{};
    for (int i = 0; i < 21; ++i) a.in[i] = (const float*)d_in[i];
    a.out = (float*)d_out; a.ws = (unsigned char*)d_ws;
    hipLaunchKernelGGL(fwd_megakernel, dim3(grid), dim3(NWAVES * 64), LDS_BYTES, stream, a);
    const hipError_t le = hipPeekAtLastError();
    if (le != hipSuccess) fprintf(stderr, "kernel_launch: launch failed: %s (grid %d x %d threads, %d B LDS)\n", hipGetErrorName(le), grid, NWAVES * 64, LDS_BYTES);
}
```

```cpp
#include <hip/hip_runtime.h>
#include <hip/hip_bf16.h>
#include <cstdio>
#include <cstdint>
#include <cmath>
__device__ __forceinline__ int fresh_tid() { int t = threadIdx.x; asm volatile("" : "+v"(t)); return t; }
namespace pg8 {
#define PG8_LAS __attribute__((address_space(3)))
typedef unsigned short bf16_t;
typedef short bf16x8 __attribute__((ext_vector_type(8)));
typedef float f32x4 __attribute__((ext_vector_type(4)));
typedef unsigned u32x4 __attribute__((ext_vector_type(4)));
constexpr int BM = 256, BK = 64, HALF = 128, HTB = HALF * BK * 2  , STAGE_BYTES = 8 * HTB, NXCD = 8, WGM = 8;

__host__ __device__ __forceinline__ int lds_byte(int r, int c) { const int st = (r >> 4) * 2 + (c >> 5), rr = r & 15, cc = c & 31, ob = rr * 64 + cc * 2; return st * 1024 + (ob ^ (((ob >> 9) & 1) << 5)); }
__host__ __device__ __forceinline__ void stage_rc(int b, int& R, int& C) { const int st = b / 1024, sb = b % 1024, swz = sb ^ (((sb >> 9) & 1) << 5); R = (st >> 1) * 16 + swz / 64; C = (st & 1) * 32 + (swz % 64) / 2; }
__host__ __device__ __forceinline__ int perm32(int rho) { const int n = rho >> 4, i = rho & 15; return 8 * (i >> 2) + 4 * n + (i & 3); }

struct Unit { int pm, pn; };
struct Gemm { const bf16_t* A; const bf16_t* Bt; int M, N, K; };

struct StaticOrder {
    int nM, nN, nwg, G, c;
    __host__ __device__ void init(int M, int N, int G_, int c_) { nM = M / BM; nN = N / BM; nwg = nM * nN; G = G_; c = c_; }
    __host__ __device__ bool next(int i, Unit& u) const {
        const long L = (long)i * G + c; if (L >= nwg) return false;
        int wgid = (int)L; { const int q = nwg / NXCD, r = nwg % NXCD, xcd = wgid % NXCD, off = wgid / NXCD; wgid = (xcd < r ? xcd * (q + 1) : r * (q + 1) + (xcd - r) * q) + off; }
        const int nig = WGM * nN, gid = wgid / nig, fm = gid * WGM, gsz = (nM - fm) < WGM ? (nM - fm) : WGM;
        u.pm = fm + ((wgid % nig) % gsz); u.pn = (wgid % nig) / gsz; return true;
    }
    __device__ __forceinline__ void a_ready(const Unit&) const {}
    __device__ __forceinline__ void done(const Unit&) const {}
};


typedef float f32x2 __attribute__((ext_vector_type(2)));
typedef __bf16 bf16x2_t __attribute__((ext_vector_type(2)));
__device__ __forceinline__ unsigned cvt_pk_bf16(float lo, float hi) { f32x2 v = {lo, hi}; bf16x2_t b = __builtin_convertvector(v, bf16x2_t); return __builtin_bit_cast(unsigned, b); }
__device__ __forceinline__ float gelu_tanh(float x) {
    const float c1 = 2.0f * 0.7978845608028654f * 1.4426950408889634f, c2 = c1 * 0.044715f;
    const float z2 = x * (c1 + c2 * x * x);
    const float e = __builtin_amdgcn_exp2f(-z2);
    return x * __builtin_amdgcn_rcpf(1.0f + e);
}
constexpr float ATT_C2 = 0.125f * 1.4426950408889634f;

struct EpiProj {
    static constexpr bool PERM = true, AFTER_DRAIN = false;
    bf16_t* O; int ldc;
    __device__ __forceinline__ void operator()(const f32x4 (&acc)[2][2][4][2], const Unit& u, int wr, int wc, int fr, int fq) const {
        const int row0 = u.pm * BM + wr * 64 + fr, col0 = u.pn * BM + wc * 32 + 8 * fq;
        const int mode = u.pn < 4 ? 0 : (u.pn < 12 ? 1 : 2);
#pragma unroll
        for (int ai = 0; ai < 2; ++ai)
#pragma unroll
            for (int m = 0; m < 4; ++m) { bf16_t* rowp = O + (size_t)(row0 + ai * HALF + m * 16) * ldc + col0;
#pragma unroll
                for (int bj = 0; bj < 2; ++bj) { f32x4 v0 = acc[ai][bj][m][0], v1 = acc[ai][bj][m][1];
                    if (mode == 0) { v0 = v0 * ATT_C2; v1 = v1 * ATT_C2; }
                    else if (mode == 2) {
#pragma unroll
                        for (int j = 0; j < 4; ++j) { v0[j] = gelu_tanh(v0[j]); v1[j] = gelu_tanh(v1[j]); } }
                    u32x4 w; w.x = cvt_pk_bf16(v0[0], v0[1]); w.y = cvt_pk_bf16(v0[2], v0[3]); w.z = cvt_pk_bf16(v1[0], v1[1]); w.w = cvt_pk_bf16(v1[2], v1[3]);
                    *(u32x4*)(rowp + bj * HALF) = w; } }
    }
};
struct EpiRelu2 {
    static constexpr bool PERM = true, AFTER_DRAIN = false;
    bf16_t* O; int ldc;
    __device__ __forceinline__ void operator()(const f32x4 (&acc)[2][2][4][2], const Unit& u, int wr, int wc, int fr, int fq) const {
        const int row0 = u.pm * BM + wr * 64 + fr, col0 = u.pn * BM + wc * 32 + 8 * fq;
#pragma unroll
        for (int ai = 0; ai < 2; ++ai)
#pragma unroll
            for (int m = 0; m < 4; ++m) { bf16_t* rowp = O + (size_t)(row0 + ai * HALF + m * 16) * ldc + col0;
#pragma unroll
                for (int bj = 0; bj < 2; ++bj) { f32x4 v0 = acc[ai][bj][m][0], v1 = acc[ai][bj][m][1];
#pragma unroll
                    for (int j = 0; j < 4; ++j) { const float a = __builtin_fmaxf(v0[j], 0.f), b = __builtin_fmaxf(v1[j], 0.f); v0[j] = a * a; v1[j] = b * b; }
                    u32x4 w; w.x = cvt_pk_bf16(v0[0], v0[1]); w.y = cvt_pk_bf16(v0[2], v0[3]); w.z = cvt_pk_bf16(v1[0], v1[1]); w.w = cvt_pk_bf16(v1[2], v1[3]);
                    *(u32x4*)(rowp + bj * HALF) = w; } }
    }
};
struct EpiGate {
    static constexpr bool PERM = true, AFTER_DRAIN = false;
    bf16_t* O; int ldc; const float* gate; int gate_stride;
    __device__ __forceinline__ void operator()(const f32x4 (&acc)[2][2][4][2], const Unit& u, int wr, int wc, int fr, int fq) const {
        const int row0 = u.pm * BM + wr * 64 + fr, col0 = u.pn * BM + wc * 32 + 8 * fq;
        const float* gp = gate + (size_t)(u.pm >> 4) * gate_stride + col0;
        f32x4 gv[2][2];
#pragma unroll
        for (int bj = 0; bj < 2; ++bj)
#pragma unroll
            for (int n = 0; n < 2; ++n) gv[bj][n] = *(const f32x4*)(gp + bj * HALF + n * 4) + 1.0f;
#pragma unroll
        for (int ai = 0; ai < 2; ++ai)
#pragma unroll
            for (int m = 0; m < 4; ++m) { bf16_t* rowp = O + (size_t)(row0 + ai * HALF + m * 16) * ldc + col0;
#pragma unroll
                for (int bj = 0; bj < 2; ++bj) { const f32x4 v0 = acc[ai][bj][m][0] * gv[bj][0], v1 = acc[ai][bj][m][1] * gv[bj][1];
                    u32x4 w; w.x = cvt_pk_bf16(v0[0], v0[1]); w.y = cvt_pk_bf16(v0[2], v0[3]); w.z = cvt_pk_bf16(v1[0], v1[1]); w.w = cvt_pk_bf16(v1[2], v1[3]);
                    *(u32x4*)(rowp + bj * HALF) = w; } }
    }
};
struct EpiRes {
    static constexpr bool PERM = false, AFTER_DRAIN = false;
    const float* base; float* out; const float* gate; int gate_stride; float alpha; int ldc;
    __device__ __forceinline__ void operator()(const f32x4 (&acc)[2][2][4][2], const Unit& u, int wr, int wc, int fr, int fq) const {
        const int row0 = u.pm * BM + wr * 64 + fr, col0 = u.pn * BM + wc * 32 + 4 * fq;
        const float* gp = gate + (size_t)(u.pm >> 4) * gate_stride + col0;
        f32x4 gv[2][2];
#pragma unroll
        for (int bj = 0; bj < 2; ++bj)
#pragma unroll
            for (int n = 0; n < 2; ++n) gv[bj][n] = *(const f32x4*)(gp + bj * HALF + n * 16) + 1.0f;
        f32x4 cur[2][2], nxt[2][2];
#pragma unroll
        for (int bj = 0; bj < 2; ++bj)
#pragma unroll
            for (int n = 0; n < 2; ++n) cur[bj][n] = *(const f32x4*)(base + (size_t)row0 * ldc + col0 + bj * HALF + n * 16);
#pragma unroll
        for (int idx = 0; idx < 8; ++idx) { const int ai = idx >> 2, m = idx & 3; const size_t off = (size_t)(row0 + ai * HALF + m * 16) * ldc + col0;
            if (idx + 1 < 8) { const size_t offn = (size_t)(row0 + ((idx + 1) >> 2) * HALF + ((idx + 1) & 3) * 16) * ldc + col0;
#pragma unroll
                for (int bj = 0; bj < 2; ++bj)
#pragma unroll
                    for (int n = 0; n < 2; ++n) nxt[bj][n] = *(const f32x4*)(base + offn + bj * HALF + n * 16); }
#pragma unroll
            for (int bj = 0; bj < 2; ++bj)
#pragma unroll
                for (int n = 0; n < 2; ++n) { *(f32x4*)(out + off + bj * HALF + n * 16) = cur[bj][n] * alpha + gv[bj][n] * acc[ai][bj][m][n]; cur[bj][n] = nxt[bj][n]; }
        }
    }
};

template <class Epi, class Sched, bool ALIGN_EPI = false, bool SP2 = false>
__device__ __forceinline__ void gemm_phase(PG8_LAS unsigned char* lds, const Gemm g, const Sched& S, const Epi& E) {
    const int tid = fresh_tid(), wid = __builtin_amdgcn_readfirstlane(tid >> 6), lane = tid & 63, wr = wid >> 2, wc = wid & 3, fr = lane & 15, fq = lane >> 4;
    const int K = g.K, nt = K / BK;
    unsigned voffA[2], voffB[2];
#pragma unroll
    for (int i = 0; i < 2; ++i) { int R, C; stage_rc(tid * 16 + i * 8192, R, C); const int Rb = Epi::PERM ? ((R & ~31) + perm32(R & 31)) : R;
        voffA[i] = (unsigned)(R * K + C) * 2u; voffB[i] = (unsigned)(Rb * K + C) * 2u; }
    const size_t kstep = (size_t)(BK * 2);
    const size_t hstep = (size_t)HALF * K * 2;
    const size_t tstep = 2 * hstep;
    const unsigned ldsw = (unsigned)wid * 1024u;
    const int aoff = lds_byte(wr * 64 + fr, fq * 8), boff = lds_byte(wc * 32 + fr, fq * 8);
#define PG8_SA(b, h) (((b) * 2 + (h)) * HTB)
#define PG8_SB(b, h) ((4 + (b) * 2 + (h)) * HTB)
#define PG8_STAGE(bufoff, gbase, voff) do { _Pragma("unroll") for (int _i = 0; _i < 2; ++_i) \
        __builtin_amdgcn_global_load_lds((const unsigned*)((const char*)(gbase) + (voff)[_i]), (PG8_LAS unsigned*)(lds + (bufoff) + ldsw + _i * 8192), 16, 0, 0); } while (0)
#define PG8_LDA(dst, b, h) do { _Pragma("unroll") for (int m = 0; m < 4; ++m) _Pragma("unroll") for (int k = 0; k < 2; ++k) dst[m][k] = *(const PG8_LAS bf16x8*)(lds + PG8_SA(b, h) + aoff + m * 2048 + k * 1024); } while (0)
#define PG8_LDB(dst, b, h) do { _Pragma("unroll") for (int n = 0; n < 2; ++n) _Pragma("unroll") for (int k = 0; k < 2; ++k) dst[n][k] = *(const PG8_LAS bf16x8*)(lds + PG8_SB(b, h) + boff + n * 2048 + k * 1024); } while (0)
#define PG8_MMA(ai, bj, At, Bt) do { __builtin_amdgcn_s_setprio(1); _Pragma("unroll") for (int m = 0; m < 4; ++m) _Pragma("unroll") for (int n = 0; n < 2; ++n) _Pragma("unroll") for (int k = 0; k < 2; ++k) \
        acc[ai][bj][m][n] = __builtin_amdgcn_mfma_f32_16x16x32_bf16(Bt[n][k], At[m][k], acc[ai][bj][m][n], 0, 0, 0); __builtin_amdgcn_s_setprio(0); } while (0)
#define PG8_WAIT_V(n) asm volatile("s_waitcnt vmcnt(" #n ")" ::: "memory")
#define PG8_WAIT_L(n) asm volatile("s_waitcnt lgkmcnt(" #n ")" ::: "memory")
#define PG8_BAR __builtin_amdgcn_s_barrier()
#define PG8_SCHED __builtin_amdgcn_sched_barrier(0)
    Unit cur, nxt; int ui = 0;
    if (!S.next(0, cur)) return;
    f32x4 acc[2][2][4][2];
#pragma unroll
    for (int a = 0; a < 2; ++a)
#pragma unroll
        for (int b = 0; b < 2; ++b)
#pragma unroll
            for (int m = 0; m < 4; ++m)
#pragma unroll
                for (int n = 0; n < 2; ++n) acc[a][b][m][n] = (f32x4){0.f, 0.f, 0.f, 0.f};
    bf16x8 At[4][2], B0[2][2], B1[2][2];
    const char* cA = (const char*)g.A + (size_t)cur.pm * tstep; const char* cB = (const char*)g.Bt + (size_t)cur.pn * tstep;
    S.a_ready(cur);
    if constexpr (SP2) {
        PG8_STAGE(PG8_SB(0, 0), cB, voffB); PG8_STAGE(PG8_SB(0, 1), cB + hstep, voffB); PG8_STAGE(PG8_SA(0, 0), cA, voffA); PG8_STAGE(PG8_SA(0, 1), cA + hstep, voffA);
        if (wr == 1) PG8_BAR;
        PG8_WAIT_V(2); PG8_BAR;
        PG8_STAGE(PG8_SB(1, 0), cB + kstep, voffB); PG8_STAGE(PG8_SA(1, 0), cA + kstep, voffA); PG8_STAGE(PG8_SB(1, 1), cB + hstep + kstep, voffB);
        PG8_WAIT_V(6); PG8_BAR;
    } else {
        PG8_STAGE(PG8_SB(0, 0), cB, voffB); PG8_STAGE(PG8_SA(0, 0), cA, voffA); PG8_STAGE(PG8_SB(0, 1), cB + hstep, voffB); PG8_STAGE(PG8_SA(0, 1), cA + hstep, voffA);
        if (wr == 1) PG8_BAR;
        PG8_WAIT_V(4); PG8_BAR;
        PG8_STAGE(PG8_SB(1, 0), cB + kstep, voffB); PG8_STAGE(PG8_SA(1, 0), cA + kstep, voffA); PG8_STAGE(PG8_SB(1, 1), cB + hstep + kstep, voffB);
        PG8_WAIT_V(6); PG8_BAR;
    }
    for (;;) {
        const bool has_next = S.next(ui + 1, nxt);
        const char* nA = has_next ? (const char*)g.A + (size_t)nxt.pm * tstep : cA; const char* nB = has_next ? (const char*)g.Bt + (size_t)nxt.pn * tstep : cB;
        for (int t = 0; t < nt; t += 2) {
            const bool last = (t == nt - 2);
            const char* a1 = cA + (size_t)(t + 1) * kstep;
            const char* a2 = last ? nA : cA + (size_t)(t + 2) * kstep; const char* b2 = last ? nB : cB + (size_t)(t + 2) * kstep;
            const char* a3 = a2 + kstep; const char* b3 = b2 + kstep;
            if (last && has_next) S.a_ready(nxt);
            if constexpr (SP2) {
            PG8_LDB(B0, 0, 0); PG8_LDB(B1, 0, 1); PG8_SCHED; PG8_LDA(At, 0, 0); PG8_STAGE(PG8_SA(1, 1), a1 + hstep, voffA);
            PG8_WAIT_V(8); PG8_WAIT_L(0); PG8_BAR; PG8_MMA(0, 0, At, B0); PG8_MMA(0, 1, At, B1); PG8_BAR; PG8_SCHED;
            PG8_LDA(At, 0, 1); PG8_STAGE(PG8_SB(0, 0), b2, voffB); PG8_STAGE(PG8_SB(0, 1), b2 + hstep, voffB); PG8_STAGE(PG8_SA(0, 0), a2, voffA);
            PG8_WAIT_V(8); PG8_WAIT_L(0); PG8_BAR; PG8_MMA(1, 0, At, B0); PG8_MMA(1, 1, At, B1); PG8_BAR; PG8_SCHED;
            PG8_LDB(B0, 1, 0); PG8_LDB(B1, 1, 1); PG8_SCHED; PG8_LDA(At, 1, 0); PG8_STAGE(PG8_SA(0, 1), a2 + hstep, voffA);
            PG8_WAIT_V(8); PG8_WAIT_L(0); PG8_BAR; PG8_MMA(0, 0, At, B0); PG8_MMA(0, 1, At, B1); PG8_BAR; PG8_SCHED;
            PG8_LDA(At, 1, 1); PG8_STAGE(PG8_SB(1, 0), b3, voffB); PG8_STAGE(PG8_SB(1, 1), b3 + hstep, voffB); PG8_STAGE(PG8_SA(1, 0), a3, voffA);
            PG8_WAIT_V(8); PG8_WAIT_L(0); PG8_BAR; PG8_MMA(1, 0, At, B0); PG8_MMA(1, 1, At, B1); PG8_BAR; PG8_SCHED;
            } else {
            PG8_LDB(B0, 0, 0); PG8_SCHED; PG8_LDA(At, 0, 0); PG8_STAGE(PG8_SA(1, 1), a1 + hstep, voffA);
            PG8_WAIT_L(8); PG8_BAR; PG8_WAIT_L(0); PG8_MMA(0, 0, At, B0); PG8_BAR; PG8_SCHED;
            PG8_LDB(B1, 0, 1); PG8_STAGE(PG8_SB(0, 0), b2, voffB);
            PG8_BAR; PG8_WAIT_L(0); PG8_MMA(0, 1, At, B1); PG8_BAR;
            PG8_LDA(At, 0, 1); PG8_STAGE(PG8_SA(0, 0), a2, voffA);
            PG8_BAR; PG8_WAIT_L(0); PG8_MMA(1, 0, At, B0); PG8_BAR; PG8_SCHED;
            PG8_STAGE(PG8_SB(0, 1), b2 + hstep, voffB);
            PG8_WAIT_V(6); PG8_BAR; PG8_MMA(1, 1, At, B1); PG8_BAR;
            PG8_LDB(B0, 1, 0); PG8_SCHED; PG8_LDA(At, 1, 0); PG8_STAGE(PG8_SA(0, 1), a2 + hstep, voffA);
            PG8_WAIT_L(8); PG8_BAR; PG8_WAIT_L(0); PG8_MMA(0, 0, At, B0); PG8_BAR; PG8_SCHED;
            PG8_LDB(B1, 1, 1); PG8_STAGE(PG8_SB(1, 0), b3, voffB);
            PG8_BAR; PG8_WAIT_L(0); PG8_MMA(0, 1, At, B1); PG8_BAR;
            PG8_LDA(At, 1, 1); PG8_STAGE(PG8_SA(1, 0), a3, voffA);
            PG8_BAR; PG8_WAIT_L(0); PG8_MMA(1, 0, At, B0); PG8_BAR; PG8_SCHED;
            PG8_STAGE(PG8_SB(1, 1), b3 + hstep, voffB);
            PG8_WAIT_V(6); PG8_BAR; PG8_MMA(1, 1, At, B1); PG8_BAR;
            }
        }
        if constexpr (ALIGN_EPI) { if (wr == 0) PG8_BAR; }
        if constexpr (!Epi::AFTER_DRAIN) { E(acc, cur, wr, wc, fr, fq); S.done(cur); }
        if (!has_next) break;
#pragma unroll
        for (int a = 0; a < 2; ++a)
#pragma unroll
            for (int b = 0; b < 2; ++b)
#pragma unroll
                for (int m = 0; m < 4; ++m)
#pragma unroll
                    for (int n = 0; n < 2; ++n) acc[a][b][m][n] = (f32x4){0.f, 0.f, 0.f, 0.f};
        cur = nxt; cA = nA; cB = nB; ++ui;
        if constexpr (ALIGN_EPI) { if (wr == 1) PG8_BAR; }
    }
    PG8_WAIT_V(0);
    if constexpr (!ALIGN_EPI) { if (wr == 0) PG8_BAR; }
    PG8_BAR;
    if constexpr (Epi::AFTER_DRAIN) { E.fused(acc, cur, wr, wc, fr, fq, lds, wid, lane); S.done(cur); }
#undef PG8_SA
#undef PG8_SB
#undef PG8_STAGE
#undef PG8_LDA
#undef PG8_LDB
#undef PG8_MMA
#undef PG8_WAIT_V
#undef PG8_WAIT_L
#undef PG8_BAR
#undef PG8_SCHED
}
}

#define LAS __attribute__((address_space(3)))
#define GAS __attribute__((address_space(1)))
namespace mix {
typedef unsigned short bf16;
typedef short bf16x8 __attribute__((ext_vector_type(8)));
typedef short s16x4 __attribute__((ext_vector_type(4)));
typedef short v4i16_t __attribute__((ext_vector_type(4)));
typedef float f32x16 __attribute__((ext_vector_type(16)));
typedef float f32x4 __attribute__((ext_vector_type(4)));
typedef unsigned u32x4 __attribute__((ext_vector_type(4)));
typedef LAS const char* lds_cptr;
constexpr int PITCH = 5120, SEQ = 4096, MIXP = 2048;
constexpr int COL_K = 1024, COL_V = 2048, COL_U = 3072, COL_G = 4096;
__device__ __forceinline__ int crow(int r, int hi) { return (r & 3) + 8 * (r >> 2) + 4 * hi; }
__device__ __forceinline__ unsigned cvtpk(float lo, float hi) { return pg8::cvt_pk_bf16(lo, hi); }
__device__ __forceinline__ float bf2f(unsigned short v) { return __uint_as_float((unsigned)v << 16); }
__device__ __forceinline__ void glds16(const void* gsrc, unsigned lds_dst) { unsigned keep;
    asm volatile("s_mov_b32 %0, m0\n\ts_mov_b32 m0, %2\n\ts_nop 0\n\tglobal_load_lds_dwordx4 %1, off\n\ts_mov_b32 m0, %0" : "=&s"(keep) : "v"(gsrc), "s"(lds_dst) : "memory"); }
__device__ __forceinline__ s16x4 vtr(lds_cptr p) { return __builtin_bit_cast(s16x4, __builtin_amdgcn_ds_read_tr16_b64_v4i16((LAS v4i16_t*)p)); }
#define MIX_MX3(a, b, c) __builtin_fmaxf(__builtin_fmaxf((a), (b)), (c))
__device__ __forceinline__ float rowmax(const f32x16& p0, const f32x16& p1) {
    float a = MIX_MX3(p0[0], p0[1], p1[0]), b = MIX_MX3(p0[2], p0[3], p1[1]); a = MIX_MX3(a, p1[2], p1[3]);
#pragma unroll
    for (int r = 4; r < 16; r += 4) { a = MIX_MX3(a, p0[r], p0[r + 1]); b = MIX_MX3(b, p0[r + 2], p0[r + 3]); a = MIX_MX3(a, p1[r], p1[r + 1]); b = MIX_MX3(b, p1[r + 2], p1[r + 3]); }
    float m = __builtin_fmaxf(a, b); auto rr = __builtin_amdgcn_permlane32_swap(__float_as_uint(m), __float_as_uint(m), false, false);
    return __builtin_fmaxf(__uint_as_float(rr[0]), __uint_as_float(rr[1])); }
#define MIX_MFMA(a, b, c) __builtin_amdgcn_mfma_f32_32x32x16_bf16(a, b, c, 0, 0, 0)

constexpr int SLOTB = 16384, A_LDS_K = 0, A_LDS_V = 2 * SLOTB;
__device__ __forceinline__ void attn_unit(int b, int h, int qb, const bf16* P, bf16* MIXO, LAS unsigned char* lds, LAS float* wsf_all, float lam, const float* subg) {
    const int tid = fresh_tid(), lane = tid & 63, r32 = lane & 31, hi = lane >> 5; const int wid = __builtin_amdgcn_readfirstlane(tid >> 6);
    const int c = wid >> 2, g = wid & 3;
    const long rowbase = (long)b * SEQ; const int q0 = qb * 128;
    const int NT = 2 * qb + 2, my_nt = 2 * qb + 1 + (g >> 1);
    const bf16* Qw = P + (rowbase + q0 + g * 32) * PITCH + h * 128 + c * 64;
    const bf16* Kh = P + rowbase * PITCH + COL_K + h * 128;
    const bf16* Vh = P + rowbase * PITCH + COL_V + h * 128;
    const unsigned lds0 = (unsigned)(uintptr_t)lds;
    LAS float* wsf = wsf_all + wid * 64;
    const bf16* ksrc = Kh + (long)lane * PITCH + wid * 8;
    const bf16* vsrc = Vh + (long)(16 * (wid & 3) + (lane >> 2)) * PITCH + (wid >> 2) * 32 + (lane & 3) * 8;
    const unsigned kdst = lds0 + A_LDS_K + wid * 1024, vdst = lds0 + A_LDS_V + wid * 1024;
#define DMA_T(t, slot) do { const bf16* ks_ = ksrc + (long)(t) * 64 * PITCH; const bf16* vs_ = vsrc + (long)(t) * 64 * PITCH; \
        glds16(ks_, (unsigned)__builtin_amdgcn_readfirstlane(kdst + (slot))); glds16(ks_ + 64, (unsigned)__builtin_amdgcn_readfirstlane(kdst + (slot) + 8192)); \
        glds16(vs_, (unsigned)__builtin_amdgcn_readfirstlane(vdst + (slot))); glds16(vs_ + 64, (unsigned)__builtin_amdgcn_readfirstlane(vdst + (slot) + 8192)); } while (0)
    DMA_T(0, 0);
    bf16x8 qr[4];
#pragma unroll
    for (int d0 = 0; d0 < 4; ++d0) qr[d0] = *reinterpret_cast<const bf16x8*>(Qw + (long)r32 * PITCH + d0 * 16 + hi * 8);
    float m_run = 0.f, l_run = 0.f;
    f32x16 o[4];
#pragma unroll
    for (int d0 = 0; d0 < 4; ++d0) o[d0] = f32x16{};
    const lds_cptr kp0 = (lds_cptr)lds + A_LDS_K + c * 8192 + hi * 1024 + r32 * 16;
    const lds_cptr vp0 = (lds_cptr)lds + A_LDS_V + ((lane >> 4) & 1) * 32 + (lane & 3) * 8 + (4 * hi + ((lane & 15) >> 2)) * 64;
    for (int t = 0; t < NT; ++t) {
        const int so = (t & 1) * SLOTB;
        if (t + 1 < NT) { DMA_T(t + 1, so ^ SLOTB); asm volatile("s_waitcnt vmcnt(4)" ::: "memory"); }
        else asm volatile("s_waitcnt vmcnt(0)" ::: "memory");
        asm volatile("s_barrier" ::: "memory");
        if (t < my_nt) {
            const lds_cptr kb = kp0 + so;
            f32x16 p0 = f32x16{}, p1 = f32x16{};
#pragma unroll
            for (int d0 = 0; d0 < 4; ++d0) {
                const bf16x8 b0 = *(const LAS bf16x8*)(kb + d0 * 2048), b1 = *(const LAS bf16x8*)(kb + d0 * 2048 + 512);
                p0 = MIX_MFMA(b0, qr[d0], p0); p1 = MIX_MFMA(b1, qr[d0], p1); }
            const float rm = rowmax(p0, p1);
            if (t == 0) m_run = rm;
            else if (__any(rm > m_run)) {
                const float mn = __builtin_fmaxf(m_run, rm), f = __builtin_amdgcn_exp2f(m_run - mn);
                l_run *= f; m_run = mn;
                if (hi == 0) wsf[r32] = f;
                asm volatile("s_waitcnt lgkmcnt(0)" ::: "memory");
#pragma unroll
                for (int r = 0; r < 16; ++r) { const float fr_ = wsf[crow(r, hi)];
#pragma unroll
                    for (int d0 = 0; d0 < 4; ++d0) o[d0][r] *= fr_; }
                asm volatile("s_waitcnt lgkmcnt(0)" ::: "memory");
            }
            float sacc = 0.f;
#pragma unroll
            for (int r = 0; r < 16; ++r) { p0[r] = __builtin_amdgcn_exp2f(p0[r] - m_run); p1[r] = __builtin_amdgcn_exp2f(p1[r] - m_run); sacc += p0[r] + p1[r]; }
            l_run += sacc;
            u32x4 pw[4];
            pw[0] = (u32x4){cvtpk(p0[0], p0[1]), cvtpk(p0[2], p0[3]), cvtpk(p0[4], p0[5]), cvtpk(p0[6], p0[7])};
            pw[1] = (u32x4){cvtpk(p0[8], p0[9]), cvtpk(p0[10], p0[11]), cvtpk(p0[12], p0[13]), cvtpk(p0[14], p0[15])};
            pw[2] = (u32x4){cvtpk(p1[0], p1[1]), cvtpk(p1[2], p1[3]), cvtpk(p1[4], p1[5]), cvtpk(p1[6], p1[7])};
            pw[3] = (u32x4){cvtpk(p1[8], p1[9]), cvtpk(p1[10], p1[11]), cvtpk(p1[12], p1[13]), cvtpk(p1[14], p1[15])};
            const lds_cptr vp = vp0 + so;
#pragma unroll
            for (int d0 = 0; d0 < 4; ++d0) {
#pragma unroll
                for (int ks = 0; ks < 4; ++ks) {
                    const s16x4 lo = vtr(vp + d0 * 4096 + ks * 1024), hh = vtr(vp + d0 * 4096 + ks * 1024 + 512);
                    const bf16x8 vf = (bf16x8){lo[0], lo[1], lo[2], lo[3], hh[0], hh[1], hh[2], hh[3]};
                    o[d0] = MIX_MFMA(__builtin_bit_cast(bf16x8, pw[ks]), vf, o[d0]); } }
        }
        asm volatile("s_waitcnt lgkmcnt(0)\n\ts_barrier" ::: "memory");
    }
#undef DMA_T
    { auto rr = __builtin_amdgcn_permlane32_swap(__float_as_uint(l_run), __float_as_uint(l_run), false, false); l_run = __uint_as_float(rr[0]) + __uint_as_float(rr[1]); }
    if (hi == 0) wsf[32 + r32] = l_run;
    asm volatile("s_waitcnt lgkmcnt(0)" ::: "memory");
    LAS float* stg = (LAS float*)lds;
#pragma unroll
    for (int r = 0; r < 16; ++r) { const int row = 32 * g + crow(r, hi); const float rl = __builtin_amdgcn_rcpf(wsf[32 + crow(r, hi)]);
#pragma unroll
        for (int d0 = 0; d0 < 4; ++d0) { const int e = 32 * d0 + r32; stg[((c * 128 + row) * 32 + ((e >> 2) ^ (row & 7))) * 4 + (e & 3)] = o[d0][r] * rl; } }
    asm volatile("s_waitcnt lgkmcnt(0)\n\ts_barrier" ::: "memory");
    {
        const int row = tid >> 2, qd = tid & 3;
        f32x4 a[8]; float ss = 0.f;
#pragma unroll
        for (int i = 0; i < 8; ++i) { const int ph = (row * 32 + ((8 * qd + i) ^ (row & 7))) * 4;
            const f32x4 v0 = *(const LAS f32x4*)(stg + ph), v1 = *(const LAS f32x4*)(stg + 128 * 128 + ph);
            a[i] = v0 - v1 * lam; ss += (a[i][0] * a[i][0] + a[i][1] * a[i][1]) + (a[i][2] * a[i][2] + a[i][3] * a[i][3]); }
        ss += __shfl_xor(ss, 1); ss += __shfl_xor(ss, 2);
        const float rs = 0.8f / sqrtf(ss * (1.0f / 128.0f) + 1e-5f);
        bf16* op = MIXO + (rowbase + q0 + row) * MIXP + h * 128 + 32 * qd;
        const float* gp = subg + 32 * qd;
#pragma unroll
        for (int i = 0; i < 8; i += 2) { const f32x4 g0 = *(const f32x4*)(gp + 4 * i), g1 = *(const f32x4*)(gp + 4 * i + 4);
            const f32x4 x0 = a[i] * g0 * rs, x1 = a[i + 1] * g1 * rs;
            u32x4 w; w.x = cvtpk(x0[0], x0[1]); w.y = cvtpk(x0[2], x0[3]); w.z = cvtpk(x1[0], x1[1]); w.w = cvtpk(x1[2], x1[3]);
            *(u32x4*)(op + 4 * i) = w; }
    }
    asm volatile("s_waitcnt lgkmcnt(0)\n\ts_barrier" ::: "memory");
}

constexpr int G_WM = 0, G_WMP = 136, G_VN = 36864;
__device__ __forceinline__ void gmlp_load_wm(const float* ws_g, LAS unsigned char* lds) {
    const int tid = fresh_tid(), t = tid >> 2, s0 = (tid & 3) * 32;
#pragma unroll
    for (int i = 0; i < 4; ++i) { const f32x4 a = *(const f32x4*)(ws_g + t * 128 + s0 + 8 * i), b = *(const f32x4*)(ws_g + t * 128 + s0 + 8 * i + 4);
        const bool keep = (t >> 6) >= ((s0 + 8 * i) >> 6);
        u32x4 w; w.x = cvtpk(a[0], a[1]); w.y = cvtpk(a[2], a[3]); w.z = cvtpk(b[0], b[1]); w.w = cvtpk(b[2], b[3]);
        if (!keep) w = (u32x4){0u, 0u, 0u, 0u};
        *(LAS u32x4*)(lds + G_WM + (t * G_WMP + s0 + 8 * i) * 2) = w; }
}
__device__ __forceinline__ void gmlp_item(int b, int nb, int g, const bf16* P, bf16* MIXO, LAS unsigned char* lds, const float* lng, const float* lnb, const float* bsg) {
    const int tid = fresh_tid(), lane = tid & 63, r32 = lane & 31, hi = lane >> 5; const int wid = __builtin_amdgcn_readfirstlane(tid >> 6);
    const long rowbase = (long)b * SEQ + nb * 128;
    {
        const int s = tid >> 2, qd = tid & 3;
        const bf16* vp = P + (rowbase + s) * PITCH + COL_G + g * 128 + qd * 32;
        float v[32]; float sum = 0.f;
#pragma unroll
        for (int i = 0; i < 4; ++i) { const u32x4 w = *(const u32x4*)(vp + 8 * i);
#pragma unroll
            for (int j = 0; j < 4; ++j) { v[8 * i + 2 * j] = __uint_as_float(w[j] << 16); v[8 * i + 2 * j + 1] = __uint_as_float(w[j] & 0xffff0000u); } }
#pragma unroll
        for (int i = 0; i < 32; ++i) sum += v[i];
        sum += __shfl_xor(sum, 1); sum += __shfl_xor(sum, 2);
        const float mean = sum * (1.0f / 128.0f); float sq = 0.f;
#pragma unroll
        for (int i = 0; i < 32; ++i) { v[i] -= mean; sq += v[i] * v[i]; }
        sq += __shfl_xor(sq, 1); sq += __shfl_xor(sq, 2);
        const float rstd = 1.0f / sqrtf(sq * (1.0f / 128.0f) + 1e-5f);
        const float* gg = lng + g * 128 + qd * 32; const float* gb = lnb + g * 128 + qd * 32;
        LAS unsigned char* dst = lds + G_VN + ((qd * 8 + (s >> 4)) * 16 + (s & 15)) * 64;
#pragma unroll
        for (int i = 0; i < 4; ++i) { float y[8];
#pragma unroll
            for (int j = 0; j < 8; ++j) y[j] = v[8 * i + j] * rstd * gg[8 * i + j] + gb[8 * i + j];
            u32x4 w; w.x = cvtpk(y[0], y[1]); w.y = cvtpk(y[2], y[3]); w.z = cvtpk(y[4], y[5]); w.w = cvtpk(y[6], y[7]);
            *(LAS u32x4*)(dst + 16 * i) = w; }
    }
    asm volatile("s_waitcnt lgkmcnt(0)" ::: "memory"); __builtin_amdgcn_s_barrier(); asm volatile("" ::: "memory");
    const int tm = wid >> 1;
    const lds_cptr ap = (lds_cptr)lds + G_WM + ((32 * tm + r32) * G_WMP + 8 * hi) * 2;
    const lds_cptr vb = (lds_cptr)lds + G_VN + (8 * hi + ((lane & 15) >> 2)) * 64 + ((lane >> 4) & 1) * 32 + (lane & 3) * 8;
#pragma unroll
    for (int dd = 0; dd < 2; ++dd) { const int dn = (wid & 1) * 2 + dd;
        f32x16 acc = f32x16{};
#pragma unroll
        for (int ks = 0; ks < 8; ++ks) {
            const bf16x8 af = *(const LAS bf16x8*)(ap + ks * 32);
            const s16x4 lo = vtr(vb + (dn * 8 + ks) * 1024), hh = vtr(vb + (dn * 8 + ks) * 1024 + 256);
            const bf16x8 vf = (bf16x8){lo[0], lo[1], lo[2], lo[3], hh[0], hh[1], hh[2], hh[3]};
            acc = MIX_MFMA(af, vf, acc); }
        const int d = 32 * dn + r32;
#pragma unroll
        for (int r = 0; r < 16; ++r) { const int t = 32 * tm + crow(r, hi);
            const float uu = bf2f(P[(rowbase + t) * PITCH + COL_U + g * 128 + d]);
            const float val = uu * (acc[r] + bsg[g * 128 + t]);
            MIXO[(rowbase + t) * MIXP + 1024 + g * 128 + d] = (bf16)(cvtpk(val, val) & 0xffffu); }
    }
    asm volatile("s_waitcnt lgkmcnt(0)" ::: "memory"); __builtin_amdgcn_s_barrier(); asm volatile("" ::: "memory");
}
}

constexpr int NWAVES = 8;
constexpr int BATCH = 4, SEQ = 4096, D = 2048, M = BATCH * SEQ, INW = 5120, FF = 8192, NMOD = 6;
constexpr float LN_EPS = 1e-5f;
constexpr float DN_ALPHA = 1.189207115002721f;
constexpr size_t MiB = 1u << 20;
constexpr size_t WS_CTL = 0, CTL_ZERO_BYTES = 64 * 1024;
constexpr size_t WS_MOD = 1 * MiB;
constexpr size_t WS_WIN = 2 * MiB, WS_WOUT = 22 * MiB, WS_W1 = 30 * MiB, WS_W2 = 62 * MiB;
constexpr size_t WS_XN = 94 * MiB;
constexpr size_t WS_PROJ = 158 * MiB;
constexpr size_t WS_MIX = 318 * MiB;
constexpr size_t WS_HID = 158 * MiB;
constexpr size_t WS_END = 414 * MiB;
static_assert(WS_WIN + (size_t)INW * D * 2 <= WS_WOUT && WS_WOUT + (size_t)D * D * 2 <= WS_W1 && WS_W1 + (size_t)FF * D * 2 <= WS_W2 && WS_W2 + (size_t)D * FF * 2 <= WS_XN &&
              WS_XN + (size_t)M * D * 2 <= WS_PROJ && WS_PROJ + (size_t)M * INW * 2 <= WS_MIX && WS_MIX + (size_t)M * D * 2 <= WS_END && WS_HID + (size_t)M * FF * 2 <= WS_END, "d_ws map");
constexpr int CW_BAR = 4096;
constexpr int RING_OFF = 0, RING_BYTES = 131072;
constexpr int LDSCTL_OFF = RING_BYTES, MISC_OFF = LDSCTL_OFF + 320;
constexpr int WSF_OFF = RING_BYTES + 1024;
constexpr int LDS_BYTES = 147456;
static_assert(MISC_OFF + 128 <= WSF_OFF && WSF_OFF + 2048 <= LDS_BYTES, "LDS map");

typedef unsigned short bf16;
typedef unsigned v4u __attribute__((ext_vector_type(4)));
typedef float f32x4 __attribute__((ext_vector_type(4)));
typedef GAS unsigned gu32;
#define RLX_AGENT __ATOMIC_RELAXED, __HIP_MEMORY_SCOPE_AGENT
#define LDS_WAIT() asm volatile("s_waitcnt lgkmcnt(0)" ::: "memory")
#define VM_WAIT() asm volatile("s_waitcnt vmcnt(0)" ::: "memory")
__device__ __forceinline__ unsigned pk2(float lo, float hi) { return pg8::cvt_pk_bf16(lo, hi); }

#define XB_TMO      128
#define XB_XCNT(j)  (256  + 64 * (j))
#define XB_XSUB(j)  (1280 + 64 * (j))
#define XB_XGEN(j)  (2304 + 64 * (j))
#define XB_TOP      3328
#define XB_TOPGEN   3392
#define XCD_BAR_WORDS 3456
#define XB_SPIN_CAP (1u << 18)

__device__ __forceinline__ unsigned xb_ld(unsigned* p)              { return __hip_atomic_load(p, __ATOMIC_RELAXED, __HIP_MEMORY_SCOPE_AGENT); }
__device__ __forceinline__ unsigned xb_add(unsigned* p, unsigned v) { return __hip_atomic_fetch_add(p, v, __ATOMIC_RELAXED, __HIP_MEMORY_SCOPE_AGENT); }
__device__ __forceinline__ unsigned xb_xcc_id() { return (unsigned)__builtin_amdgcn_s_getreg((3 << 11) | 20) & 0xFu; }
#define XB_SPIN(cond, bar) do { unsigned _sp = 0; while (cond) { __builtin_amdgcn_s_sleep(1); \
    if ((++_sp & 255u) == 0u) { if (xb_ld(&(bar)[XB_TMO])) break; if (_sp > XB_SPIN_CAP) { atomicAdd(&(bar)[XB_TMO], 1u); break; } } } } while (0)

struct XcdBarrier {
    unsigned* bar; unsigned x;
    volatile LAS unsigned* st;
};

__device__ __forceinline__ XcdBarrier xcd_barrier_post(unsigned* bar, volatile LAS unsigned* st) {
    XcdBarrier b; b.bar = bar; b.x = xb_xcc_id(); b.st = st;
    if (threadIdx.x == 0) (void)xb_add(&bar[XB_XCNT(b.x)], 1u);
    return b;
}
__device__ __forceinline__ void xcd_barrier_complete(unsigned* bar, unsigned x, unsigned& nloc, unsigned& nx) {
    const unsigned G = gridDim.x * gridDim.y * gridDim.z;
    unsigned sum, cnt, mine, sp = 0u;
    for (;;) {
        sum = 0u; cnt = 0u; mine = 0u;
#pragma unroll
        for (unsigned j = 0; j < 16; ++j) { const unsigned c = xb_ld(&bar[XB_XCNT(j)]); sum += c; cnt += (c > 0u) ? 1u : 0u; mine = (j == x) ? c : mine; }
        if (sum == G) break;
        __builtin_amdgcn_s_sleep(1);
        if ((++sp & 255u) == 0u) { if (xb_ld(&bar[XB_TMO])) break; if (sp > XB_SPIN_CAP) { atomicAdd(&bar[XB_TMO], 1u); break; } }
    }
    nloc = mine > 0u ? mine : 1u; nx = cnt > 0u ? cnt : 1u;
}

__device__ __forceinline__ void xcd_barrier(const XcdBarrier& b) {
    asm volatile("s_waitcnt vmcnt(0)" ::: "memory");
    __syncthreads();
    if (threadIdx.x == 0) {
        unsigned* bar = b.bar;
        __builtin_amdgcn_s_waitcnt(0);
        unsigned nloc = b.st[0], nx = b.st[1];
        if (nloc == 0u) { xcd_barrier_complete(bar, b.x, nloc, nx); b.st[0] = nloc; b.st[1] = nx; }
        const unsigned old = xb_add(&bar[XB_XSUB(b.x)], 1u);
        const unsigned gen = old / nloc;
        if (old + 1u == (gen + 1u) * nloc) {
            __builtin_amdgcn_fence(__ATOMIC_RELEASE, "agent");
            asm volatile("s_waitcnt vmcnt(0)" ::: "memory");
            const unsigned og = xb_add(&bar[XB_TOP], 1u);
            const unsigned tg = og / nx;
            if (og + 1u == (tg + 1u) * nx) xb_add(&bar[XB_TOPGEN], 1u);
            else XB_SPIN(xb_ld(&bar[XB_TOPGEN]) == tg, bar);
            __builtin_amdgcn_fence(__ATOMIC_ACQUIRE, "agent");
            xb_add(&bar[XB_XGEN(b.x)], 1u);
            asm volatile("s_waitcnt vmcnt(0)" ::: "memory");
        } else {
            XB_SPIN(xb_ld(&bar[XB_XGEN(b.x)]) == gen, bar);
            __builtin_amdgcn_fence(__ATOMIC_ACQUIRE, "agent");
            asm volatile("s_waitcnt vmcnt(0)" ::: "memory");
        }
    }
    __syncthreads();
}

struct Frame {
    LAS unsigned char* lds;
    volatile LAS unsigned* MISC;
    gu32* ctl;
    int tid, lane, wave;
    int vcu, G;
    __device__ __forceinline__ void refresh() { tid = fresh_tid(); lane = tid & 63; wave = __builtin_amdgcn_readfirstlane(tid >> 6); }
};
__device__ __forceinline__ float wave_sum(float v) {
#pragma unroll
    for (int o = 1; o < 64; o <<= 1) v += __shfl_xor(v, o);
    return v;
}
__device__ __forceinline__ void p0_transpose_item(const float* W, int K, int N, bf16* WT, LAS float* scr, int item, int lane) {
    const int nblk = N / 32, kb = item / nblk, nb = item % nblk, k0 = 64 * kb, n0 = 32 * nb;
#pragma unroll 8
    for (int i = 0; i < 32; ++i) { const int kk = 2 * i + (lane >> 5); scr[kk * 33 + (lane & 31)] = W[(size_t)(k0 + kk) * N + n0 + (lane & 31)]; }
    LDS_WAIT(); asm volatile("" ::: "memory");
    const int c = lane & 7;
#pragma unroll
    for (int j = 0; j < 4; ++j) { const int n = (lane >> 3) + 8 * j; const LAS float* s = scr + (8 * c) * 33 + n;
        v4u o; o.x = pk2(s[0 * 33], s[1 * 33]); o.y = pk2(s[2 * 33], s[3 * 33]); o.z = pk2(s[4 * 33], s[5 * 33]); o.w = pk2(s[6 * 33], s[7 * 33]);
        *(GAS v4u*)(WT + (size_t)(n0 + n) * K + k0 + 8 * c) = o; }
    LDS_WAIT(); asm volatile("" ::: "memory");
}
__device__ __forceinline__ void p0_mod(Frame& F, const float* cvec, const float* w_ada, const float* b_ada, float* mod) {
    LAS float* sc = (LAS float*)(F.lds + RING_OFF);
    LAS float* red = (LAS float*)(F.lds + RING_OFF + 32768);
    for (int i = F.tid; i < BATCH * D; i += NWAVES * 64) { const float v = cvec[i]; sc[i] = v / (1.0f + __expf(-v)); }
    LDS_WAIT(); __syncthreads();
    const int col = blockIdx.x * 64 + F.lane, kbase = F.wave * 256;
    const float* wp = w_ada + (size_t)kbase * (NMOD * D) + col;
    float a0 = 0.f, a1 = 0.f, a2 = 0.f, a3 = 0.f;
#pragma unroll 16
    for (int k = 0; k < 256; ++k) { const float w = wp[(size_t)k * (NMOD * D)];
        a0 += sc[kbase + k] * w; a1 += sc[D + kbase + k] * w; a2 += sc[2 * D + kbase + k] * w; a3 += sc[3 * D + kbase + k] * w; }
    red[(F.wave * 4 + 0) * 64 + F.lane] = a0; red[(F.wave * 4 + 1) * 64 + F.lane] = a1; red[(F.wave * 4 + 2) * 64 + F.lane] = a2; red[(F.wave * 4 + 3) * 64 + F.lane] = a3;
    LDS_WAIT(); __syncthreads();
    if (F.tid < 256) { const int b = F.tid >> 6, l = F.tid & 63; float s = 0.f;
#pragma unroll
        for (int w = 0; w < 8; ++w) s += red[(w * 4 + b) * 64 + l];
        mod[(size_t)b * (NMOD * D) + blockIdx.x * 64 + l] = s + b_ada[blockIdx.x * 64 + l]; }
    LDS_WAIT(); __syncthreads();
}
struct RowStats { float mean, rstd; };
__device__ __forceinline__ RowStats row_stats(f32x4 (&v)[8]) {
    float s = 0.f;
#pragma unroll
    for (int j = 0; j < 8; ++j) s += (v[j].x + v[j].y) + (v[j].z + v[j].w);
    const float mean = wave_sum(s) * (1.f / D); float s2 = 0.f;
#pragma unroll
    for (int j = 0; j < 8; ++j) { const f32x4 d = v[j] - mean; s2 += (d.x * d.x + d.y * d.y) + (d.z * d.z + d.w * d.w); }
    RowStats r; r.mean = mean; r.rstd = 1.f / sqrtf(wave_sum(s2) * (1.f / D) + LN_EPS); return r;
}
__device__ __forceinline__ void p1_xn(Frame& F, const float* x, const float* mod, bf16* XN) {
    const int gw = F.vcu * NWAVES + F.wave, NGW = F.G * NWAVES;
    for (int m = gw; m < M; m += NGW) {
        const GAS f32x4* xr = (const GAS f32x4*)(x + (size_t)m * D) + F.lane;
        const float* mb = mod + (size_t)(m >> 12) * (NMOD * D);
        f32x4 v[8];
#pragma unroll
        for (int j = 0; j < 8; ++j) v[j] = xr[64 * j];
        const RowStats st = row_stats(v);
        GAS unsigned long long* o8 = (GAS unsigned long long*)(XN + (size_t)m * D) + F.lane;
#pragma unroll
        for (int j = 0; j < 8; ++j) { const f32x4 sh = *((const f32x4*)(mb + 0 * D) + F.lane + 64 * j), sc = *((const f32x4*)(mb + 1 * D) + F.lane + 64 * j);
            const f32x4 y = (v[j] - st.mean) * st.rstd * (sc + 1.0f) + sh;
            o8[64 * j] = (unsigned long long)pk2(y.x, y.y) | ((unsigned long long)pk2(y.z, y.w) << 32); }
    }
}
__device__ __forceinline__ void add_bf16x4(f32x4& v, unsigned long long w, float alpha) {
    const unsigned lo = (unsigned)w, hi = (unsigned)(w >> 32);
    v.x = v.x * alpha + __uint_as_float(lo << 16); v.y = v.y * alpha + __uint_as_float(lo & 0xffff0000u);
    v.z = v.z * alpha + __uint_as_float(hi << 16); v.w = v.w * alpha + __uint_as_float(hi & 0xffff0000u);
}
__device__ __forceinline__ void p5_ln(Frame& F, const float* X, const bf16* G, float* H, const float* lg, const float* lb, const float* mod, bf16* XN) {
    const int gw = F.vcu * NWAVES + F.wave, NGW = F.G * NWAVES;
    for (int m = gw; m < M; m += NGW) {
        const GAS f32x4* xr = (const GAS f32x4*)(X + (size_t)m * D) + F.lane;
        const GAS unsigned long long* gr = (const GAS unsigned long long*)(G + (size_t)m * D) + F.lane;
        GAS f32x4* hr = (GAS f32x4*)(H + (size_t)m * D) + F.lane;
        const float* mb = mod + (size_t)(m >> 12) * (NMOD * D);
        f32x4 v[8]; unsigned long long gq[8];
#pragma unroll
        for (int j = 0; j < 8; ++j) { v[j] = xr[64 * j]; gq[j] = gr[64 * j]; }
#pragma unroll
        for (int j = 0; j < 8; ++j) add_bf16x4(v[j], gq[j], DN_ALPHA);
        const RowStats st = row_stats(v);
#pragma unroll
        for (int j = 0; j < 8; ++j) { const f32x4 g = *((const f32x4*)lg + F.lane + 64 * j), b = *((const f32x4*)lb + F.lane + 64 * j);
            v[j] = (v[j] - st.mean) * st.rstd * g + b; hr[64 * j] = v[j]; }
        const RowStats s2 = row_stats(v);
        GAS unsigned long long* o8 = (GAS unsigned long long*)(XN + (size_t)m * D) + F.lane;
#pragma unroll
        for (int j = 0; j < 8; ++j) { const f32x4 sh = *((const f32x4*)(mb + 3 * D) + F.lane + 64 * j), sc = *((const f32x4*)(mb + 4 * D) + F.lane + 64 * j);
            const f32x4 y = (v[j] - s2.mean) * s2.rstd * (sc + 1.0f) + sh;
            o8[64 * j] = (unsigned long long)pk2(y.x, y.y) | ((unsigned long long)pk2(y.z, y.w) << 32); }
    }
}
__device__ __forceinline__ void p8_ln(Frame& F, float* H, const bf16* G, const float* lg, const float* lb) {
    const int gw = F.vcu * NWAVES + F.wave, NGW = F.G * NWAVES;
    for (int m = gw; m < M; m += NGW) {
        GAS f32x4* yr = (GAS f32x4*)(H + (size_t)m * D) + F.lane;
        const GAS unsigned long long* gr = (const GAS unsigned long long*)(G + (size_t)m * D) + F.lane;
        f32x4 v[8]; unsigned long long gq[8];
#pragma unroll
        for (int j = 0; j < 8; ++j) { v[j] = yr[64 * j]; gq[j] = gr[64 * j]; }
#pragma unroll
        for (int j = 0; j < 8; ++j) add_bf16x4(v[j], gq[j], DN_ALPHA);
        const RowStats st = row_stats(v);
#pragma unroll
        for (int j = 0; j < 8; ++j) { const f32x4 g = *((const f32x4*)lg + F.lane + 64 * j), b = *((const f32x4*)lb + F.lane + 64 * j);
            yr[64 * j] = (v[j] - st.mean) * st.rstd * g + b; }
    }
}

#define REP_P0 1
#define REP_P1 1
#define REP_P2 1
#define REP_P3A 1
#define REP_P3G 1
#define REP_P4 1
#define REP_P6 1
#define REP_P7X 0
constexpr size_t WS_SCRATCH = 414 * MiB;
struct Args { const float* in[21]; float* out; unsigned char* ws; };
__global__ void __launch_bounds__(NWAVES * 64, 2) fwd_megakernel(Args args) {
    extern __shared__ __attribute__((aligned(16))) unsigned char lds[];
    Frame F;
    F.lds = (LAS unsigned char*)lds;
    F.MISC = (volatile LAS unsigned*)(F.lds + MISC_OFF);
    F.refresh();
    F.G = gridDim.x; { const int bx = blockIdx.x; F.vcu = (F.G % 8 == 0) ? (bx % 8) * (F.G / 8) + bx / 8 : bx; }
    unsigned char* ws = args.ws;
    F.ctl = (gu32*)(ws + WS_CTL);
    const float* x = args.in[0]; const float* cvec = args.in[1]; const float* w_ada = args.in[2]; const float* b_ada = args.in[3]; const float* w_in = args.in[4];
    const float* lq1 = args.in[5]; const float* lk1 = args.in[6]; const float* lq2 = args.in[7]; const float* lk2 = args.in[8]; const float* subg = args.in[9];
    const float* gln_g = args.in[10]; const float* gln_b = args.in[11]; const float* g_ws = args.in[12]; const float* g_bs = args.in[13]; const float* w_out = args.in[14];
    const float* ln1_g = args.in[15]; const float* ln1_b = args.in[16]; const float* w_ff1 = args.in[17]; const float* w_ff2 = args.in[18]; const float* ln2_g = args.in[19]; const float* ln2_b = args.in[20];
    float* out = args.out;
    float* MOD = (float*)(ws + WS_MOD);
    bf16* Win_t = (bf16*)(ws + WS_WIN); bf16* Wout_t = (bf16*)(ws + WS_WOUT); bf16* W1_t = (bf16*)(ws + WS_W1); bf16* W2_t = (bf16*)(ws + WS_W2);
    bf16* XN = (bf16*)(ws + WS_XN); bf16* PROJ = (bf16*)(ws + WS_PROJ); bf16* MIXB = (bf16*)(ws + WS_MIX); bf16* HID = (bf16*)(ws + WS_HID);
    bf16* GMIX = (bf16*)(ws + WS_PROJ);
    for (int u = F.tid; u < (LDS_BYTES - LDSCTL_OFF) / 4; u += NWAVES * 64) ((LAS unsigned*)(F.lds + LDSCTL_OFF))[u] = 0u;
    __syncthreads();
    XcdBarrier bar = xcd_barrier_post((unsigned*)(F.ctl + CW_BAR), F.MISC + 8);
#define GRID_BAR() xcd_barrier(bar)

    for (int rep = 0; rep < REP_P0; ++rep) {
        if (blockIdx.x < (NMOD * D) / 64) p0_mod(F, cvec, w_ada, b_ada, MOD);
        F.refresh();
        LAS float* scr = (LAS float*)(F.lds + RING_OFF + F.wave * 16384);
        const int gw = F.vcu * NWAVES + F.wave, NGW = F.G * NWAVES;
        constexpr int I_IN = (D / 64) * (INW / 32), I_O = (D / 64) * (D / 32), I_1 = (D / 64) * (FF / 32), I_2 = (FF / 64) * (D / 32);
        constexpr int NITEMS = I_IN + I_O + I_1 + I_2;
        for (int it = gw; it < NITEMS; it += NGW) {
            int r = it;
            if (r < I_IN) { p0_transpose_item(w_in, D, INW, Win_t, scr, r, F.lane); continue; } r -= I_IN;
            if (r < I_O) { p0_transpose_item(w_out, D, D, Wout_t, scr, r, F.lane); continue; } r -= I_O;
            if (r < I_1) { p0_transpose_item(w_ff1, D, FF, W1_t, scr, r, F.lane); continue; } r -= I_1;
            p0_transpose_item(w_ff2, FF, D, W2_t, scr, r, F.lane);
        }
        GRID_BAR();
    }
    for (int rep = 0; rep < REP_P1; ++rep) { F.refresh(); p1_xn(F, x, MOD, XN);
    GRID_BAR(); }
    for (int rep = 0; rep < REP_P2; ++rep) {
        pg8::Gemm g{XN, Win_t, M, INW, D}; pg8::StaticOrder S; S.init(M, INW, F.G, (int)blockIdx.x);
        pg8::EpiProj E{PROJ, INW};
        pg8::gemm_phase<pg8::EpiProj, pg8::StaticOrder, true, true>(F.lds + RING_OFF, g, S, E);
        GRID_BAR();
    }
    {
        F.refresh();
        float lam;
        { const float a = lq1[F.lane] * lk1[F.lane], b = lq2[F.lane] * lk2[F.lane];
          lam = __expf(wave_sum(a)) - __expf(wave_sum(b)) + 0.2f; }
        LAS float* wsf = (LAS float*)(F.lds + WSF_OFF);
        const int bh = F.vcu >> 3, s = F.vcu & 7;
        for (int rep = 0; rep < REP_P3A; ++rep)
        for (int i = 0; i < 4; ++i) { const int qb = (i == 0) ? s : (i == 1) ? 15 - s : (i == 2) ? 16 + s : 31 - s;
            mix::attn_unit(bh >> 3, bh & 7, qb, PROJ, MIXB, F.lds + RING_OFF, wsf, lam, subg); }
        const int gg = F.vcu >> 5;
        for (int rep = 0; rep < REP_P3G; ++rep) {
        mix::gmlp_load_wm(g_ws + (size_t)gg * 128 * 128, F.lds + RING_OFF);
        for (int i = 0; i < 4; ++i) { const int idx = (F.vcu & 31) * 4 + i;
            mix::gmlp_item(idx >> 5, idx & 31, gg, PROJ, MIXB, F.lds + RING_OFF, gln_g, gln_b, g_bs); } }
        GRID_BAR();
    }
    for (int rep = 0; rep < REP_P4; ++rep) {
        pg8::Gemm g{MIXB, Wout_t, M, D, D}; pg8::StaticOrder S; S.init(M, D, F.G, (int)blockIdx.x);
        pg8::EpiGate E{GMIX, D, MOD + 2 * D, NMOD * D};
        pg8::gemm_phase<pg8::EpiGate, pg8::StaticOrder, true, true>(F.lds + RING_OFF, g, S, E);
        GRID_BAR();
    }
    F.refresh(); p5_ln(F, x, GMIX, out, ln1_g, ln1_b, MOD, XN);
    GRID_BAR();
    for (int rep = 0; rep < REP_P6; ++rep) {
        pg8::Gemm g{XN, W1_t, M, FF, D}; pg8::StaticOrder S; S.init(M, FF, F.G, (int)blockIdx.x);
        pg8::EpiRelu2 E{HID, FF};
        pg8::gemm_phase<pg8::EpiRelu2, pg8::StaticOrder, true, true>(F.lds + RING_OFF, g, S, E);
        GRID_BAR();
    }
    for (int rep = 0; rep < REP_P7X; ++rep) {
        pg8::Gemm g{HID, W2_t, M, D, FF}; pg8::StaticOrder S; S.init(M, D, F.G, (int)blockIdx.x);
        pg8::EpiRelu2 E{(bf16*)(ws + WS_SCRATCH), D};
        pg8::gemm_phase<pg8::EpiRelu2, pg8::StaticOrder, true, true>(F.lds + RING_OFF, g, S, E);
        GRID_BAR();
    }
    {
        pg8::Gemm g{HID, W2_t, M, D, FF}; pg8::StaticOrder S; S.init(M, D, F.G, (int)blockIdx.x);
        pg8::EpiGate E{XN, D, MOD + 5 * D, NMOD * D};
        pg8::gemm_phase<pg8::EpiGate, pg8::StaticOrder, true, true>(F.lds + RING_OFF, g, S, E);
        GRID_BAR();
    }
    F.refresh(); p8_ln(F, out, XN, ln2_g, ln2_b);
#undef GRID_BAR
}

extern "C" void kernel_launch(void* const* d_in, const int* in_sizes, int n_in, void* d_out, int out_size, void* d_ws, size_t ws_size, hipStream_t stream) {
    static int grid = 0;
    if (grid == 0) {
        if (n_in != 21 || in_sizes[0] != M * D || out_size != M * D || ws_size < WS_END + 64 * MiB) { fprintf(stderr, "kernel_launch: built for 21 inputs, x and out of %d floats, >= %zu bytes of workspace; got n_in %d, in0 %d, out %d, ws %zu; nothing launched\n", M * D, (size_t)WS_END, n_in, n_in > 0 ? in_sizes[0] : -1, out_size, ws_size); grid = -1; return; }
        int dev = 0, cus = 0, per_cu = 0;
        if (hipGetDevice(&dev) != hipSuccess || hipDeviceGetAttribute(&cus, hipDeviceAttributeMultiprocessorCount, dev) != hipSuccess) { fprintf(stderr, "kernel_launch: hipGetDevice / hipDeviceGetAttribute failed\n"); grid = -1; return; }
        if (hipFuncSetAttribute((const void*)fwd_megakernel, hipFuncAttributeMaxDynamicSharedMemorySize, LDS_BYTES) != hipSuccess) { fprintf(stderr, "kernel_launch: hipFuncSetAttribute failed\n"); grid = -1; return; }
        if (hipOccupancyMaxActiveBlocksPerMultiprocessor(&per_cu, (const void*)fwd_megakernel, NWAVES * 64, LDS_BYTES) != hipSuccess || per_cu < 1)
            fprintf(stderr, "kernel_launch: note: the occupancy query reports %d workgroups per CU\n", per_cu);
        (void)hipGetLastError();
        grid = cus;
        if (grid != 256) fprintf(stderr, "kernel_launch: launching %d workgroups (built for 256 CUs)\n", grid);
    }
    if (grid < 0) return;
    if (hipMemsetAsync((char*)d_ws + WS_CTL, 0, CTL_ZERO_BYTES, stream) != hipSuccess) { fprintf(stderr, "kernel_launch: hipMemsetAsync of the control words failed\n"); return; }
    Args a{};
    for (int i = 0; i < 21; ++i) a.in[i] = (const float*)d_in[i];
    a.out = (float*)d_out; a.ws = (unsigned char*)d_ws;
    hipLaunchKernelGGL(fwd_megakernel, dim3(grid), dim3(NWAVES * 64), LDS_BYTES, stream, a);
    const hipError_t le = hipPeekAtLastError();
    if (le != hipSuccess) fprintf(stderr, "kernel_launch: launch failed: %s (grid %d x %d threads, %d B LDS)\n", hipGetErrorName(le), grid, NWAVES * 64, LDS_BYTES);
}
```

```cpp
#include <hip/hip_runtime.h>
#include <hip/hip_bf16.h>
#include <cstdio>
#include <cstdint>
#include <cmath>
__device__ __forceinline__ int fresh_tid() { int t = threadIdx.x; asm volatile("" : "+v"(t)); return t; }
namespace pg8 {
#define PG8_LAS __attribute__((address_space(3)))
typedef unsigned short bf16_t;
typedef short bf16x8 __attribute__((ext_vector_type(8)));
typedef float f32x4 __attribute__((ext_vector_type(4)));
typedef unsigned u32x4 __attribute__((ext_vector_type(4)));
constexpr int BM = 256, BK = 64, HALF = 128, HTB = HALF * BK * 2  , STAGE_BYTES = 8 * HTB, NXCD = 8, WGM = 8;

__host__ __device__ __forceinline__ int lds_byte(int r, int c) { const int st = (r >> 4) * 2 + (c >> 5), rr = r & 15, cc = c & 31, ob = rr * 64 + cc * 2; return st * 1024 + (ob ^ (((ob >> 9) & 1) << 5)); }
__host__ __device__ __forceinline__ void stage_rc(int b, int& R, int& C) { const int st = b / 1024, sb = b % 1024, swz = sb ^ (((sb >> 9) & 1) << 5); R = (st >> 1) * 16 + swz / 64; C = (st & 1) * 32 + (swz % 64) / 2; }
__host__ __device__ __forceinline__ int perm32(int rho) { const int n = rho >> 4, i = rho & 15; return 8 * (i >> 2) + 4 * n + (i & 3); }

struct Unit { int pm, pn; };
struct Gemm { const bf16_t* A; const bf16_t* Bt; int M, N, K; };

struct StaticOrder {
    int nM, nN, nwg, G, c;
    __host__ __device__ void init(int M, int N, int G_, int c_) { nM = M / BM; nN = N / BM; nwg = nM * nN; G = G_; c = c_; }
    __host__ __device__ bool next(int i, Unit& u) const {
        const long L = (long)i * G + c; if (L >= nwg) return false;
        int wgid = (int)L; { const int q = nwg / NXCD, r = nwg % NXCD, xcd = wgid % NXCD, off = wgid / NXCD; wgid = (xcd < r ? xcd * (q + 1) : r * (q + 1) + (xcd - r) * q) + off; }
        const int nig = WGM * nN, gid = wgid / nig, fm = gid * WGM, gsz = (nM - fm) < WGM ? (nM - fm) : WGM;
        u.pm = fm + ((wgid % nig) % gsz); u.pn = (wgid % nig) / gsz; return true;
    }
    __device__ __forceinline__ void a_ready(const Unit&) const {}
    __device__ __forceinline__ void done(const Unit&) const {}
};


typedef float f32x2 __attribute__((ext_vector_type(2)));
typedef __bf16 bf16x2_t __attribute__((ext_vector_type(2)));
__device__ __forceinline__ unsigned cvt_pk_bf16(float lo, float hi) { f32x2 v = {lo, hi}; bf16x2_t b = __builtin_convertvector(v, bf16x2_t); return __builtin_bit_cast(unsigned, b); }
__device__ __forceinline__ float gelu_tanh(float x) {
    const float c1 = 2.0f * 0.7978845608028654f * 1.4426950408889634f, c2 = c1 * 0.044715f;
    const float z2 = x * (c1 + c2 * x * x);
    const float e = __builtin_amdgcn_exp2f(-z2);
    return x * __builtin_amdgcn_rcpf(1.0f + e);
}
constexpr float ATT_C2 = 0.125f * 1.4426950408889634f;

struct EpiProj {
    static constexpr bool PERM = true, AFTER_DRAIN = false;
    bf16_t* O; int ldc;
    __device__ __forceinline__ void operator()(const f32x4 (&acc)[2][2][4][2], const Unit& u, int wr, int wc, int fr, int fq) const {
        const int row0 = u.pm * BM + wr * 64 + fr, col0 = u.pn * BM + wc * 32 + 8 * fq;
        const int mode = u.pn < 4 ? 0 : (u.pn < 12 ? 1 : 2);
#pragma unroll
        for (int ai = 0; ai < 2; ++ai)
#pragma unroll
            for (int m = 0; m < 4; ++m) { bf16_t* rowp = O + (size_t)(row0 + ai * HALF + m * 16) * ldc + col0;
#pragma unroll
                for (int bj = 0; bj < 2; ++bj) { f32x4 v0 = acc[ai][bj][m][0], v1 = acc[ai][bj][m][1];
                    if (mode == 0) { v0 = v0 * ATT_C2; v1 = v1 * ATT_C2; }
                    else if (mode == 2) {
#pragma unroll
                        for (int j = 0; j < 4; ++j) { v0[j] = gelu_tanh(v0[j]); v1[j] = gelu_tanh(v1[j]); } }
                    u32x4 w; w.x = cvt_pk_bf16(v0[0], v0[1]); w.y = cvt_pk_bf16(v0[2], v0[3]); w.z = cvt_pk_bf16(v1[0], v1[1]); w.w = cvt_pk_bf16(v1[2], v1[3]);
                    *(u32x4*)(rowp + bj * HALF) = w; } }
    }
};
struct EpiRelu2 {
    static constexpr bool PERM = true, AFTER_DRAIN = false;
    bf16_t* O; int ldc;
    __device__ __forceinline__ void operator()(const f32x4 (&acc)[2][2][4][2], const Unit& u, int wr, int wc, int fr, int fq) const {
        const int row0 = u.pm * BM + wr * 64 + fr, col0 = u.pn * BM + wc * 32 + 8 * fq;
#pragma unroll
        for (int ai = 0; ai < 2; ++ai)
#pragma unroll
            for (int m = 0; m < 4; ++m) { bf16_t* rowp = O + (size_t)(row0 + ai * HALF + m * 16) * ldc + col0;
#pragma unroll
                for (int bj = 0; bj < 2; ++bj) { f32x4 v0 = acc[ai][bj][m][0], v1 = acc[ai][bj][m][1];
#pragma unroll
                    for (int j = 0; j < 4; ++j) { const float a = __builtin_fmaxf(v0[j], 0.f), b = __builtin_fmaxf(v1[j], 0.f); v0[j] = a * a; v1[j] = b * b; }
                    u32x4 w; w.x = cvt_pk_bf16(v0[0], v0[1]); w.y = cvt_pk_bf16(v0[2], v0[3]); w.z = cvt_pk_bf16(v1[0], v1[1]); w.w = cvt_pk_bf16(v1[2], v1[3]);
                    *(u32x4*)(rowp + bj * HALF) = w; } }
    }
};
struct EpiGate {
    static constexpr bool PERM = true, AFTER_DRAIN = false;
    bf16_t* O; int ldc; const float* gate; int gate_stride;
    __device__ __forceinline__ void operator()(const f32x4 (&acc)[2][2][4][2], const Unit& u, int wr, int wc, int fr, int fq) const {
        const int row0 = u.pm * BM + wr * 64 + fr, col0 = u.pn * BM + wc * 32 + 8 * fq;
        const float* gp = gate + (size_t)(u.pm >> 4) * gate_stride + col0;
        f32x4 gv[2][2];
#pragma unroll
        for (int bj = 0; bj < 2; ++bj)
#pragma unroll
            for (int n = 0; n < 2; ++n) gv[bj][n] = *(const f32x4*)(gp + bj * HALF + n * 4) + 1.0f;
#pragma unroll
        for (int ai = 0; ai < 2; ++ai)
#pragma unroll
            for (int m = 0; m < 4; ++m) { bf16_t* rowp = O + (size_t)(row0 + ai * HALF + m * 16) * ldc + col0;
#pragma unroll
                for (int bj = 0; bj < 2; ++bj) { const f32x4 v0 = acc[ai][bj][m][0] * gv[bj][0], v1 = acc[ai][bj][m][1] * gv[bj][1];
                    u32x4 w; w.x = cvt_pk_bf16(v0[0], v0[1]); w.y = cvt_pk_bf16(v0[2], v0[3]); w.z = cvt_pk_bf16(v1[0], v1[1]); w.w = cvt_pk_bf16(v1[2], v1[3]);
                    *(u32x4*)(rowp + bj * HALF) = w; } }
    }
};
struct EpiRes {
    static constexpr bool PERM = false, AFTER_DRAIN = false;
    const float* base; float* out; const float* gate; int gate_stride; float alpha; int ldc;
    __device__ __forceinline__ void operator()(const f32x4 (&acc)[2][2][4][2], const Unit& u, int wr, int wc, int fr, int fq) const {
        const int row0 = u.pm * BM + wr * 64 + fr, col0 = u.pn * BM + wc * 32 + 4 * fq;
        const float* gp = gate + (size_t)(u.pm >> 4) * gate_stride + col0;
        f32x4 gv[2][2];
#pragma unroll
        for (int bj = 0; bj < 2; ++bj)
#pragma unroll
            for (int n = 0; n < 2; ++n) gv[bj][n] = *(const f32x4*)(gp + bj * HALF + n * 16) + 1.0f;
        f32x4 cur[2][2], nxt[2][2];
#pragma unroll
        for (int bj = 0; bj < 2; ++bj)
#pragma unroll
            for (int n = 0; n < 2; ++n) cur[bj][n] = *(const f32x4*)(base + (size_t)row0 * ldc + col0 + bj * HALF + n * 16);
#pragma unroll
        for (int idx = 0; idx < 8; ++idx) { const int ai = idx >> 2, m = idx & 3; const size_t off = (size_t)(row0 + ai * HALF + m * 16) * ldc + col0;
            if (idx + 1 < 8) { const size_t offn = (size_t)(row0 + ((idx + 1) >> 2) * HALF + ((idx + 1) & 3) * 16) * ldc + col0;
#pragma unroll
                for (int bj = 0; bj < 2; ++bj)
#pragma unroll
                    for (int n = 0; n < 2; ++n) nxt[bj][n] = *(const f32x4*)(base + offn + bj * HALF + n * 16); }
#pragma unroll
            for (int bj = 0; bj < 2; ++bj)
#pragma unroll
                for (int n = 0; n < 2; ++n) { *(f32x4*)(out + off + bj * HALF + n * 16) = cur[bj][n] * alpha + gv[bj][n] * acc[ai][bj][m][n]; cur[bj][n] = nxt[bj][n]; }
        }
    }
};

template <class Epi, class Sched, bool ALIGN_EPI = false, bool SP2 = false>
__device__ __forceinline__ void gemm_phase(PG8_LAS unsigned char* lds, const Gemm g, const Sched& S, const Epi& E) {
    const int tid = fresh_tid(), wid = __builtin_amdgcn_readfirstlane(tid >> 6), lane = tid & 63, wr = wid >> 2, wc = wid & 3, fr = lane & 15, fq = lane >> 4;
    const int K = g.K, nt = K / BK;
    unsigned voffA[2], voffB[2];
#pragma unroll
    for (int i = 0; i < 2; ++i) { int R, C; stage_rc(tid * 16 + i * 8192, R, C); const int Rb = Epi::PERM ? ((R & ~31) + perm32(R & 31)) : R;
        voffA[i] = (unsigned)(R * K + C) * 2u; voffB[i] = (unsigned)(Rb * K + C) * 2u; }
    const size_t kstep = (size_t)(BK * 2);
    const size_t hstep = (size_t)HALF * K * 2;
    const size_t tstep = 2 * hstep;
    const unsigned ldsw = (unsigned)wid * 1024u;
    const int aoff = lds_byte(wr * 64 + fr, fq * 8), boff = lds_byte(wc * 32 + fr, fq * 8);
#define PG8_SA(b, h) (((b) * 2 + (h)) * HTB)
#define PG8_SB(b, h) ((4 + (b) * 2 + (h)) * HTB)
#define PG8_STAGE(bufoff, gbase, voff) do { _Pragma("unroll") for (int _i = 0; _i < 2; ++_i) \
        __builtin_amdgcn_global_load_lds((const unsigned*)((const char*)(gbase) + (voff)[_i]), (PG8_LAS unsigned*)(lds + (bufoff) + ldsw + _i * 8192), 16, 0, 0); } while (0)
#define PG8_LDA(dst, b, h) do { _Pragma("unroll") for (int m = 0; m < 4; ++m) _Pragma("unroll") for (int k = 0; k < 2; ++k) dst[m][k] = *(const PG8_LAS bf16x8*)(lds + PG8_SA(b, h) + aoff + m * 2048 + k * 1024); } while (0)
#define PG8_LDB(dst, b, h) do { _Pragma("unroll") for (int n = 0; n < 2; ++n) _Pragma("unroll") for (int k = 0; k < 2; ++k) dst[n][k] = *(const PG8_LAS bf16x8*)(lds + PG8_SB(b, h) + boff + n * 2048 + k * 1024); } while (0)
#define PG8_MMA(ai, bj, At, Bt) do { __builtin_amdgcn_s_setprio(1); _Pragma("unroll") for (int m = 0; m < 4; ++m) _Pragma("unroll") for (int n = 0; n < 2; ++n) _Pragma("unroll") for (int k = 0; k < 2; ++k) \
        acc[ai][bj][m][n] = __builtin_amdgcn_mfma_f32_16x16x32_bf16(Bt[n][k], At[m][k], acc[ai][bj][m][n], 0, 0, 0); __builtin_amdgcn_s_setprio(0); } while (0)
#define PG8_WAIT_V(n) asm volatile("s_waitcnt vmcnt(" #n ")" ::: "memory")
#define PG8_WAIT_L(n) asm volatile("s_waitcnt lgkmcnt(" #n ")" ::: "memory")
#define PG8_BAR __builtin_amdgcn_s_barrier()
#define PG8_SCHED __builtin_amdgcn_sched_barrier(0)
    Unit cur, nxt; int ui = 0;
    if (!S.next(0, cur)) return;
    f32x4 acc[2][2][4][2];
#pragma unroll
    for (int a = 0; a < 2; ++a)
#pragma unroll
        for (int b = 0; b < 2; ++b)
#pragma unroll
            for (int m = 0; m < 4; ++m)
#pragma unroll
                for (int n = 0; n < 2; ++n) acc[a][b][m][n] = (f32x4){0.f, 0.f, 0.f, 0.f};
    bf16x8 At[4][2], B0[2][2], B1[2][2];
    const char* cA = (const char*)g.A + (size_t)cur.pm * tstep; const char* cB = (const char*)g.Bt + (size_t)cur.pn * tstep;
    S.a_ready(cur);
    if constexpr (SP2) {
        PG8_STAGE(PG8_SB(0, 0), cB, voffB); PG8_STAGE(PG8_SB(0, 1), cB + hstep, voffB); PG8_STAGE(PG8_SA(0, 0), cA, voffA); PG8_STAGE(PG8_SA(0, 1), cA + hstep, voffA);
        if (wr == 1) PG8_BAR;
        PG8_WAIT_V(2); PG8_BAR;
        PG8_STAGE(PG8_SB(1, 0), cB + kstep, voffB); PG8_STAGE(PG8_SA(1, 0), cA + kstep, voffA); PG8_STAGE(PG8_SB(1, 1), cB + hstep + kstep, voffB);
        PG8_WAIT_V(6); PG8_BAR;
    } else {
        PG8_STAGE(PG8_SB(0, 0), cB, voffB); PG8_STAGE(PG8_SA(0, 0), cA, voffA); PG8_STAGE(PG8_SB(0, 1), cB + hstep, voffB); PG8_STAGE(PG8_SA(0, 1), cA + hstep, voffA);
        if (wr == 1) PG8_BAR;
        PG8_WAIT_V(4); PG8_BAR;
        PG8_STAGE(PG8_SB(1, 0), cB + kstep, voffB); PG8_STAGE(PG8_SA(1, 0), cA + kstep, voffA); PG8_STAGE(PG8_SB(1, 1), cB + hstep + kstep, voffB);
        PG8_WAIT_V(6); PG8_BAR;
    }
    for (;;) {
        const bool has_next = S.next(ui + 1, nxt);
        const char* nA = has_next ? (const char*)g.A + (size_t)nxt.pm * tstep : cA; const char* nB = has_next ? (const char*)g.Bt + (size_t)nxt.pn * tstep : cB;
        for (int t = 0; t < nt; t += 2) {
            const bool last = (t == nt - 2);
            const char* a1 = cA + (size_t)(t + 1) * kstep;
            const char* a2 = last ? nA : cA + (size_t)(t + 2) * kstep; const char* b2 = last ? nB : cB + (size_t)(t + 2) * kstep;
            const char* a3 = a2 + kstep; const char* b3 = b2 + kstep;
            if (last && has_next) S.a_ready(nxt);
            if constexpr (SP2) {
            PG8_LDB(B0, 0, 0); PG8_LDB(B1, 0, 1); PG8_SCHED; PG8_LDA(At, 0, 0); PG8_STAGE(PG8_SA(1, 1), a1 + hstep, voffA);
            PG8_WAIT_V(8); PG8_WAIT_L(0); PG8_BAR; PG8_MMA(0, 0, At, B0); PG8_MMA(0, 1, At, B1); PG8_BAR; PG8_SCHED;
            PG8_LDA(At, 0, 1); PG8_STAGE(PG8_SB(0, 0), b2, voffB); PG8_STAGE(PG8_SB(0, 1), b2 + hstep, voffB); PG8_STAGE(PG8_SA(0, 0), a2, voffA);
            PG8_WAIT_V(8); PG8_WAIT_L(0); PG8_BAR; PG8_MMA(1, 0, At, B0); PG8_MMA(1, 1, At, B1); PG8_BAR; PG8_SCHED;
            PG8_LDB(B0, 1, 0); PG8_LDB(B1, 1, 1); PG8_SCHED; PG8_LDA(At, 1, 0); PG8_STAGE(PG8_SA(0, 1), a2 + hstep, voffA);
            PG8_WAIT_V(8); PG8_WAIT_L(0); PG8_BAR; PG8_MMA(0, 0, At, B0); PG8_MMA(0, 1, At, B1); PG8_BAR; PG8_SCHED;
            PG8_LDA(At, 1, 1); PG8_STAGE(PG8_SB(1, 0), b3, voffB); PG8_STAGE(PG8_SB(1, 1), b3 + hstep, voffB); PG8_STAGE(PG8_SA(1, 0), a3, voffA);
            PG8_WAIT_V(8); PG8_WAIT_L(0); PG8_BAR; PG8_MMA(1, 0, At, B0); PG8_MMA(1, 1, At, B1); PG8_BAR; PG8_SCHED;
            } else {
            PG8_LDB(B0, 0, 0); PG8_SCHED; PG8_LDA(At, 0, 0); PG8_STAGE(PG8_SA(1, 1), a1 + hstep, voffA);
            PG8_WAIT_L(8); PG8_BAR; PG8_WAIT_L(0); PG8_MMA(0, 0, At, B0); PG8_BAR; PG8_SCHED;
            PG8_LDB(B1, 0, 1); PG8_STAGE(PG8_SB(0, 0), b2, voffB);
            PG8_BAR; PG8_WAIT_L(0); PG8_MMA(0, 1, At, B1); PG8_BAR;
            PG8_LDA(At, 0, 1); PG8_STAGE(PG8_SA(0, 0), a2, voffA);
            PG8_BAR; PG8_WAIT_L(0); PG8_MMA(1, 0, At, B0); PG8_BAR; PG8_SCHED;
            PG8_STAGE(PG8_SB(0, 1), b2 + hstep, voffB);
            PG8_WAIT_V(6); PG8_BAR; PG8_MMA(1, 1, At, B1); PG8_BAR;
            PG8_LDB(B0, 1, 0); PG8_SCHED; PG8_LDA(At, 1, 0); PG8_STAGE(PG8_SA(0, 1), a2 + hstep, voffA);
            PG8_WAIT_L(8); PG8_BAR; PG8_WAIT_L(0); PG8_MMA(0, 0, At, B0); PG8_BAR; PG8_SCHED;
            PG8_LDB(B1, 1, 1); PG8_STAGE(PG8_SB(1, 0), b3, voffB);
            PG8_BAR; PG8_WAIT_L(0); PG8_MMA(0, 1, At, B1); PG8_BAR;
            PG8_LDA(At, 1, 1); PG8_STAGE(PG8_SA(1, 0), a3, voffA);
            PG8_BAR; PG8_WAIT_L(0); PG8_MMA(1, 0, At, B0); PG8_BAR; PG8_SCHED;
            PG8_STAGE(PG8_SB(1, 1), b3 + hstep, voffB);
            PG8_WAIT_V(6); PG8_BAR; PG8_MMA(1, 1, At, B1); PG8_BAR;
            }
        }
        if constexpr (ALIGN_EPI) { if (wr == 0) PG8_BAR; }
        if constexpr (!Epi::AFTER_DRAIN) { E(acc, cur, wr, wc, fr, fq); S.done(cur); }
        if (!has_next) break;
#pragma unroll
        for (int a = 0; a < 2; ++a)
#pragma unroll
            for (int b = 0; b < 2; ++b)
#pragma unroll
                for (int m = 0; m < 4; ++m)
#pragma unroll
                    for (int n = 0; n < 2; ++n) acc[a][b][m][n] = (f32x4){0.f, 0.f, 0.f, 0.f};
        cur = nxt; cA = nA; cB = nB; ++ui;
        if constexpr (ALIGN_EPI) { if (wr == 1) PG8_BAR; }
    }
    PG8_WAIT_V(0);
    if constexpr (!ALIGN_EPI) { if (wr == 0) PG8_BAR; }
    PG8_BAR;
    if constexpr (Epi::AFTER_DRAIN) { E.fused(acc, cur, wr, wc, fr, fq, lds, wid, lane); S.done(cur); }
#undef PG8_SA
#undef PG8_SB
#undef PG8_STAGE
#undef PG8_LDA
#undef PG8_LDB
#undef PG8_MMA
#undef PG8_WAIT_V
#undef PG8_WAIT_L
#undef PG8_BAR
#undef PG8_SCHED
}
}

#define LAS __attribute__((address_space(3)))
#define GAS __attribute__((address_space(1)))
namespace mix {
typedef unsigned short bf16;
typedef short bf16x8 __attribute__((ext_vector_type(8)));
typedef short s16x4 __attribute__((ext_vector_type(4)));
typedef short v4i16_t __attribute__((ext_vector_type(4)));
typedef float f32x16 __attribute__((ext_vector_type(16)));
typedef float f32x4 __attribute__((ext_vector_type(4)));
typedef unsigned u32x4 __attribute__((ext_vector_type(4)));
typedef LAS const char* lds_cptr;
constexpr int PITCH = 5120, SEQ = 4096, MIXP = 2048;
constexpr int COL_K = 1024, COL_V = 2048, COL_U = 3072, COL_G = 4096;
__device__ __forceinline__ int crow(int r, int hi) { return (r & 3) + 8 * (r >> 2) + 4 * hi; }
__device__ __forceinline__ unsigned cvtpk(float lo, float hi) { return pg8::cvt_pk_bf16(lo, hi); }
__device__ __forceinline__ float bf2f(unsigned short v) { return __uint_as_float((unsigned)v << 16); }
__device__ __forceinline__ void glds16(const void* gsrc, unsigned lds_dst) { unsigned keep;
    asm volatile("s_mov_b32 %0, m0\n\ts_mov_b32 m0, %2\n\ts_nop 0\n\tglobal_load_lds_dwordx4 %1, off\n\ts_mov_b32 m0, %0" : "=&s"(keep) : "v"(gsrc), "s"(lds_dst) : "memory"); }
__device__ __forceinline__ s16x4 vtr(lds_cptr p) { return __builtin_bit_cast(s16x4, __builtin_amdgcn_ds_read_tr16_b64_v4i16((LAS v4i16_t*)p)); }
#define MIX_MX3(a, b, c) __builtin_fmaxf(__builtin_fmaxf((a), (b)), (c))
__device__ __forceinline__ float rowmax(const f32x16& p0, const f32x16& p1) {
    float a = MIX_MX3(p0[0], p0[1], p1[0]), b = MIX_MX3(p0[2], p0[3], p1[1]); a = MIX_MX3(a, p1[2], p1[3]);
#pragma unroll
    for (int r = 4; r < 16; r += 4) { a = MIX_MX3(a, p0[r], p0[r + 1]); b = MIX_MX3(b, p0[r + 2], p0[r + 3]); a = MIX_MX3(a, p1[r], p1[r + 1]); b = MIX_MX3(b, p1[r + 2], p1[r + 3]); }
    float m = __builtin_fmaxf(a, b); auto rr = __builtin_amdgcn_permlane32_swap(__float_as_uint(m), __float_as_uint(m), false, false);
    return __builtin_fmaxf(__uint_as_float(rr[0]), __uint_as_float(rr[1])); }
#define MIX_MFMA(a, b, c) __builtin_amdgcn_mfma_f32_32x32x16_bf16(a, b, c, 0, 0, 0)

constexpr int SLOTB = 16384, A_NSLOT = 3, A_LDS_K = 0, A_LDS_V = A_NSLOT * SLOTB;
#define MIX_SBAR() __builtin_amdgcn_sched_barrier(0)
#define ATT_DUP_DMA 0
#define ATT_DUP_VREAD 0
#define ATT_DUP_QK 0
#define ATT_DUP_EXP 0
__device__ __forceinline__ void attn_unit(int b, int h, int qb, const bf16* P, bf16* MIXO, LAS unsigned char* lds, LAS float* wsf_all, float lam, const float* subg) {
    const int tid = fresh_tid(), lane = tid & 63, r32 = lane & 31, hi = lane >> 5; const int wid = __builtin_amdgcn_readfirstlane(tid >> 6);
    const int c = wid >> 2, g = wid & 3;
    const long rowbase = (long)b * SEQ; const int q0 = qb * 128;
    const int NT = 2 * qb + 2, my_nt = 2 * qb + 1 + (g >> 1);
    const bf16* Qw = P + (rowbase + q0 + g * 32) * PITCH + h * 128 + c * 64;
    const bf16* Kh = P + rowbase * PITCH + COL_K + h * 128;
    const bf16* Vh = P + rowbase * PITCH + COL_V + h * 128;
    const unsigned lds0 = (unsigned)(uintptr_t)lds;
    LAS float* wsf = wsf_all + wid * 64;
    const bf16* ksrc = Kh + (long)(8 * wid + (lane >> 3)) * PITCH + (((lane & 7) ^ ((4 * (wid & 1) + (lane >> 4)) & 7)) * 8);
    const bf16* vsrc = Vh + (long)(16 * (wid & 3) + (lane >> 2)) * PITCH + (wid >> 2) * 32 + (lane & 3) * 8;
    const unsigned kdst = lds0 + A_LDS_K + wid * 1024, vdst = lds0 + A_LDS_V + wid * 1024;
#define DMA_T(t, slot) do { const bf16* ks_ = ksrc + (long)(t) * 64 * PITCH; const bf16* vs_ = vsrc + (long)(t) * 64 * PITCH; \
        glds16(ks_, (unsigned)__builtin_amdgcn_readfirstlane(kdst + (slot))); glds16(ks_ + 64, (unsigned)__builtin_amdgcn_readfirstlane(kdst + (slot) + 8192)); \
        glds16(vs_, (unsigned)__builtin_amdgcn_readfirstlane(vdst + (slot))); glds16(vs_ + 64, (unsigned)__builtin_amdgcn_readfirstlane(vdst + (slot) + 8192)); } while (0)
    DMA_T(0, 0); DMA_T(1, SLOTB);
    bf16x8 qr[4];
#pragma unroll
    for (int d0 = 0; d0 < 4; ++d0) qr[d0] = *reinterpret_cast<const bf16x8*>(Qw + (long)r32 * PITCH + d0 * 16 + hi * 8);
    float m_run = 0.f, l_run = 0.f;
    f32x16 o[4];
#pragma unroll
    for (int d0 = 0; d0 < 4; ++d0) o[d0] = f32x16{};
    const lds_cptr kpr = (lds_cptr)lds + A_LDS_K + c * 8192 + r32 * 128;
    const int ksw = (r32 >> 1) & 7;
    const int kq0 = ((0 + hi) ^ ksw) * 16, kq1 = ((2 + hi) ^ ksw) * 16, kq2 = ((4 + hi) ^ ksw) * 16, kq3 = ((6 + hi) ^ ksw) * 16;
    const lds_cptr vp0 = (lds_cptr)lds + A_LDS_V + ((lane >> 4) & 1) * 32 + (lane & 3) * 8 + (4 * hi + ((lane & 15) >> 2)) * 64;
    bf16x8 kf[8];
#define KLOAD1(so_, d0_, kq_) do { kf[2 * (d0_)] = *(const LAS bf16x8*)(kpr + (so_) + (kq_)); kf[2 * (d0_) + 1] = *(const LAS bf16x8*)(kpr + (so_) + (kq_) + 4096); } while (0)
#define KLOAD(so_) do { KLOAD1(so_, 0, kq0); KLOAD1(so_, 1, kq1); KLOAD1(so_, 2, kq2); KLOAD1(so_, 3, kq3); } while (0)
#define VFRAG(dst, vp_, d0_, ks_) do { const s16x4 lo_ = vtr((vp_) + (d0_) * 4096 + (ks_) * 1024), hh_ = vtr((vp_) + (d0_) * 4096 + (ks_) * 1024 + 512); \
        dst = (bf16x8){lo_[0], lo_[1], lo_[2], lo_[3], hh_[0], hh_[1], hh_[2], hh_[3]}; } while (0)
    int so = 0, so1 = SLOTB, so2 = 2 * SLOTB;
    for (int t = 0; t < NT; ++t) {
        asm volatile("s_waitcnt vmcnt(0) lgkmcnt(0)\n\ts_barrier" ::: "memory");
        if (t + 2 < NT) { DMA_T(t + 2, so2); if (ATT_DUP_DMA) DMA_T(t + 2, so2); }
        if (t == 0) KLOAD(0);
        if (t < my_nt) {
            f32x16 p0 = f32x16{}, p1 = f32x16{};
            MIX_SBAR();
#pragma unroll
            for (int d0 = 0; d0 < 4; ++d0) { p0 = MIX_MFMA(kf[2 * d0], qr[d0], p0); p1 = MIX_MFMA(kf[2 * d0 + 1], qr[d0], p1); }
            if (ATT_DUP_QK) { f32x16 q0 = f32x16{}, q1 = f32x16{};
#pragma unroll
                for (int d0 = 0; d0 < 4; ++d0) { q0 = MIX_MFMA(kf[2 * d0], qr[d0], q0); q1 = MIX_MFMA(kf[2 * d0 + 1], qr[d0], q1); }
                asm volatile("" :: "v"(q0), "v"(q1)); }
            MIX_SBAR();
            const lds_cptr vp = vp0 + so;
            bf16x8 va[8], vb[8];
#pragma unroll
            for (int i = 0; i < 8; ++i) VFRAG(va[i], vp, i >> 2, i & 3);
            if (ATT_DUP_VREAD) { bf16x8 vd[8];
#pragma unroll
                for (int i = 0; i < 8; ++i) { VFRAG(vd[i], vp, 2 + (i >> 2), i & 3); asm volatile("" :: "v"(vd[i])); }
#pragma unroll
                for (int i = 0; i < 8; ++i) { VFRAG(vd[i], vp, i >> 2, i & 3); asm volatile("" :: "v"(vd[i])); } }
            MIX_SBAR();
            const float rm = rowmax(p0, p1);
            if (t == 0) m_run = rm;
            else if (__any(rm > m_run)) {
                const float mn = __builtin_fmaxf(m_run, rm), f = __builtin_amdgcn_exp2f(m_run - mn);
                l_run *= f; m_run = mn;
                if (hi == 0) wsf[r32] = f;
                asm volatile("s_waitcnt lgkmcnt(0)" ::: "memory");
#pragma unroll
                for (int r = 0; r < 16; ++r) { const float fr_ = wsf[crow(r, hi)];
#pragma unroll
                    for (int d0 = 0; d0 < 4; ++d0) o[d0][r] *= fr_; }
                asm volatile("s_waitcnt lgkmcnt(0)" ::: "memory");
            }
            float sacc = 0.f;
#pragma unroll
            for (int r = 0; r < 16; ++r) { if (ATT_DUP_EXP) { float e0 = __builtin_amdgcn_exp2f(p0[r] - m_run - 1.0f), e1 = __builtin_amdgcn_exp2f(p1[r] - m_run - 1.0f); asm volatile("" :: "v"(e0), "v"(e1)); }
                p0[r] = __builtin_amdgcn_exp2f(p0[r] - m_run); p1[r] = __builtin_amdgcn_exp2f(p1[r] - m_run); sacc += p0[r] + p1[r]; }
            l_run += sacc;
            u32x4 pw[4];
            pw[0] = (u32x4){cvtpk(p0[0], p0[1]), cvtpk(p0[2], p0[3]), cvtpk(p0[4], p0[5]), cvtpk(p0[6], p0[7])};
            pw[1] = (u32x4){cvtpk(p0[8], p0[9]), cvtpk(p0[10], p0[11]), cvtpk(p0[12], p0[13]), cvtpk(p0[14], p0[15])};
            pw[2] = (u32x4){cvtpk(p1[0], p1[1]), cvtpk(p1[2], p1[3]), cvtpk(p1[4], p1[5]), cvtpk(p1[6], p1[7])};
            pw[3] = (u32x4){cvtpk(p1[8], p1[9]), cvtpk(p1[10], p1[11]), cvtpk(p1[12], p1[13]), cvtpk(p1[14], p1[15])};
            MIX_SBAR();
#pragma unroll
            for (int i = 0; i < 8; ++i) VFRAG(vb[i], vp, 2 + (i >> 2), i & 3);
            MIX_SBAR();
#pragma unroll
            for (int i = 0; i < 8; ++i) o[i >> 2] = MIX_MFMA(__builtin_bit_cast(bf16x8, pw[i & 3]), va[i], o[i >> 2]);
            MIX_SBAR();
            if (t + 1 < NT) KLOAD(so1);
            MIX_SBAR();
#pragma unroll
            for (int i = 0; i < 8; ++i) o[2 + (i >> 2)] = MIX_MFMA(__builtin_bit_cast(bf16x8, pw[i & 3]), vb[i], o[2 + (i >> 2)]);
            MIX_SBAR();
        }
        { const int s_ = so; so = so1; so1 = so2; so2 = s_; }
    }
#undef DMA_T
#undef KLOAD
#undef VFRAG
    asm volatile("s_waitcnt vmcnt(0) lgkmcnt(0)\n\ts_barrier" ::: "memory");
    { auto rr = __builtin_amdgcn_permlane32_swap(__float_as_uint(l_run), __float_as_uint(l_run), false, false); l_run = __uint_as_float(rr[0]) + __uint_as_float(rr[1]); }
    if (hi == 0) wsf[32 + r32] = l_run;
    asm volatile("s_waitcnt lgkmcnt(0)" ::: "memory");
    LAS float* stg = (LAS float*)lds;
#pragma unroll
    for (int r = 0; r < 16; ++r) { const int row = 32 * g + crow(r, hi); const float rl = __builtin_amdgcn_rcpf(wsf[32 + crow(r, hi)]);
#pragma unroll
        for (int d0 = 0; d0 < 4; ++d0) { const int e = 32 * d0 + r32; stg[((c * 128 + row) * 32 + ((e >> 2) ^ (row & 7))) * 4 + (e & 3)] = o[d0][r] * rl; } }
    asm volatile("s_waitcnt lgkmcnt(0)\n\ts_barrier" ::: "memory");
    {
        const int row = tid >> 2, qd = tid & 3;
        f32x4 a[8]; float ss = 0.f;
#pragma unroll
        for (int i = 0; i < 8; ++i) { const int ph = (row * 32 + ((8 * qd + i) ^ (row & 7))) * 4;
            const f32x4 v0 = *(const LAS f32x4*)(stg + ph), v1 = *(const LAS f32x4*)(stg + 128 * 128 + ph);
            a[i] = v0 - v1 * lam; ss += (a[i][0] * a[i][0] + a[i][1] * a[i][1]) + (a[i][2] * a[i][2] + a[i][3] * a[i][3]); }
        ss += __shfl_xor(ss, 1); ss += __shfl_xor(ss, 2);
        const float rs = 0.8f / sqrtf(ss * (1.0f / 128.0f) + 1e-5f);
        bf16* op = MIXO + (rowbase + q0 + row) * MIXP + h * 128 + 32 * qd;
        const float* gp = subg + 32 * qd;
#pragma unroll
        for (int i = 0; i < 8; i += 2) { const f32x4 g0 = *(const f32x4*)(gp + 4 * i), g1 = *(const f32x4*)(gp + 4 * i + 4);
            const f32x4 x0 = a[i] * g0 * rs, x1 = a[i + 1] * g1 * rs;
            u32x4 w; w.x = cvtpk(x0[0], x0[1]); w.y = cvtpk(x0[2], x0[3]); w.z = cvtpk(x1[0], x1[1]); w.w = cvtpk(x1[2], x1[3]);
            *(u32x4*)(op + 4 * i) = w; }
    }
    asm volatile("s_waitcnt lgkmcnt(0)\n\ts_barrier" ::: "memory");
}

constexpr int G_WM = 0, G_WMP = 136, G_VN = 36864;
__device__ __forceinline__ void gmlp_load_wm(const float* ws_g, LAS unsigned char* lds) {
    const int tid = fresh_tid(), t = tid >> 2, s0 = (tid & 3) * 32;
#pragma unroll
    for (int i = 0; i < 4; ++i) { const f32x4 a = *(const f32x4*)(ws_g + t * 128 + s0 + 8 * i), b = *(const f32x4*)(ws_g + t * 128 + s0 + 8 * i + 4);
        const bool keep = (t >> 6) >= ((s0 + 8 * i) >> 6);
        u32x4 w; w.x = cvtpk(a[0], a[1]); w.y = cvtpk(a[2], a[3]); w.z = cvtpk(b[0], b[1]); w.w = cvtpk(b[2], b[3]);
        if (!keep) w = (u32x4){0u, 0u, 0u, 0u};
        *(LAS u32x4*)(lds + G_WM + (t * G_WMP + s0 + 8 * i) * 2) = w; }
}
__device__ __forceinline__ void gmlp_item(int b, int nb, int g, const bf16* P, bf16* MIXO, LAS unsigned char* lds, const float* lng, const float* lnb, const float* bsg) {
    const int tid = fresh_tid(), lane = tid & 63, r32 = lane & 31, hi = lane >> 5; const int wid = __builtin_amdgcn_readfirstlane(tid >> 6);
    const long rowbase = (long)b * SEQ + nb * 128;
    {
        const int s = tid >> 2, qd = tid & 3;
        const bf16* vp = P + (rowbase + s) * PITCH + COL_G + g * 128 + qd * 32;
        float v[32]; float sum = 0.f;
#pragma unroll
        for (int i = 0; i < 4; ++i) { const u32x4 w = *(const u32x4*)(vp + 8 * i);
#pragma unroll
            for (int j = 0; j < 4; ++j) { v[8 * i + 2 * j] = __uint_as_float(w[j] << 16); v[8 * i + 2 * j + 1] = __uint_as_float(w[j] & 0xffff0000u); } }
#pragma unroll
        for (int i = 0; i < 32; ++i) sum += v[i];
        sum += __shfl_xor(sum, 1); sum += __shfl_xor(sum, 2);
        const float mean = sum * (1.0f / 128.0f); float sq = 0.f;
#pragma unroll
        for (int i = 0; i < 32; ++i) { v[i] -= mean; sq += v[i] * v[i]; }
        sq += __shfl_xor(sq, 1); sq += __shfl_xor(sq, 2);
        const float rstd = 1.0f / sqrtf(sq * (1.0f / 128.0f) + 1e-5f);
        const float* gg = lng + g * 128 + qd * 32; const float* gb = lnb + g * 128 + qd * 32;
        LAS unsigned char* dst = lds + G_VN + ((qd * 8 + (s >> 4)) * 16 + (s & 15)) * 64;
#pragma unroll
        for (int i = 0; i < 4; ++i) { float y[8];
#pragma unroll
            for (int j = 0; j < 8; ++j) y[j] = v[8 * i + j] * rstd * gg[8 * i + j] + gb[8 * i + j];
            u32x4 w; w.x = cvtpk(y[0], y[1]); w.y = cvtpk(y[2], y[3]); w.z = cvtpk(y[4], y[5]); w.w = cvtpk(y[6], y[7]);
            *(LAS u32x4*)(dst + 16 * i) = w; }
    }
    asm volatile("s_waitcnt lgkmcnt(0)" ::: "memory"); __builtin_amdgcn_s_barrier(); asm volatile("" ::: "memory");
    const int tm = wid >> 1;
    const lds_cptr ap = (lds_cptr)lds + G_WM + ((32 * tm + r32) * G_WMP + 8 * hi) * 2;
    const lds_cptr vb = (lds_cptr)lds + G_VN + (8 * hi + ((lane & 15) >> 2)) * 64 + ((lane >> 4) & 1) * 32 + (lane & 3) * 8;
#pragma unroll
    for (int dd = 0; dd < 2; ++dd) { const int dn = (wid & 1) * 2 + dd;
        f32x16 acc = f32x16{};
#pragma unroll
        for (int ks = 0; ks < 8; ++ks) {
            const bf16x8 af = *(const LAS bf16x8*)(ap + ks * 32);
            const s16x4 lo = vtr(vb + (dn * 8 + ks) * 1024), hh = vtr(vb + (dn * 8 + ks) * 1024 + 256);
            const bf16x8 vf = (bf16x8){lo[0], lo[1], lo[2], lo[3], hh[0], hh[1], hh[2], hh[3]};
            acc = MIX_MFMA(af, vf, acc); }
        const int d = 32 * dn + r32;
#pragma unroll
        for (int r = 0; r < 16; ++r) { const int t = 32 * tm + crow(r, hi);
            const float uu = bf2f(P[(rowbase + t) * PITCH + COL_U + g * 128 + d]);
            const float val = uu * (acc[r] + bsg[g * 128 + t]);
            MIXO[(rowbase + t) * MIXP + 1024 + g * 128 + d] = (bf16)(cvtpk(val, val) & 0xffffu); }
    }
    asm volatile("s_waitcnt lgkmcnt(0)" ::: "memory"); __builtin_amdgcn_s_barrier(); asm volatile("" ::: "memory");
}
}

constexpr int NWAVES = 8;
constexpr int BATCH = 4, SEQ = 4096, D = 2048, M = BATCH * SEQ, INW = 5120, FF = 8192, NMOD = 6;
constexpr float LN_EPS = 1e-5f;
constexpr float DN_ALPHA = 1.189207115002721f;
constexpr size_t MiB = 1u << 20;
constexpr size_t WS_CTL = 0, CTL_ZERO_BYTES = 64 * 1024;
constexpr size_t WS_MOD = 1 * MiB;
constexpr size_t WS_WIN = 2 * MiB, WS_WOUT = 22 * MiB, WS_W1 = 30 * MiB, WS_W2 = 62 * MiB;
constexpr size_t WS_XN = 94 * MiB;
constexpr size_t WS_PROJ = 158 * MiB;
constexpr size_t WS_MIX = 318 * MiB;
constexpr size_t WS_HID = 158 * MiB;
constexpr size_t WS_END = 414 * MiB;
static_assert(WS_WIN + (size_t)INW * D * 2 <= WS_WOUT && WS_WOUT + (size_t)D * D * 2 <= WS_W1 && WS_W1 + (size_t)FF * D * 2 <= WS_W2 && WS_W2 + (size_t)D * FF * 2 <= WS_XN &&
              WS_XN + (size_t)M * D * 2 <= WS_PROJ && WS_PROJ + (size_t)M * INW * 2 <= WS_MIX && WS_MIX + (size_t)M * D * 2 <= WS_END && WS_HID + (size_t)M * FF * 2 <= WS_END, "d_ws map");
constexpr int CW_BAR = 4096;
constexpr int RING_OFF = 0, RING_BYTES = 131072;
constexpr int LDSCTL_OFF = RING_BYTES, MISC_OFF = LDSCTL_OFF + 320;
constexpr int WSF_OFF = RING_BYTES + 1024;
constexpr int LDS_BYTES = 147456;
static_assert(MISC_OFF + 128 <= WSF_OFF && WSF_OFF + 2048 <= LDS_BYTES, "LDS map");

typedef unsigned short bf16;
typedef unsigned v4u __attribute__((ext_vector_type(4)));
typedef float f32x4 __attribute__((ext_vector_type(4)));
typedef GAS unsigned gu32;
#define RLX_AGENT __ATOMIC_RELAXED, __HIP_MEMORY_SCOPE_AGENT
#define LDS_WAIT() asm volatile("s_waitcnt lgkmcnt(0)" ::: "memory")
#define VM_WAIT() asm volatile("s_waitcnt vmcnt(0)" ::: "memory")
__device__ __forceinline__ unsigned pk2(float lo, float hi) { return pg8::cvt_pk_bf16(lo, hi); }

#define XB_TMO      128
#define XB_XCNT(j)  (256  + 64 * (j))
#define XB_XSUB(j)  (1280 + 64 * (j))
#define XB_XGEN(j)  (2304 + 64 * (j))
#define XB_TOP      3328
#define XB_TOPGEN   3392
#define XCD_BAR_WORDS 3456
#define XB_SPIN_CAP (1u << 18)

__device__ __forceinline__ unsigned xb_ld(unsigned* p)              { return __hip_atomic_load(p, __ATOMIC_RELAXED, __HIP_MEMORY_SCOPE_AGENT); }
__device__ __forceinline__ unsigned xb_add(unsigned* p, unsigned v) { return __hip_atomic_fetch_add(p, v, __ATOMIC_RELAXED, __HIP_MEMORY_SCOPE_AGENT); }
__device__ __forceinline__ unsigned xb_xcc_id() { return (unsigned)__builtin_amdgcn_s_getreg((3 << 11) | 20) & 0xFu; }
#define XB_SPIN(cond, bar) do { unsigned _sp = 0; while (cond) { __builtin_amdgcn_s_sleep(1); \
    if ((++_sp & 255u) == 0u) { if (xb_ld(&(bar)[XB_TMO])) break; if (_sp > XB_SPIN_CAP) { atomicAdd(&(bar)[XB_TMO], 1u); break; } } } } while (0)

struct XcdBarrier {
    unsigned* bar; unsigned x;
    volatile LAS unsigned* st;
};

__device__ __forceinline__ XcdBarrier xcd_barrier_post(unsigned* bar, volatile LAS unsigned* st) {
    XcdBarrier b; b.bar = bar; b.x = xb_xcc_id(); b.st = st;
    if (threadIdx.x == 0) (void)xb_add(&bar[XB_XCNT(b.x)], 1u);
    return b;
}
__device__ __forceinline__ void xcd_barrier_complete(unsigned* bar, unsigned x, unsigned& nloc, unsigned& nx) {
    const unsigned G = gridDim.x * gridDim.y * gridDim.z;
    unsigned sum, cnt, mine, sp = 0u;
    for (;;) {
        sum = 0u; cnt = 0u; mine = 0u;
#pragma unroll
        for (unsigned j = 0; j < 16; ++j) { const unsigned c = xb_ld(&bar[XB_XCNT(j)]); sum += c; cnt += (c > 0u) ? 1u : 0u; mine = (j == x) ? c : mine; }
        if (sum == G) break;
        __builtin_amdgcn_s_sleep(1);
        if ((++sp & 255u) == 0u) { if (xb_ld(&bar[XB_TMO])) break; if (sp > XB_SPIN_CAP) { atomicAdd(&bar[XB_TMO], 1u); break; } }
    }
    nloc = mine > 0u ? mine : 1u; nx = cnt > 0u ? cnt : 1u;
}

__device__ __forceinline__ void xcd_barrier(const XcdBarrier& b) {
    asm volatile("s_waitcnt vmcnt(0)" ::: "memory");
    __syncthreads();
    if (threadIdx.x == 0) {
        unsigned* bar = b.bar;
        __builtin_amdgcn_s_waitcnt(0);
        unsigned nloc = b.st[0], nx = b.st[1];
        if (nloc == 0u) { xcd_barrier_complete(bar, b.x, nloc, nx); b.st[0] = nloc; b.st[1] = nx; }
        const unsigned old = xb_add(&bar[XB_XSUB(b.x)], 1u);
        const unsigned gen = old / nloc;
        if (old + 1u == (gen + 1u) * nloc) {
            __builtin_amdgcn_fence(__ATOMIC_RELEASE, "agent");
            asm volatile("s_waitcnt vmcnt(0)" ::: "memory");
            const unsigned og = xb_add(&bar[XB_TOP], 1u);
            const unsigned tg = og / nx;
            if (og + 1u == (tg + 1u) * nx) xb_add(&bar[XB_TOPGEN], 1u);
            else XB_SPIN(xb_ld(&bar[XB_TOPGEN]) == tg, bar);
            __builtin_amdgcn_fence(__ATOMIC_ACQUIRE, "agent");
            xb_add(&bar[XB_XGEN(b.x)], 1u);
            asm volatile("s_waitcnt vmcnt(0)" ::: "memory");
        } else {
            XB_SPIN(xb_ld(&bar[XB_XGEN(b.x)]) == gen, bar);
            __builtin_amdgcn_fence(__ATOMIC_ACQUIRE, "agent");
            asm volatile("s_waitcnt vmcnt(0)" ::: "memory");
        }
    }
    __syncthreads();
}

struct Frame {
    LAS unsigned char* lds;
    volatile LAS unsigned* MISC;
    gu32* ctl;
    int tid, lane, wave;
    int vcu, G;
    __device__ __forceinline__ void refresh() { tid = fresh_tid(); lane = tid & 63; wave = __builtin_amdgcn_readfirstlane(tid >> 6); }
};
__device__ __forceinline__ float wave_sum(float v) {
#pragma unroll
    for (int o = 1; o < 64; o <<= 1) v += __shfl_xor(v, o);
    return v;
}
__device__ __forceinline__ void p0_transpose_item(const float* W, int K, int N, bf16* WT, LAS float* scr, int item, int lane) {
    const int nblk = N / 32, kb = item / nblk, nb = item % nblk, k0 = 64 * kb, n0 = 32 * nb;
#pragma unroll 8
    for (int i = 0; i < 32; ++i) { const int kk = 2 * i + (lane >> 5); scr[kk * 33 + (lane & 31)] = W[(size_t)(k0 + kk) * N + n0 + (lane & 31)]; }
    LDS_WAIT(); asm volatile("" ::: "memory");
    const int c = lane & 7;
#pragma unroll
    for (int j = 0; j < 4; ++j) { const int n = (lane >> 3) + 8 * j; const LAS float* s = scr + (8 * c) * 33 + n;
        v4u o; o.x = pk2(s[0 * 33], s[1 * 33]); o.y = pk2(s[2 * 33], s[3 * 33]); o.z = pk2(s[4 * 33], s[5 * 33]); o.w = pk2(s[6 * 33], s[7 * 33]);
        *(GAS v4u*)(WT + (size_t)(n0 + n) * K + k0 + 8 * c) = o; }
    LDS_WAIT(); asm volatile("" ::: "memory");
}
__device__ __forceinline__ void p0_mod(Frame& F, const float* cvec, const float* w_ada, const float* b_ada, float* mod) {
    LAS float* sc = (LAS float*)(F.lds + RING_OFF);
    LAS float* red = (LAS float*)(F.lds + RING_OFF + 32768);
    for (int i = F.tid; i < BATCH * D; i += NWAVES * 64) { const float v = cvec[i]; sc[i] = v / (1.0f + __expf(-v)); }
    LDS_WAIT(); __syncthreads();
    const int col = blockIdx.x * 64 + F.lane, kbase = F.wave * 256;
    const float* wp = w_ada + (size_t)kbase * (NMOD * D) + col;
    float a0 = 0.f, a1 = 0.f, a2 = 0.f, a3 = 0.f;
#pragma unroll 16
    for (int k = 0; k < 256; ++k) { const float w = wp[(size_t)k * (NMOD * D)];
        a0 += sc[kbase + k] * w; a1 += sc[D + kbase + k] * w; a2 += sc[2 * D + kbase + k] * w; a3 += sc[3 * D + kbase + k] * w; }
    red[(F.wave * 4 + 0) * 64 + F.lane] = a0; red[(F.wave * 4 + 1) * 64 + F.lane] = a1; red[(F.wave * 4 + 2) * 64 + F.lane] = a2; red[(F.wave * 4 + 3) * 64 + F.lane] = a3;
    LDS_WAIT(); __syncthreads();
    if (F.tid < 256) { const int b = F.tid >> 6, l = F.tid & 63; float s = 0.f;
#pragma unroll
        for (int w = 0; w < 8; ++w) s += red[(w * 4 + b) * 64 + l];
        mod[(size_t)b * (NMOD * D) + blockIdx.x * 64 + l] = s + b_ada[blockIdx.x * 64 + l]; }
    LDS_WAIT(); __syncthreads();
}
struct RowStats { float mean, rstd; };
__device__ __forceinline__ RowStats row_stats(f32x4 (&v)[8]) {
    float s = 0.f;
#pragma unroll
    for (int j = 0; j < 8; ++j) s += (v[j].x + v[j].y) + (v[j].z + v[j].w);
    const float mean = wave_sum(s) * (1.f / D); float s2 = 0.f;
#pragma unroll
    for (int j = 0; j < 8; ++j) { const f32x4 d = v[j] - mean; s2 += (d.x * d.x + d.y * d.y) + (d.z * d.z + d.w * d.w); }
    RowStats r; r.mean = mean; r.rstd = 1.f / sqrtf(wave_sum(s2) * (1.f / D) + LN_EPS); return r;
}
__device__ __forceinline__ void p1_xn(Frame& F, const float* x, const float* mod, bf16* XN) {
    const int gw = F.vcu * NWAVES + F.wave, NGW = F.G * NWAVES;
    for (int m = gw; m < M; m += NGW) {
        const GAS f32x4* xr = (const GAS f32x4*)(x + (size_t)m * D) + F.lane;
        const float* mb = mod + (size_t)(m >> 12) * (NMOD * D);
        f32x4 v[8];
#pragma unroll
        for (int j = 0; j < 8; ++j) v[j] = xr[64 * j];
        const RowStats st = row_stats(v);
        GAS unsigned long long* o8 = (GAS unsigned long long*)(XN + (size_t)m * D) + F.lane;
#pragma unroll
        for (int j = 0; j < 8; ++j) { const f32x4 sh = *((const f32x4*)(mb + 0 * D) + F.lane + 64 * j), sc = *((const f32x4*)(mb + 1 * D) + F.lane + 64 * j);
            const f32x4 y = (v[j] - st.mean) * st.rstd * (sc + 1.0f) + sh;
            o8[64 * j] = (unsigned long long)pk2(y.x, y.y) | ((unsigned long long)pk2(y.z, y.w) << 32); }
    }
}
__device__ __forceinline__ void add_bf16x4(f32x4& v, unsigned long long w, float alpha) {
    const unsigned lo = (unsigned)w, hi = (unsigned)(w >> 32);
    v.x = v.x * alpha + __uint_as_float(lo << 16); v.y = v.y * alpha + __uint_as_float(lo & 0xffff0000u);
    v.z = v.z * alpha + __uint_as_float(hi << 16); v.w = v.w * alpha + __uint_as_float(hi & 0xffff0000u);
}
__device__ __forceinline__ void p5_ln(Frame& F, const float* X, const bf16* G, float* H, const float* lg, const float* lb, const float* mod, bf16* XN) {
    const int gw = F.vcu * NWAVES + F.wave, NGW = F.G * NWAVES;
    for (int m = gw; m < M; m += NGW) {
        const GAS f32x4* xr = (const GAS f32x4*)(X + (size_t)m * D) + F.lane;
        const GAS unsigned long long* gr = (const GAS unsigned long long*)(G + (size_t)m * D) + F.lane;
        GAS f32x4* hr = (GAS f32x4*)(H + (size_t)m * D) + F.lane;
        const float* mb = mod + (size_t)(m >> 12) * (NMOD * D);
        f32x4 v[8]; unsigned long long gq[8];
#pragma unroll
        for (int j = 0; j < 8; ++j) { v[j] = xr[64 * j]; gq[j] = gr[64 * j]; }
#pragma unroll
        for (int j = 0; j < 8; ++j) add_bf16x4(v[j], gq[j], DN_ALPHA);
        const RowStats st = row_stats(v);
#pragma unroll
        for (int j = 0; j < 8; ++j) { const f32x4 g = *((const f32x4*)lg + F.lane + 64 * j), b = *((const f32x4*)lb + F.lane + 64 * j);
            v[j] = (v[j] - st.mean) * st.rstd * g + b; hr[64 * j] = v[j]; }
        const RowStats s2 = row_stats(v);
        GAS unsigned long long* o8 = (GAS unsigned long long*)(XN + (size_t)m * D) + F.lane;
#pragma unroll
        for (int j = 0; j < 8; ++j) { const f32x4 sh = *((const f32x4*)(mb + 3 * D) + F.lane + 64 * j), sc = *((const f32x4*)(mb + 4 * D) + F.lane + 64 * j);
            const f32x4 y = (v[j] - s2.mean) * s2.rstd * (sc + 1.0f) + sh;
            o8[64 * j] = (unsigned long long)pk2(y.x, y.y) | ((unsigned long long)pk2(y.z, y.w) << 32); }
    }
}
__device__ __forceinline__ void p8_ln(Frame& F, float* H, const bf16* G, const float* lg, const float* lb) {
    const int gw = F.vcu * NWAVES + F.wave, NGW = F.G * NWAVES;
    for (int m = gw; m < M; m += NGW) {
        GAS f32x4* yr = (GAS f32x4*)(H + (size_t)m * D) + F.lane;
        const GAS unsigned long long* gr = (const GAS unsigned long long*)(G + (size_t)m * D) + F.lane;
        f32x4 v[8]; unsigned long long gq[8];
#pragma unroll
        for (int j = 0; j < 8; ++j) { v[j] = yr[64 * j]; gq[j] = gr[64 * j]; }
#pragma unroll
        for (int j = 0; j < 8; ++j) add_bf16x4(v[j], gq[j], DN_ALPHA);
        const RowStats st = row_stats(v);
#pragma unroll
        for (int j = 0; j < 8; ++j) { const f32x4 g = *((const f32x4*)lg + F.lane + 64 * j), b = *((const f32x4*)lb + F.lane + 64 * j);
            yr[64 * j] = (v[j] - st.mean) * st.rstd * g + b; }
    }
}

#define REP_P0 1
#define REP_P1 1
#define REP_P2 1
#define REP_P3A 1
#define REP_P3G 1
#define REP_P4 1
#define REP_P6 1
#define REP_P7X 0
constexpr size_t WS_SCRATCH = 414 * MiB;
struct Args { const float* in[21]; float* out; unsigned char* ws; };
__global__ void __launch_bounds__(NWAVES * 64, 2) fwd_megakernel(Args args) {
    extern __shared__ __attribute__((aligned(16))) unsigned char lds[];
    Frame F;
    F.lds = (LAS unsigned char*)lds;
    F.MISC = (volatile LAS unsigned*)(F.lds + MISC_OFF);
    F.refresh();
    F.G = gridDim.x; { const int bx = blockIdx.x; F.vcu = (F.G % 8 == 0) ? (bx % 8) * (F.G / 8) + bx / 8 : bx; }
    unsigned char* ws = args.ws;
    F.ctl = (gu32*)(ws + WS_CTL);
    const float* x = args.in[0]; const float* cvec = args.in[1]; const float* w_ada = args.in[2]; const float* b_ada = args.in[3]; const float* w_in = args.in[4];
    const float* lq1 = args.in[5]; const float* lk1 = args.in[6]; const float* lq2 = args.in[7]; const float* lk2 = args.in[8]; const float* subg = args.in[9];
    const float* gln_g = args.in[10]; const float* gln_b = args.in[11]; const float* g_ws = args.in[12]; const float* g_bs = args.in[13]; const float* w_out = args.in[14];
    const float* ln1_g = args.in[15]; const float* ln1_b = args.in[16]; const float* w_ff1 = args.in[17]; const float* w_ff2 = args.in[18]; const float* ln2_g = args.in[19]; const float* ln2_b = args.in[20];
    float* out = args.out;
    float* MOD = (float*)(ws + WS_MOD);
    bf16* Win_t = (bf16*)(ws + WS_WIN); bf16* Wout_t = (bf16*)(ws + WS_WOUT); bf16* W1_t = (bf16*)(ws + WS_W1); bf16* W2_t = (bf16*)(ws + WS_W2);
    bf16* XN = (bf16*)(ws + WS_XN); bf16* PROJ = (bf16*)(ws + WS_PROJ); bf16* MIXB = (bf16*)(ws + WS_MIX); bf16* HID = (bf16*)(ws + WS_HID);
    bf16* GMIX = (bf16*)(ws + WS_PROJ);
    for (int u = F.tid; u < (LDS_BYTES - LDSCTL_OFF) / 4; u += NWAVES * 64) ((LAS unsigned*)(F.lds + LDSCTL_OFF))[u] = 0u;
    __syncthreads();
    XcdBarrier bar = xcd_barrier_post((unsigned*)(F.ctl + CW_BAR), F.MISC + 8);
#define GRID_BAR() xcd_barrier(bar)

    for (int rep = 0; rep < REP_P0; ++rep) {
        if (blockIdx.x < (NMOD * D) / 64) p0_mod(F, cvec, w_ada, b_ada, MOD);
        F.refresh();
        LAS float* scr = (LAS float*)(F.lds + RING_OFF + F.wave * 16384);
        const int gw = F.vcu * NWAVES + F.wave, NGW = F.G * NWAVES;
        constexpr int I_IN = (D / 64) * (INW / 32), I_O = (D / 64) * (D / 32), I_1 = (D / 64) * (FF / 32), I_2 = (FF / 64) * (D / 32);
        constexpr int NITEMS = I_IN + I_O + I_1 + I_2;
        for (int it = gw; it < NITEMS; it += NGW) {
            int r = it;
            if (r < I_IN) { p0_transpose_item(w_in, D, INW, Win_t, scr, r, F.lane); continue; } r -= I_IN;
            if (r < I_O) { p0_transpose_item(w_out, D, D, Wout_t, scr, r, F.lane); continue; } r -= I_O;
            if (r < I_1) { p0_transpose_item(w_ff1, D, FF, W1_t, scr, r, F.lane); continue; } r -= I_1;
            p0_transpose_item(w_ff2, FF, D, W2_t, scr, r, F.lane);
        }
        GRID_BAR();
    }
    for (int rep = 0; rep < REP_P1; ++rep) { F.refresh(); p1_xn(F, x, MOD, XN);
    GRID_BAR(); }
    for (int rep = 0; rep < REP_P2; ++rep) {
        pg8::Gemm g{XN, Win_t, M, INW, D}; pg8::StaticOrder S; S.init(M, INW, F.G, (int)blockIdx.x);
        pg8::EpiProj E{PROJ, INW};
        pg8::gemm_phase<pg8::EpiProj, pg8::StaticOrder, true, true>(F.lds + RING_OFF, g, S, E);
        GRID_BAR();
    }
    {
        F.refresh();
        float lam;
        { const float a = lq1[F.lane] * lk1[F.lane], b = lq2[F.lane] * lk2[F.lane];
          lam = __expf(wave_sum(a)) - __expf(wave_sum(b)) + 0.2f; }
        LAS float* wsf = (LAS float*)(F.lds + WSF_OFF);
        const int bh = F.vcu >> 3, s = F.vcu & 7;
        for (int rep = 0; rep < REP_P3A; ++rep)
        for (int i = 0; i < 4; ++i) { const int qb = (i == 0) ? s : (i == 1) ? 15 - s : (i == 2) ? 16 + s : 31 - s;
            mix::attn_unit(bh >> 3, bh & 7, qb, PROJ, MIXB, F.lds + RING_OFF, wsf, lam, subg); }
        const int gg = F.vcu >> 5;
        for (int rep = 0; rep < REP_P3G; ++rep) {
        mix::gmlp_load_wm(g_ws + (size_t)gg * 128 * 128, F.lds + RING_OFF);
        for (int i = 0; i < 4; ++i) { const int idx = (F.vcu & 31) * 4 + i;
            mix::gmlp_item(idx >> 5, idx & 31, gg, PROJ, MIXB, F.lds + RING_OFF, gln_g, gln_b, g_bs); } }
        GRID_BAR();
    }
    for (int rep = 0; rep < REP_P4; ++rep) {
        pg8::Gemm g{MIXB, Wout_t, M, D, D}; pg8::StaticOrder S; S.init(M, D, F.G, (int)blockIdx.x);
        pg8::EpiGate E{GMIX, D, MOD + 2 * D, NMOD * D};
        pg8::gemm_phase<pg8::EpiGate, pg8::StaticOrder, true, true>(F.lds + RING_OFF, g, S, E);
        GRID_BAR();
    }
    F.refresh(); p5_ln(F, x, GMIX, out, ln1_g, ln1_b, MOD, XN);
    GRID_BAR();
    for (int rep = 0; rep < REP_P6; ++rep) {
        pg8::Gemm g{XN, W1_t, M, FF, D}; pg8::StaticOrder S; S.init(M, FF, F.G, (int)blockIdx.x);
        pg8::EpiRelu2 E{HID, FF};
        pg8::gemm_phase<pg8::EpiRelu2, pg8::StaticOrder, true, true>(F.lds + RING_OFF, g, S, E);
        GRID_BAR();
    }
    for (int rep = 0; rep < REP_P7X; ++rep) {
        pg8::Gemm g{HID, W2_t, M, D, FF}; pg8::StaticOrder S; S.init(M, D, F.G, (int)blockIdx.x);
        pg8::EpiRelu2 E{(bf16*)(ws + WS_SCRATCH), D};
        pg8::gemm_phase<pg8::EpiRelu2, pg8::StaticOrder, true, true>(F.lds + RING_OFF, g, S, E);
        GRID_BAR();
    }
    {
        pg8::Gemm g{HID, W2_t, M, D, FF}; pg8::StaticOrder S; S.init(M, D, F.G, (int)blockIdx.x);
        pg8::EpiGate E{XN, D, MOD + 5 * D, NMOD * D};
        pg8::gemm_phase<pg8::EpiGate, pg8::StaticOrder, true, true>(F.lds + RING_OFF, g, S, E);
        GRID_BAR();
    }
    F.refresh(); p8_ln(F, out, XN, ln2_g, ln2_b);
#undef GRID_BAR
}

extern "C" void kernel_launch(void* const* d_in, const int* in_sizes, int n_in, void* d_out, int out_size, void* d_ws, size_t ws_size, hipStream_t stream) {
    static int grid = 0;
    if (grid == 0) {
        if (n_in != 21 || in_sizes[0] != M * D || out_size != M * D || ws_size < WS_END + 64 * MiB) { fprintf(stderr, "kernel_launch: built for 21 inputs, x and out of %d floats, >= %zu bytes of workspace; got n_in %d, in0 %d, out %d, ws %zu; nothing launched\n", M * D, (size_t)WS_END, n_in, n_in > 0 ? in_sizes[0] : -1, out_size, ws_size); grid = -1; return; }
        int dev = 0, cus = 0, per_cu = 0;
        if (hipGetDevice(&dev) != hipSuccess || hipDeviceGetAttribute(&cus, hipDeviceAttributeMultiprocessorCount, dev) != hipSuccess) { fprintf(stderr, "kernel_launch: hipGetDevice / hipDeviceGetAttribute failed\n"); grid = -1; return; }
        if (hipFuncSetAttribute((const void*)fwd_megakernel, hipFuncAttributeMaxDynamicSharedMemorySize, LDS_BYTES) != hipSuccess) { fprintf(stderr, "kernel_launch: hipFuncSetAttribute failed\n"); grid = -1; return; }
        if (hipOccupancyMaxActiveBlocksPerMultiprocessor(&per_cu, (const void*)fwd_megakernel, NWAVES * 64, LDS_BYTES) != hipSuccess || per_cu < 1)
            fprintf(stderr, "kernel_launch: note: the occupancy query reports %d workgroups per CU\n", per_cu);
        (void)hipGetLastError();
        grid = cus;
        if (grid != 256) fprintf(stderr, "kernel_launch: launching %d workgroups (built for 256 CUs)\n", grid);
    }
    if (grid < 0) return;
    if (hipMemsetAsync((char*)d_ws + WS_CTL, 0, CTL_ZERO_BYTES, stream) != hipSuccess) { fprintf(stderr, "kernel_launch: hipMemsetAsync of the control words failed\n"); return; }
    Args a{};
    for (int i = 0; i < 21; ++i) a.in[i] = (const float*)d_in[i];
    a.out = (float*)d_out; a.ws = (unsigned char*)d_ws;
    hipLaunchKernelGGL(fwd_megakernel, dim3(grid), dim3(NWAVES * 64), LDS_BYTES, stream, a);
    const hipError_t le = hipPeekAtLastError();
    if (le != hipSuccess) fprintf(stderr, "kernel_launch: launch failed: %s (grid %d x %d threads, %d B LDS)\n", hipGetErrorName(le), grid, NWAVES * 64, LDS_BYTES);
}
```

```cpp
#include <hip/hip_runtime.h>
#include <hip/hip_bf16.h>
#include <cstdio>
#include <cstdint>
#include <cmath>
__device__ __forceinline__ int fresh_tid() { int t = threadIdx.x; asm volatile("" : "+v"(t)); return t; }
namespace pg8 {
#define PG8_LAS __attribute__((address_space(3)))
typedef unsigned short bf16_t;
typedef short bf16x8 __attribute__((ext_vector_type(8)));
typedef float f32x4 __attribute__((ext_vector_type(4)));
typedef unsigned u32x4 __attribute__((ext_vector_type(4)));
constexpr int BM = 256, BK = 64, HALF = 128, HTB = HALF * BK * 2  , STAGE_BYTES = 8 * HTB, NXCD = 8, WGM = 8;

__host__ __device__ __forceinline__ int lds_byte(int r, int c) { const int st = (r >> 4) * 2 + (c >> 5), rr = r & 15, cc = c & 31, ob = rr * 64 + cc * 2; return st * 1024 + (ob ^ (((ob >> 9) & 1) << 5)); }
__host__ __device__ __forceinline__ void stage_rc(int b, int& R, int& C) { const int st = b / 1024, sb = b % 1024, swz = sb ^ (((sb >> 9) & 1) << 5); R = (st >> 1) * 16 + swz / 64; C = (st & 1) * 32 + (swz % 64) / 2; }
__host__ __device__ __forceinline__ int perm32(int rho) { const int n = rho >> 4, i = rho & 15; return 8 * (i >> 2) + 4 * n + (i & 3); }

struct Unit { int pm, pn; };
struct Gemm { const bf16_t* A; const bf16_t* Bt; int M, N, K; };

struct StaticOrder {
    int nM, nN, nwg, G, c;
    __host__ __device__ void init(int M, int N, int G_, int c_) { nM = M / BM; nN = N / BM; nwg = nM * nN; G = G_; c = c_; }
    __host__ __device__ bool next(int i, Unit& u) const {
        const long L = (long)i * G + c; if (L >= nwg) return false;
        int wgid = (int)L; { const int q = nwg / NXCD, r = nwg % NXCD, xcd = wgid % NXCD, off = wgid / NXCD; wgid = (xcd < r ? xcd * (q + 1) : r * (q + 1) + (xcd - r) * q) + off; }
        const int nig = WGM * nN, gid = wgid / nig, fm = gid * WGM, gsz = (nM - fm) < WGM ? (nM - fm) : WGM;
        u.pm = fm + ((wgid % nig) % gsz); u.pn = (wgid % nig) / gsz; return true;
    }
    __device__ __forceinline__ void a_ready(const Unit&) const {}
    __device__ __forceinline__ void done(const Unit&) const {}
};


typedef float f32x2 __attribute__((ext_vector_type(2)));
typedef __bf16 bf16x2_t __attribute__((ext_vector_type(2)));
__device__ __forceinline__ unsigned cvt_pk_bf16(float lo, float hi) { f32x2 v = {lo, hi}; bf16x2_t b = __builtin_convertvector(v, bf16x2_t); return __builtin_bit_cast(unsigned, b); }
__device__ __forceinline__ float gelu_tanh(float x) {
    const float c1 = 2.0f * 0.7978845608028654f * 1.4426950408889634f, c2 = c1 * 0.044715f;
    const float z2 = x * (c1 + c2 * x * x);
    const float e = __builtin_amdgcn_exp2f(-z2);
    return x * __builtin_amdgcn_rcpf(1.0f + e);
}
constexpr float ATT_C2 = 0.125f * 1.4426950408889634f;

struct EpiProj {
    static constexpr bool PERM = true, AFTER_DRAIN = false;
    bf16_t* O; int ldc;
    __device__ __forceinline__ void operator()(const f32x4 (&acc)[2][2][4][2], const Unit& u, int wr, int wc, int fr, int fq) const {
        const int row0 = u.pm * BM + wr * 64 + fr, col0 = u.pn * BM + wc * 32 + 8 * fq;
        const int mode = u.pn < 4 ? 0 : (u.pn < 12 ? 1 : 2);
#pragma unroll
        for (int ai = 0; ai < 2; ++ai)
#pragma unroll
            for (int m = 0; m < 4; ++m) { bf16_t* rowp = O + (size_t)(row0 + ai * HALF + m * 16) * ldc + col0;
#pragma unroll
                for (int bj = 0; bj < 2; ++bj) { f32x4 v0 = acc[ai][bj][m][0], v1 = acc[ai][bj][m][1];
                    if (mode == 0) { v0 = v0 * ATT_C2; v1 = v1 * ATT_C2; }
                    else if (mode == 2) {
#pragma unroll
                        for (int j = 0; j < 4; ++j) { v0[j] = gelu_tanh(v0[j]); v1[j] = gelu_tanh(v1[j]); } }
                    u32x4 w; w.x = cvt_pk_bf16(v0[0], v0[1]); w.y = cvt_pk_bf16(v0[2], v0[3]); w.z = cvt_pk_bf16(v1[0], v1[1]); w.w = cvt_pk_bf16(v1[2], v1[3]);
                    *(u32x4*)(rowp + bj * HALF) = w; } }
    }
};
struct EpiRelu2 {
    static constexpr bool PERM = true, AFTER_DRAIN = false;
    bf16_t* O; int ldc;
    __device__ __forceinline__ void operator()(const f32x4 (&acc)[2][2][4][2], const Unit& u, int wr, int wc, int fr, int fq) const {
        const int row0 = u.pm * BM + wr * 64 + fr, col0 = u.pn * BM + wc * 32 + 8 * fq;
#pragma unroll
        for (int ai = 0; ai < 2; ++ai)
#pragma unroll
            for (int m = 0; m < 4; ++m) { bf16_t* rowp = O + (size_t)(row0 + ai * HALF + m * 16) * ldc + col0;
#pragma unroll
                for (int bj = 0; bj < 2; ++bj) { f32x4 v0 = acc[ai][bj][m][0], v1 = acc[ai][bj][m][1];
#pragma unroll
                    for (int j = 0; j < 4; ++j) { const float a = __builtin_fmaxf(v0[j], 0.f), b = __builtin_fmaxf(v1[j], 0.f); v0[j] = a * a; v1[j] = b * b; }
                    u32x4 w; w.x = cvt_pk_bf16(v0[0], v0[1]); w.y = cvt_pk_bf16(v0[2], v0[3]); w.z = cvt_pk_bf16(v1[0], v1[1]); w.w = cvt_pk_bf16(v1[2], v1[3]);
                    *(u32x4*)(rowp + bj * HALF) = w; } }
    }
};
struct EpiGate {
    static constexpr bool PERM = true, AFTER_DRAIN = false;
    bf16_t* O; int ldc; const float* gate; int gate_stride;
    __device__ __forceinline__ void operator()(const f32x4 (&acc)[2][2][4][2], const Unit& u, int wr, int wc, int fr, int fq) const {
        const int row0 = u.pm * BM + wr * 64 + fr, col0 = u.pn * BM + wc * 32 + 8 * fq;
        const float* gp = gate + (size_t)(u.pm >> 4) * gate_stride + col0;
        f32x4 gv[2][2];
#pragma unroll
        for (int bj = 0; bj < 2; ++bj)
#pragma unroll
            for (int n = 0; n < 2; ++n) gv[bj][n] = *(const f32x4*)(gp + bj * HALF + n * 4) + 1.0f;
#pragma unroll
        for (int ai = 0; ai < 2; ++ai)
#pragma unroll
            for (int m = 0; m < 4; ++m) { bf16_t* rowp = O + (size_t)(row0 + ai * HALF + m * 16) * ldc + col0;
#pragma unroll
                for (int bj = 0; bj < 2; ++bj) { const f32x4 v0 = acc[ai][bj][m][0] * gv[bj][0], v1 = acc[ai][bj][m][1] * gv[bj][1];
                    u32x4 w; w.x = cvt_pk_bf16(v0[0], v0[1]); w.y = cvt_pk_bf16(v0[2], v0[3]); w.z = cvt_pk_bf16(v1[0], v1[1]); w.w = cvt_pk_bf16(v1[2], v1[3]);
                    *(u32x4*)(rowp + bj * HALF) = w; } }
    }
};
struct EpiRes {
    static constexpr bool PERM = false, AFTER_DRAIN = false;
    const float* base; float* out; const float* gate; int gate_stride; float alpha; int ldc;
    __device__ __forceinline__ void operator()(const f32x4 (&acc)[2][2][4][2], const Unit& u, int wr, int wc, int fr, int fq) const {
        const int row0 = u.pm * BM + wr * 64 + fr, col0 = u.pn * BM + wc * 32 + 4 * fq;
        const float* gp = gate + (size_t)(u.pm >> 4) * gate_stride + col0;
        f32x4 gv[2][2];
#pragma unroll
        for (int bj = 0; bj < 2; ++bj)
#pragma unroll
            for (int n = 0; n < 2; ++n) gv[bj][n] = *(const f32x4*)(gp + bj * HALF + n * 16) + 1.0f;
        f32x4 cur[2][2], nxt[2][2];
#pragma unroll
        for (int bj = 0; bj < 2; ++bj)
#pragma unroll
            for (int n = 0; n < 2; ++n) cur[bj][n] = *(const f32x4*)(base + (size_t)row0 * ldc + col0 + bj * HALF + n * 16);
#pragma unroll
        for (int idx = 0; idx < 8; ++idx) { const int ai = idx >> 2, m = idx & 3; const size_t off = (size_t)(row0 + ai * HALF + m * 16) * ldc + col0;
            if (idx + 1 < 8) { const size_t offn = (size_t)(row0 + ((idx + 1) >> 2) * HALF + ((idx + 1) & 3) * 16) * ldc + col0;
#pragma unroll
                for (int bj = 0; bj < 2; ++bj)
#pragma unroll
                    for (int n = 0; n < 2; ++n) nxt[bj][n] = *(const f32x4*)(base + offn + bj * HALF + n * 16); }
#pragma unroll
            for (int bj = 0; bj < 2; ++bj)
#pragma unroll
                for (int n = 0; n < 2; ++n) { *(f32x4*)(out + off + bj * HALF + n * 16) = cur[bj][n] * alpha + gv[bj][n] * acc[ai][bj][m][n]; cur[bj][n] = nxt[bj][n]; }
        }
    }
};

template <class Epi, class Sched, bool ALIGN_EPI = false, bool SP2 = false>
__device__ __forceinline__ void gemm_phase(PG8_LAS unsigned char* lds, const Gemm g, const Sched& S, const Epi& E) {
    const int tid = fresh_tid(), wid = __builtin_amdgcn_readfirstlane(tid >> 6), lane = tid & 63, wr = wid >> 2, wc = wid & 3, fr = lane & 15, fq = lane >> 4;
    const int K = g.K, nt = K / BK;
    unsigned voffA[2], voffB[2];
#pragma unroll
    for (int i = 0; i < 2; ++i) { int R, C; stage_rc(tid * 16 + i * 8192, R, C); const int Rb = Epi::PERM ? ((R & ~31) + perm32(R & 31)) : R;
        voffA[i] = (unsigned)(R * K + C) * 2u; voffB[i] = (unsigned)(Rb * K + C) * 2u; }
    const size_t kstep = (size_t)(BK * 2);
    const size_t hstep = (size_t)HALF * K * 2;
    const size_t tstep = 2 * hstep;
    const unsigned ldsw = (unsigned)wid * 1024u;
    const int aoff = lds_byte(wr * 64 + fr, fq * 8), boff = lds_byte(wc * 32 + fr, fq * 8);
#define PG8_SA(b, h) (((b) * 2 + (h)) * HTB)
#define PG8_SB(b, h) ((4 + (b) * 2 + (h)) * HTB)
#define PG8_STAGE(bufoff, gbase, voff) do { _Pragma("unroll") for (int _i = 0; _i < 2; ++_i) \
        __builtin_amdgcn_global_load_lds((const unsigned*)((const char*)(gbase) + (voff)[_i]), (PG8_LAS unsigned*)(lds + (bufoff) + ldsw + _i * 8192), 16, 0, 0); } while (0)
#define PG8_LDA(dst, b, h) do { _Pragma("unroll") for (int m = 0; m < 4; ++m) _Pragma("unroll") for (int k = 0; k < 2; ++k) dst[m][k] = *(const PG8_LAS bf16x8*)(lds + PG8_SA(b, h) + aoff + m * 2048 + k * 1024); } while (0)
#define PG8_LDB(dst, b, h) do { _Pragma("unroll") for (int n = 0; n < 2; ++n) _Pragma("unroll") for (int k = 0; k < 2; ++k) dst[n][k] = *(const PG8_LAS bf16x8*)(lds + PG8_SB(b, h) + boff + n * 2048 + k * 1024); } while (0)
#define PG8_MMA(ai, bj, At, Bt) do { __builtin_amdgcn_s_setprio(1); _Pragma("unroll") for (int m = 0; m < 4; ++m) _Pragma("unroll") for (int n = 0; n < 2; ++n) _Pragma("unroll") for (int k = 0; k < 2; ++k) \
        acc[ai][bj][m][n] = __builtin_amdgcn_mfma_f32_16x16x32_bf16(Bt[n][k], At[m][k], acc[ai][bj][m][n], 0, 0, 0); __builtin_amdgcn_s_setprio(0); } while (0)
#define PG8_WAIT_V(n) asm volatile("s_waitcnt vmcnt(" #n ")" ::: "memory")
#define PG8_WAIT_L(n) asm volatile("s_waitcnt lgkmcnt(" #n ")" ::: "memory")
#define PG8_BAR __builtin_amdgcn_s_barrier()
#define PG8_SCHED __builtin_amdgcn_sched_barrier(0)
    Unit cur, nxt; int ui = 0;
    if (!S.next(0, cur)) return;
    f32x4 acc[2][2][4][2];
#pragma unroll
    for (int a = 0; a < 2; ++a)
#pragma unroll
        for (int b = 0; b < 2; ++b)
#pragma unroll
            for (int m = 0; m < 4; ++m)
#pragma unroll
                for (int n = 0; n < 2; ++n) acc[a][b][m][n] = (f32x4){0.f, 0.f, 0.f, 0.f};
    bf16x8 At[4][2], B0[2][2], B1[2][2];
    const char* cA = (const char*)g.A + (size_t)cur.pm * tstep; const char* cB = (const char*)g.Bt + (size_t)cur.pn * tstep;
    S.a_ready(cur);
    if constexpr (SP2) {
        PG8_STAGE(PG8_SB(0, 0), cB, voffB); PG8_STAGE(PG8_SB(0, 1), cB + hstep, voffB); PG8_STAGE(PG8_SA(0, 0), cA, voffA); PG8_STAGE(PG8_SA(0, 1), cA + hstep, voffA);
        if (wr == 1) PG8_BAR;
        PG8_WAIT_V(2); PG8_BAR;
        PG8_STAGE(PG8_SB(1, 0), cB + kstep, voffB); PG8_STAGE(PG8_SA(1, 0), cA + kstep, voffA); PG8_STAGE(PG8_SB(1, 1), cB + hstep + kstep, voffB);
        PG8_WAIT_V(6); PG8_BAR;
    } else {
        PG8_STAGE(PG8_SB(0, 0), cB, voffB); PG8_STAGE(PG8_SA(0, 0), cA, voffA); PG8_STAGE(PG8_SB(0, 1), cB + hstep, voffB); PG8_STAGE(PG8_SA(0, 1), cA + hstep, voffA);
        if (wr == 1) PG8_BAR;
        PG8_WAIT_V(4); PG8_BAR;
        PG8_STAGE(PG8_SB(1, 0), cB + kstep, voffB); PG8_STAGE(PG8_SA(1, 0), cA + kstep, voffA); PG8_STAGE(PG8_SB(1, 1), cB + hstep + kstep, voffB);
        PG8_WAIT_V(6); PG8_BAR;
    }
    for (;;) {
        const bool has_next = S.next(ui + 1, nxt);
        const char* nA = has_next ? (const char*)g.A + (size_t)nxt.pm * tstep : cA; const char* nB = has_next ? (const char*)g.Bt + (size_t)nxt.pn * tstep : cB;
        for (int t = 0; t < nt; t += 2) {
            const bool last = (t == nt - 2);
            const char* a1 = cA + (size_t)(t + 1) * kstep;
            const char* a2 = last ? nA : cA + (size_t)(t + 2) * kstep; const char* b2 = last ? nB : cB + (size_t)(t + 2) * kstep;
            const char* a3 = a2 + kstep; const char* b3 = b2 + kstep;
            if (last && has_next) S.a_ready(nxt);
            if constexpr (SP2) {
            PG8_LDB(B0, 0, 0); PG8_LDB(B1, 0, 1); PG8_SCHED; PG8_LDA(At, 0, 0); PG8_STAGE(PG8_SA(1, 1), a1 + hstep, voffA);
            PG8_WAIT_V(8); PG8_WAIT_L(0); PG8_BAR; PG8_MMA(0, 0, At, B0); PG8_MMA(0, 1, At, B1); PG8_BAR; PG8_SCHED;
            PG8_LDA(At, 0, 1); PG8_STAGE(PG8_SB(0, 0), b2, voffB); PG8_STAGE(PG8_SB(0, 1), b2 + hstep, voffB); PG8_STAGE(PG8_SA(0, 0), a2, voffA);
            PG8_WAIT_V(8); PG8_WAIT_L(0); PG8_BAR; PG8_MMA(1, 0, At, B0); PG8_MMA(1, 1, At, B1); PG8_BAR; PG8_SCHED;
            PG8_LDB(B0, 1, 0); PG8_LDB(B1, 1, 1); PG8_SCHED; PG8_LDA(At, 1, 0); PG8_STAGE(PG8_SA(0, 1), a2 + hstep, voffA);
            PG8_WAIT_V(8); PG8_WAIT_L(0); PG8_BAR; PG8_MMA(0, 0, At, B0); PG8_MMA(0, 1, At, B1); PG8_BAR; PG8_SCHED;
            PG8_LDA(At, 1, 1); PG8_STAGE(PG8_SB(1, 0), b3, voffB); PG8_STAGE(PG8_SB(1, 1), b3 + hstep, voffB); PG8_STAGE(PG8_SA(1, 0), a3, voffA);
            PG8_WAIT_V(8); PG8_WAIT_L(0); PG8_BAR; PG8_MMA(1, 0, At, B0); PG8_MMA(1, 1, At, B1); PG8_BAR; PG8_SCHED;
            } else {
            PG8_LDB(B0, 0, 0); PG8_SCHED; PG8_LDA(At, 0, 0); PG8_STAGE(PG8_SA(1, 1), a1 + hstep, voffA);
            PG8_WAIT_L(8); PG8_BAR; PG8_WAIT_L(0); PG8_MMA(0, 0, At, B0); PG8_BAR; PG8_SCHED;
            PG8_LDB(B1, 0, 1); PG8_STAGE(PG8_SB(0, 0), b2, voffB);
            PG8_BAR; PG8_WAIT_L(0); PG8_MMA(0, 1, At, B1); PG8_BAR;
            PG8_LDA(At, 0, 1); PG8_STAGE(PG8_SA(0, 0), a2, voffA);
            PG8_BAR; PG8_WAIT_L(0); PG8_MMA(1, 0, At, B0); PG8_BAR; PG8_SCHED;
            PG8_STAGE(PG8_SB(0, 1), b2 + hstep, voffB);
            PG8_WAIT_V(6); PG8_BAR; PG8_MMA(1, 1, At, B1); PG8_BAR;
            PG8_LDB(B0, 1, 0); PG8_SCHED; PG8_LDA(At, 1, 0); PG8_STAGE(PG8_SA(0, 1), a2 + hstep, voffA);
            PG8_WAIT_L(8); PG8_BAR; PG8_WAIT_L(0); PG8_MMA(0, 0, At, B0); PG8_BAR; PG8_SCHED;
            PG8_LDB(B1, 1, 1); PG8_STAGE(PG8_SB(1, 0), b3, voffB);
            PG8_BAR; PG8_WAIT_L(0); PG8_MMA(0, 1, At, B1); PG8_BAR;
            PG8_LDA(At, 1, 1); PG8_STAGE(PG8_SA(1, 0), a3, voffA);
            PG8_BAR; PG8_WAIT_L(0); PG8_MMA(1, 0, At, B0); PG8_BAR; PG8_SCHED;
            PG8_STAGE(PG8_SB(1, 1), b3 + hstep, voffB);
            PG8_WAIT_V(6); PG8_BAR; PG8_MMA(1, 1, At, B1); PG8_BAR;
            }
        }
        if constexpr (ALIGN_EPI) { if (wr == 0) PG8_BAR; }
        if constexpr (!Epi::AFTER_DRAIN) { E(acc, cur, wr, wc, fr, fq); S.done(cur); }
        if (!has_next) break;
#pragma unroll
        for (int a = 0; a < 2; ++a)
#pragma unroll
            for (int b = 0; b < 2; ++b)
#pragma unroll
                for (int m = 0; m < 4; ++m)
#pragma unroll
                    for (int n = 0; n < 2; ++n) acc[a][b][m][n] = (f32x4){0.f, 0.f, 0.f, 0.f};
        cur = nxt; cA = nA; cB = nB; ++ui;
        if constexpr (ALIGN_EPI) { if (wr == 1) PG8_BAR; }
    }
    PG8_WAIT_V(0);
    if constexpr (!ALIGN_EPI) { if (wr == 0) PG8_BAR; }
    PG8_BAR;
    if constexpr (Epi::AFTER_DRAIN) { E.fused(acc, cur, wr, wc, fr, fq, lds, wid, lane); S.done(cur); }
#undef PG8_SA
#undef PG8_SB
#undef PG8_STAGE
#undef PG8_LDA
#undef PG8_LDB
#undef PG8_MMA
#undef PG8_WAIT_V
#undef PG8_WAIT_L
#undef PG8_BAR
#undef PG8_SCHED
}
}

#define LAS __attribute__((address_space(3)))
#define GAS __attribute__((address_space(1)))
namespace mix {
typedef unsigned short bf16;
typedef short bf16x8 __attribute__((ext_vector_type(8)));
typedef short s16x4 __attribute__((ext_vector_type(4)));
typedef short v4i16_t __attribute__((ext_vector_type(4)));
typedef float f32x16 __attribute__((ext_vector_type(16)));
typedef float f32x4 __attribute__((ext_vector_type(4)));
typedef unsigned u32x4 __attribute__((ext_vector_type(4)));
typedef LAS const char* lds_cptr;
constexpr int PITCH = 5120, SEQ = 4096, MIXP = 2048;
constexpr int COL_K = 1024, COL_V = 2048, COL_U = 3072, COL_G = 4096;
__device__ __forceinline__ int crow(int r, int hi) { return (r & 3) + 8 * (r >> 2) + 4 * hi; }
__device__ __forceinline__ unsigned cvtpk(float lo, float hi) { return pg8::cvt_pk_bf16(lo, hi); }
__device__ __forceinline__ float bf2f(unsigned short v) { return __uint_as_float((unsigned)v << 16); }
__device__ __forceinline__ void glds16(const void* gsrc, unsigned lds_dst) { unsigned keep;
    asm volatile("s_mov_b32 %0, m0\n\ts_mov_b32 m0, %2\n\ts_nop 0\n\tglobal_load_lds_dwordx4 %1, off\n\ts_mov_b32 m0, %0" : "=&s"(keep) : "v"(gsrc), "s"(lds_dst) : "memory"); }
__device__ __forceinline__ s16x4 vtr(lds_cptr p) { return __builtin_bit_cast(s16x4, __builtin_amdgcn_ds_read_tr16_b64_v4i16((LAS v4i16_t*)p)); }
#define MIX_MX3(a, b, c) __builtin_fmaxf(__builtin_fmaxf((a), (b)), (c))
__device__ __forceinline__ float rowmax(const f32x16& p0, const f32x16& p1) {
    float a = MIX_MX3(p0[0], p0[1], p1[0]), b = MIX_MX3(p0[2], p0[3], p1[1]); a = MIX_MX3(a, p1[2], p1[3]);
#pragma unroll
    for (int r = 4; r < 16; r += 4) { a = MIX_MX3(a, p0[r], p0[r + 1]); b = MIX_MX3(b, p0[r + 2], p0[r + 3]); a = MIX_MX3(a, p1[r], p1[r + 1]); b = MIX_MX3(b, p1[r + 2], p1[r + 3]); }
    float m = __builtin_fmaxf(a, b); auto rr = __builtin_amdgcn_permlane32_swap(__float_as_uint(m), __float_as_uint(m), false, false);
    return __builtin_fmaxf(__uint_as_float(rr[0]), __uint_as_float(rr[1])); }
#define MIX_MFMA(a, b, c) __builtin_amdgcn_mfma_f32_32x32x16_bf16(a, b, c, 0, 0, 0)

constexpr int SLOTB = 16384, A_NSLOT = 3, A_LDS_K = 0, A_LDS_V = A_NSLOT * SLOTB;
#define MIX_SBAR() __builtin_amdgcn_sched_barrier(0)
#define MIX_PIN(x) asm volatile("" : "+v"(x))
#define ATT_THRL 2.0f
__device__ __forceinline__ void attn_unit(int b, int h, int qb, const bf16* P, bf16* MIXO, LAS unsigned char* lds, LAS float* wsf_all, float lam, const float* subg) {
    const int tid = fresh_tid(), lane = tid & 63, r32 = lane & 31, hi = lane >> 5; const int wid = __builtin_amdgcn_readfirstlane(tid >> 6);
    const int c = wid >> 2, g = wid & 3;
    const long rowbase = (long)b * SEQ; const int q0 = qb * 128;
    const int NT = 2 * qb + 2;
    const bf16* Qw = P + (rowbase + q0 + g * 32) * PITCH + h * 128 + c * 64;
    const bf16* Kh = P + rowbase * PITCH + COL_K + h * 128;
    const bf16* Vh = P + rowbase * PITCH + COL_V + h * 128;
    const unsigned lds0 = (unsigned)(uintptr_t)lds;
    LAS float* wsf = wsf_all + wid * 64;
    const bf16* ksrc = Kh + (long)(8 * wid + (lane >> 3)) * PITCH + (((lane & 7) ^ ((4 * (wid & 1) + (lane >> 4)) & 7)) * 8);
    const bf16* vsrc = Vh + (long)(16 * (wid & 3) + (lane >> 2)) * PITCH + (wid >> 2) * 32 + (lane & 3) * 8;
    const unsigned kdst = lds0 + A_LDS_K + wid * 1024, vdst = lds0 + A_LDS_V + wid * 1024;
#define DMA_K(t, slot) do { const bf16* ks_ = ksrc + (long)(t) * 64 * PITCH; \
        glds16(ks_, (unsigned)__builtin_amdgcn_readfirstlane(kdst + (slot))); glds16(ks_ + 64, (unsigned)__builtin_amdgcn_readfirstlane(kdst + (slot) + 8192)); } while (0)
#define DMA_V(t, slot) do { const bf16* vs_ = vsrc + (long)(t) * 64 * PITCH; \
        glds16(vs_, (unsigned)__builtin_amdgcn_readfirstlane(vdst + (slot))); glds16(vs_ + 64, (unsigned)__builtin_amdgcn_readfirstlane(vdst + (slot) + 8192)); } while (0)
    const lds_cptr kpr = (lds_cptr)lds + A_LDS_K + c * 8192 + r32 * 128;
    const int ksw = (r32 >> 1) & 7;
    const int kq0 = ((0 + hi) ^ ksw) * 16, kq1 = ((2 + hi) ^ ksw) * 16, kq2 = ((4 + hi) ^ ksw) * 16, kq3 = ((6 + hi) ^ ksw) * 16;
    const lds_cptr vp0 = (lds_cptr)lds + A_LDS_V + ((lane >> 4) & 1) * 32 + (lane & 3) * 8 + (4 * hi + ((lane & 15) >> 2)) * 64;
    DMA_K(0, 0); DMA_V(0, 0); DMA_K(1, SLOTB);
    bf16x8 qr[4];
#pragma unroll
    for (int d0 = 0; d0 < 4; ++d0) qr[d0] = *reinterpret_cast<const bf16x8*>(Qw + (long)r32 * PITCH + d0 * 16 + hi * 8);
    float mhat = 0.f, l_reg = 0.f;
    f32x16 o[4];
#pragma unroll
    for (int d0 = 0; d0 < 4; ++d0) o[d0] = f32x16{};
    const f32x16 zero16 = f32x16{};
    bool resc = false;
    f32x16 pA0, pA1, pB0, pB1; bf16x8 kf[8]; s16x4 vlo[4], vhi[4]; u32x4 pw0, pw1, pw2, pw3;
    int sl_prev = 0, sl_cur = 0, sl_next = SLOTB;
#define ROT() do { sl_prev = sl_cur; sl_cur = sl_next; sl_next = (sl_next == (A_NSLOT - 1) * SLOTB) ? 0 : sl_next + SLOTB; } while (0)
#define WAIT_BAR(N) asm volatile("s_waitcnt vmcnt(" #N ") lgkmcnt(0)\n\ts_barrier" ::: "memory")
#define KRD1(so_, d0_, kq_) do { kf[2 * (d0_)] = *(const LAS bf16x8*)(kpr + (so_) + (kq_)); kf[2 * (d0_) + 1] = *(const LAS bf16x8*)(kpr + (so_) + (kq_) + 4096); } while (0)
#define RESC() do { if (resc) { asm volatile("s_waitcnt lgkmcnt(0)" ::: "memory"); \
        _Pragma("unroll") for (int r = 0; r < 16; ++r) { const float f_ = wsf[crow(r, hi)]; _Pragma("unroll") for (int d_ = 0; d_ < 4; ++d_) o[d_][r] *= f_; } } } while (0)
    DMA_K(2, 2 * SLOTB);
    WAIT_BAR(6);
    KRD1(0, 0, kq0); KRD1(0, 1, kq1); KRD1(0, 2, kq2); KRD1(0, 3, kq3);
    pA0 = MIX_MFMA(kf[0], qr[0], zero16); pA1 = MIX_MFMA(kf[1], qr[0], zero16);
#pragma unroll
    for (int d0 = 1; d0 < 4; ++d0) { pA0 = MIX_MFMA(kf[2 * d0], qr[d0], pA0); pA1 = MIX_MFMA(kf[2 * d0 + 1], qr[d0], pA1); }
    { const float rm = rowmax(pA0, pA1); mhat = rm;
#pragma unroll
      for (int r = 0; r < 16; ++r) { pA0[r] = __builtin_amdgcn_exp2f(pA0[r] - rm); pA1[r] = __builtin_amdgcn_exp2f(pA1[r] - rm); } }
    WAIT_BAR(0);
    DMA_K(3, 0); DMA_V(1, SLOTB); ROT();
    KRD1(sl_cur, 0, kq0); KRD1(sl_cur, 1, kq1); KRD1(sl_cur, 2, kq2); KRD1(sl_cur, 3, kq3);
    if (NT > 2) { WAIT_BAR(4); } else { WAIT_BAR(0); }
#define PKW(Pp, B) cvtpk(Pp[B], Pp[B + 1])
#define PAF(k) __builtin_bit_cast(bf16x8, pw##k)
#define VFR(i) (bf16x8){vlo[i][0], vlo[i][1], vlo[i][2], vlo[i][3], vhi[i][0], vhi[i][1], vhi[i][2], vhi[i][3]}
#define VRD(i, f) do { vlo[i] = vtr(vp_ + (((f) >> 2) * 4096 + ((f) & 3) * 1024)); vhi[i] = vtr(vp_ + (((f) >> 2) * 4096 + ((f) & 3) * 1024 + 512)); } while (0)
#define GAPA(MF, A0, A1, A2, A3, W0, W1, PW) do { MF; sacc += A0; sacc += A1; sacc += A2; sacc += A3; MIX_PIN(sacc); W0; W1; MIX_PIN(PW); MIX_SBAR(); } while (0)
#define EX(v) __builtin_amdgcn_exp2f((v) - mhat)
#define GAPB(MF, X, B) do { MF; X[B] = EX(X[B]); X[B + 1] = EX(X[B + 1]); MIX_PIN(X); MIX_SBAR(); } while (0)
#define STEP(C0, C1, P0, P1, t, GK, GV, GL, LAST) do { MIX_SBAR(); \
    const lds_cptr vp_ = vp0 + sl_prev; \
    float sacc = (P0[0] + P0[1]); \
    GAPA(C0 = MIX_MFMA(kf[0], qr[0], zero16), P0[2], P0[3], P0[4], P0[5],     pw0[0] = PKW(P0, 0),  pw0[1] = PKW(P0, 2),  pw0); \
    GAPA(C1 = MIX_MFMA(kf[1], qr[0], zero16), P0[6], P0[7], P0[8], P0[9],     pw0[2] = PKW(P0, 4),  pw0[3] = PKW(P0, 6),  pw0); \
    GAPA(C0 = MIX_MFMA(kf[2], qr[1], C0),   P0[10], P0[11], P0[12], P0[13], pw1[0] = PKW(P0, 8),  pw1[1] = PKW(P0, 10), pw1); \
    GAPA(C1 = MIX_MFMA(kf[3], qr[1], C1),   P0[14], P0[15], P1[0], P1[1],   pw1[2] = PKW(P0, 12), pw1[3] = PKW(P0, 14), pw1); \
    VRD(0, 0); MIX_SBAR(); GAPA(C0 = MIX_MFMA(kf[4], qr[2], C0),   P1[2], P1[3], P1[4], P1[5],     pw2[0] = PKW(P1, 0),  pw2[1] = PKW(P1, 2),  pw2); \
    VRD(1, 1); MIX_SBAR(); GAPA(C1 = MIX_MFMA(kf[5], qr[2], C1),   P1[6], P1[7], P1[8], P1[9],     pw2[2] = PKW(P1, 4),  pw2[3] = PKW(P1, 6),  pw2); \
    VRD(2, 2); MIX_SBAR(); GAPA(C0 = MIX_MFMA(kf[6], qr[3], C0),   P1[10], P1[11], P1[12], P1[13], pw3[0] = PKW(P1, 8),  pw3[1] = PKW(P1, 10), pw3); \
    VRD(3, 3); MIX_SBAR(); GAPA(C1 = MIX_MFMA(kf[7], qr[3], C1),   P1[14], P1[15], 0.f, 0.f,       pw3[2] = PKW(P1, 12), pw3[3] = PKW(P1, 14), pw3); \
    l_reg += sacc; \
    if (GK) { DMA_K((t) + 3, sl_cur); } if (GV) { DMA_V((t) + 1, sl_next); } \
    if (LAST) { if (g < 2) { _Pragma("unroll") for (int r = 0; r < 16; ++r) { C0[r] = -INFINITY; C1[r] = -INFINITY; } } } \
    { const float rm = rowmax(C0, C1) - mhat; \
      resc = false; \
      if (__builtin_expect(__any(rm > ATT_THRL), 0)) { const float dl = __builtin_fmaxf(rm, 0.f); mhat += dl; \
        const float f = __builtin_amdgcn_exp2f(-dl); l_reg *= f; if (hi == 0) wsf[r32] = f; resc = true; } } \
    MIX_SBAR(); \
    GAPB(o[0] = MIX_MFMA(PAF(0), VFR(0), o[0]), C0, 0);  VRD(0, 4);  MIX_SBAR(); \
    GAPB(o[0] = MIX_MFMA(PAF(1), VFR(1), o[0]), C0, 2);  VRD(1, 5);  MIX_SBAR(); \
    GAPB(o[0] = MIX_MFMA(PAF(2), VFR(2), o[0]), C0, 4);  VRD(2, 6);  MIX_SBAR(); \
    GAPB(o[0] = MIX_MFMA(PAF(3), VFR(3), o[0]), C0, 6);  VRD(3, 7);  MIX_SBAR(); \
    GAPB(o[1] = MIX_MFMA(PAF(0), VFR(0), o[1]), C0, 8);  VRD(0, 8);  MIX_SBAR(); \
    GAPB(o[1] = MIX_MFMA(PAF(1), VFR(1), o[1]), C0, 10); VRD(1, 9);  MIX_SBAR(); \
    GAPB(o[1] = MIX_MFMA(PAF(2), VFR(2), o[1]), C0, 12); VRD(2, 10); MIX_SBAR(); \
    GAPB(o[1] = MIX_MFMA(PAF(3), VFR(3), o[1]), C0, 14); VRD(3, 11); MIX_SBAR(); \
    GAPB(o[2] = MIX_MFMA(PAF(0), VFR(0), o[2]), C1, 0);  VRD(0, 12); MIX_SBAR(); \
    GAPB(o[2] = MIX_MFMA(PAF(1), VFR(1), o[2]), C1, 2);  VRD(1, 13); MIX_SBAR(); \
    GAPB(o[2] = MIX_MFMA(PAF(2), VFR(2), o[2]), C1, 4);  VRD(2, 14); MIX_SBAR(); \
    GAPB(o[2] = MIX_MFMA(PAF(3), VFR(3), o[2]), C1, 6);  VRD(3, 15); MIX_SBAR(); \
    GAPB(o[3] = MIX_MFMA(PAF(0), VFR(0), o[3]), C1, 8);  if (GL) { KRD1(sl_next, 0, kq0); } MIX_SBAR(); \
    GAPB(o[3] = MIX_MFMA(PAF(1), VFR(1), o[3]), C1, 10); if (GL) { KRD1(sl_next, 1, kq1); } MIX_SBAR(); \
    GAPB(o[3] = MIX_MFMA(PAF(2), VFR(2), o[3]), C1, 12); if (GL) { KRD1(sl_next, 2, kq2); } MIX_SBAR(); \
    GAPB(o[3] = MIX_MFMA(PAF(3), VFR(3), o[3]), C1, 14); if (GL) { KRD1(sl_next, 3, kq3); } MIX_SBAR(); \
    } while (0)
#define ENDW(tt) do { if ((tt) + 3 < NT) { WAIT_BAR(4); } else if ((tt) + 2 < NT) { WAIT_BAR(2); } else { WAIT_BAR(0); } } while (0)
    int t = 1;
    for (; t + 5 < NT; t += 2) {
        STEP(pB0, pB1, pA0, pA1, t, true, true, true, false);     WAIT_BAR(4); RESC(); ROT();
        STEP(pA0, pA1, pB0, pB1, t + 1, true, true, true, false); WAIT_BAR(4); RESC(); ROT();
    }
    for (; t + 1 < NT; t += 2) {
        STEP(pB0, pB1, pA0, pA1, t, (t + 3 < NT), (t + 1 < NT), (t + 1 < NT), false);       ENDW(t);     RESC(); ROT();
        STEP(pA0, pA1, pB0, pB1, t + 1, (t + 4 < NT), (t + 2 < NT), (t + 2 < NT), false);   ENDW(t + 1); RESC(); ROT();
    }
    STEP(pB0, pB1, pA0, pA1, NT - 1, false, false, false, true); RESC();
    { float sacc = 0.f;
#pragma unroll
      for (int r = 0; r < 16; ++r) sacc += pB0[r] + pB1[r];
      l_reg += sacc;
      pw0 = (u32x4){PKW(pB0, 0), PKW(pB0, 2), PKW(pB0, 4), PKW(pB0, 6)}; pw1 = (u32x4){PKW(pB0, 8), PKW(pB0, 10), PKW(pB0, 12), PKW(pB0, 14)};
      pw2 = (u32x4){PKW(pB1, 0), PKW(pB1, 2), PKW(pB1, 4), PKW(pB1, 6)}; pw3 = (u32x4){PKW(pB1, 8), PKW(pB1, 10), PKW(pB1, 12), PKW(pB1, 14)};
      const lds_cptr vp_ = vp0 + sl_cur;
#pragma unroll
      for (int d0 = 0; d0 < 4; ++d0) {
          VRD(0, 4 * d0); VRD(1, 4 * d0 + 1); VRD(2, 4 * d0 + 2); VRD(3, 4 * d0 + 3);
          o[d0] = MIX_MFMA(PAF(0), VFR(0), o[d0]); o[d0] = MIX_MFMA(PAF(1), VFR(1), o[d0]); o[d0] = MIX_MFMA(PAF(2), VFR(2), o[d0]); o[d0] = MIX_MFMA(PAF(3), VFR(3), o[d0]); } }
#undef DMA_K
#undef DMA_V
#undef ROT
#undef WAIT_BAR
#undef KRD1
#undef RESC
#undef PKW
#undef PAF
#undef VFR
#undef VRD
#undef GAPA
#undef GAPB
#undef EX
#undef STEP
#undef ENDW
    asm volatile("s_waitcnt vmcnt(0) lgkmcnt(0)\n\ts_barrier" ::: "memory");
    { auto rr = __builtin_amdgcn_permlane32_swap(__float_as_uint(l_reg), __float_as_uint(l_reg), false, false); l_reg = __uint_as_float(rr[0]) + __uint_as_float(rr[1]); }
    if (hi == 0) wsf[32 + r32] = l_reg;
    asm volatile("s_waitcnt lgkmcnt(0)" ::: "memory");
    LAS float* stg = (LAS float*)lds;
#pragma unroll
    for (int r = 0; r < 16; ++r) { const int row = 32 * g + crow(r, hi); const float rl = __builtin_amdgcn_rcpf(wsf[32 + crow(r, hi)]);
#pragma unroll
        for (int d0 = 0; d0 < 4; ++d0) { const int e = 32 * d0 + r32; stg[((c * 128 + row) * 32 + ((e >> 2) ^ (row & 7))) * 4 + (e & 3)] = o[d0][r] * rl; } }
    asm volatile("s_waitcnt lgkmcnt(0)\n\ts_barrier" ::: "memory");
    {
        const int row = tid >> 2, qd = tid & 3;
        f32x4 a[8]; float ss = 0.f;
#pragma unroll
        for (int i = 0; i < 8; ++i) { const int ph = (row * 32 + ((8 * qd + i) ^ (row & 7))) * 4;
            const f32x4 v0 = *(const LAS f32x4*)(stg + ph), v1 = *(const LAS f32x4*)(stg + 128 * 128 + ph);
            a[i] = v0 - v1 * lam; ss += (a[i][0] * a[i][0] + a[i][1] * a[i][1]) + (a[i][2] * a[i][2] + a[i][3] * a[i][3]); }
        ss += __shfl_xor(ss, 1); ss += __shfl_xor(ss, 2);
        const float rs = 0.8f / sqrtf(ss * (1.0f / 128.0f) + 1e-5f);
        bf16* op = MIXO + (rowbase + q0 + row) * MIXP + h * 128 + 32 * qd;
        const float* gp = subg + 32 * qd;
#pragma unroll
        for (int i = 0; i < 8; i += 2) { const f32x4 g0 = *(const f32x4*)(gp + 4 * i), g1 = *(const f32x4*)(gp + 4 * i + 4);
            const f32x4 x0 = a[i] * g0 * rs, x1 = a[i + 1] * g1 * rs;
            u32x4 w; w.x = cvtpk(x0[0], x0[1]); w.y = cvtpk(x0[2], x0[3]); w.z = cvtpk(x1[0], x1[1]); w.w = cvtpk(x1[2], x1[3]);
            *(u32x4*)(op + 4 * i) = w; }
    }
    asm volatile("s_waitcnt lgkmcnt(0)\n\ts_barrier" ::: "memory");
}

constexpr int G_WM = 0, G_WMP = 136, G_VN = 36864;
__device__ __forceinline__ void gmlp_load_wm(const float* ws_g, LAS unsigned char* lds) {
    const int tid = fresh_tid(), t = tid >> 2, s0 = (tid & 3) * 32;
#pragma unroll
    for (int i = 0; i < 4; ++i) { const f32x4 a = *(const f32x4*)(ws_g + t * 128 + s0 + 8 * i), b = *(const f32x4*)(ws_g + t * 128 + s0 + 8 * i + 4);
        const bool keep = (t >> 6) >= ((s0 + 8 * i) >> 6);
        u32x4 w; w.x = cvtpk(a[0], a[1]); w.y = cvtpk(a[2], a[3]); w.z = cvtpk(b[0], b[1]); w.w = cvtpk(b[2], b[3]);
        if (!keep) w = (u32x4){0u, 0u, 0u, 0u};
        *(LAS u32x4*)(lds + G_WM + (t * G_WMP + s0 + 8 * i) * 2) = w; }
}
__device__ __forceinline__ void gmlp_item(int b, int nb, int g, const bf16* P, bf16* MIXO, LAS unsigned char* lds, const float* lng, const float* lnb, const float* bsg) {
    const int tid = fresh_tid(), lane = tid & 63, r32 = lane & 31, hi = lane >> 5; const int wid = __builtin_amdgcn_readfirstlane(tid >> 6);
    const long rowbase = (long)b * SEQ + nb * 128;
    {
        const int s = tid >> 2, qd = tid & 3;
        const bf16* vp = P + (rowbase + s) * PITCH + COL_G + g * 128 + qd * 32;
        float v[32]; float sum = 0.f;
#pragma unroll
        for (int i = 0; i < 4; ++i) { const u32x4 w = *(const u32x4*)(vp + 8 * i);
#pragma unroll
            for (int j = 0; j < 4; ++j) { v[8 * i + 2 * j] = __uint_as_float(w[j] << 16); v[8 * i + 2 * j + 1] = __uint_as_float(w[j] & 0xffff0000u); } }
#pragma unroll
        for (int i = 0; i < 32; ++i) sum += v[i];
        sum += __shfl_xor(sum, 1); sum += __shfl_xor(sum, 2);
        const float mean = sum * (1.0f / 128.0f); float sq = 0.f;
#pragma unroll
        for (int i = 0; i < 32; ++i) { v[i] -= mean; sq += v[i] * v[i]; }
        sq += __shfl_xor(sq, 1); sq += __shfl_xor(sq, 2);
        const float rstd = 1.0f / sqrtf(sq * (1.0f / 128.0f) + 1e-5f);
        const float* gg = lng + g * 128 + qd * 32; const float* gb = lnb + g * 128 + qd * 32;
        LAS unsigned char* dst = lds + G_VN + ((qd * 8 + (s >> 4)) * 16 + (s & 15)) * 64;
#pragma unroll
        for (int i = 0; i < 4; ++i) { float y[8];
#pragma unroll
            for (int j = 0; j < 8; ++j) y[j] = v[8 * i + j] * rstd * gg[8 * i + j] + gb[8 * i + j];
            u32x4 w; w.x = cvtpk(y[0], y[1]); w.y = cvtpk(y[2], y[3]); w.z = cvtpk(y[4], y[5]); w.w = cvtpk(y[6], y[7]);
            *(LAS u32x4*)(dst + 16 * i) = w; }
    }
    asm volatile("s_waitcnt lgkmcnt(0)" ::: "memory"); __builtin_amdgcn_s_barrier(); asm volatile("" ::: "memory");
    const int tm = wid >> 1;
    const lds_cptr ap = (lds_cptr)lds + G_WM + ((32 * tm + r32) * G_WMP + 8 * hi) * 2;
    const lds_cptr vb = (lds_cptr)lds + G_VN + (8 * hi + ((lane & 15) >> 2)) * 64 + ((lane >> 4) & 1) * 32 + (lane & 3) * 8;
#pragma unroll
    for (int dd = 0; dd < 2; ++dd) { const int dn = (wid & 1) * 2 + dd;
        f32x16 acc = f32x16{};
#pragma unroll
        for (int ks = 0; ks < 8; ++ks) {
            const bf16x8 af = *(const LAS bf16x8*)(ap + ks * 32);
            const s16x4 lo = vtr(vb + (dn * 8 + ks) * 1024), hh = vtr(vb + (dn * 8 + ks) * 1024 + 256);
            const bf16x8 vf = (bf16x8){lo[0], lo[1], lo[2], lo[3], hh[0], hh[1], hh[2], hh[3]};
            acc = MIX_MFMA(af, vf, acc); }
        const int d = 32 * dn + r32;
#pragma unroll
        for (int r = 0; r < 16; ++r) { const int t = 32 * tm + crow(r, hi);
            const float uu = bf2f(P[(rowbase + t) * PITCH + COL_U + g * 128 + d]);
            const float val = uu * (acc[r] + bsg[g * 128 + t]);
            MIXO[(rowbase + t) * MIXP + 1024 + g * 128 + d] = (bf16)(cvtpk(val, val) & 0xffffu); }
    }
    asm volatile("s_waitcnt lgkmcnt(0)" ::: "memory"); __builtin_amdgcn_s_barrier(); asm volatile("" ::: "memory");
}
}

constexpr int NWAVES = 8;
constexpr int BATCH = 4, SEQ = 4096, D = 2048, M = BATCH * SEQ, INW = 5120, FF = 8192, NMOD = 6;
constexpr float LN_EPS = 1e-5f;
constexpr float DN_ALPHA = 1.189207115002721f;
constexpr size_t MiB = 1u << 20;
constexpr size_t WS_CTL = 0, CTL_ZERO_BYTES = 64 * 1024;
constexpr size_t WS_MOD = 1 * MiB;
constexpr size_t WS_WIN = 2 * MiB, WS_WOUT = 22 * MiB, WS_W1 = 30 * MiB, WS_W2 = 62 * MiB;
constexpr size_t WS_XN = 94 * MiB;
constexpr size_t WS_PROJ = 158 * MiB;
constexpr size_t WS_MIX = 318 * MiB;
constexpr size_t WS_HID = 158 * MiB;
constexpr size_t WS_END = 414 * MiB;
static_assert(WS_WIN + (size_t)INW * D * 2 <= WS_WOUT && WS_WOUT + (size_t)D * D * 2 <= WS_W1 && WS_W1 + (size_t)FF * D * 2 <= WS_W2 && WS_W2 + (size_t)D * FF * 2 <= WS_XN &&
              WS_XN + (size_t)M * D * 2 <= WS_PROJ && WS_PROJ + (size_t)M * INW * 2 <= WS_MIX && WS_MIX + (size_t)M * D * 2 <= WS_END && WS_HID + (size_t)M * FF * 2 <= WS_END, "d_ws map");
constexpr int CW_BAR = 4096;
constexpr int RING_OFF = 0, RING_BYTES = 131072;
constexpr int LDSCTL_OFF = RING_BYTES, MISC_OFF = LDSCTL_OFF + 320;
constexpr int WSF_OFF = RING_BYTES + 1024;
constexpr int LDS_BYTES = 147456;
static_assert(MISC_OFF + 128 <= WSF_OFF && WSF_OFF + 2048 <= LDS_BYTES, "LDS map");

typedef unsigned short bf16;
typedef unsigned v4u __attribute__((ext_vector_type(4)));
typedef float f32x4 __attribute__((ext_vector_type(4)));
typedef GAS unsigned gu32;
#define RLX_AGENT __ATOMIC_RELAXED, __HIP_MEMORY_SCOPE_AGENT
#define LDS_WAIT() asm volatile("s_waitcnt lgkmcnt(0)" ::: "memory")
#define VM_WAIT() asm volatile("s_waitcnt vmcnt(0)" ::: "memory")
__device__ __forceinline__ unsigned pk2(float lo, float hi) { return pg8::cvt_pk_bf16(lo, hi); }

#define XB_TMO      128
#define XB_XCNT(j)  (256  + 64 * (j))
#define XB_XSUB(j)  (1280 + 64 * (j))
#define XB_XGEN(j)  (2304 + 64 * (j))
#define XB_TOP      3328
#define XB_TOPGEN   3392
#define XCD_BAR_WORDS 3456
#define XB_SPIN_CAP (1u << 18)

__device__ __forceinline__ unsigned xb_ld(unsigned* p)              { return __hip_atomic_load(p, __ATOMIC_RELAXED, __HIP_MEMORY_SCOPE_AGENT); }
__device__ __forceinline__ unsigned xb_add(unsigned* p, unsigned v) { return __hip_atomic_fetch_add(p, v, __ATOMIC_RELAXED, __HIP_MEMORY_SCOPE_AGENT); }
__device__ __forceinline__ unsigned xb_xcc_id() { return (unsigned)__builtin_amdgcn_s_getreg((3 << 11) | 20) & 0xFu; }
#define XB_SPIN(cond, bar) do { unsigned _sp = 0; while (cond) { __builtin_amdgcn_s_sleep(1); \
    if ((++_sp & 255u) == 0u) { if (xb_ld(&(bar)[XB_TMO])) break; if (_sp > XB_SPIN_CAP) { atomicAdd(&(bar)[XB_TMO], 1u); break; } } } } while (0)

struct XcdBarrier {
    unsigned* bar; unsigned x;
    volatile LAS unsigned* st;
};

__device__ __forceinline__ XcdBarrier xcd_barrier_post(unsigned* bar, volatile LAS unsigned* st) {
    XcdBarrier b; b.bar = bar; b.x = xb_xcc_id(); b.st = st;
    if (threadIdx.x == 0) (void)xb_add(&bar[XB_XCNT(b.x)], 1u);
    return b;
}
__device__ __forceinline__ void xcd_barrier_complete(unsigned* bar, unsigned x, unsigned& nloc, unsigned& nx) {
    const unsigned G = gridDim.x * gridDim.y * gridDim.z;
    unsigned sum, cnt, mine, sp = 0u;
    for (;;) {
        sum = 0u; cnt = 0u; mine = 0u;
#pragma unroll
        for (unsigned j = 0; j < 16; ++j) { const unsigned c = xb_ld(&bar[XB_XCNT(j)]); sum += c; cnt += (c > 0u) ? 1u : 0u; mine = (j == x) ? c : mine; }
        if (sum == G) break;
        __builtin_amdgcn_s_sleep(1);
        if ((++sp & 255u) == 0u) { if (xb_ld(&bar[XB_TMO])) break; if (sp > XB_SPIN_CAP) { atomicAdd(&bar[XB_TMO], 1u); break; } }
    }
    nloc = mine > 0u ? mine : 1u; nx = cnt > 0u ? cnt : 1u;
}

__device__ __forceinline__ void xcd_barrier(const XcdBarrier& b) {
    asm volatile("s_waitcnt vmcnt(0)" ::: "memory");
    __syncthreads();
    if (threadIdx.x == 0) {
        unsigned* bar = b.bar;
        __builtin_amdgcn_s_waitcnt(0);
        unsigned nloc = b.st[0], nx = b.st[1];
        if (nloc == 0u) { xcd_barrier_complete(bar, b.x, nloc, nx); b.st[0] = nloc; b.st[1] = nx; }
        const unsigned old = xb_add(&bar[XB_XSUB(b.x)], 1u);
        const unsigned gen = old / nloc;
        if (old + 1u == (gen + 1u) * nloc) {
            __builtin_amdgcn_fence(__ATOMIC_RELEASE, "agent");
            asm volatile("s_waitcnt vmcnt(0)" ::: "memory");
            const unsigned og = xb_add(&bar[XB_TOP], 1u);
            const unsigned tg = og / nx;
            if (og + 1u == (tg + 1u) * nx) xb_add(&bar[XB_TOPGEN], 1u);
            else XB_SPIN(xb_ld(&bar[XB_TOPGEN]) == tg, bar);
            __builtin_amdgcn_fence(__ATOMIC_ACQUIRE, "agent");
            xb_add(&bar[XB_XGEN(b.x)], 1u);
            asm volatile("s_waitcnt vmcnt(0)" ::: "memory");
        } else {
            XB_SPIN(xb_ld(&bar[XB_XGEN(b.x)]) == gen, bar);
            __builtin_amdgcn_fence(__ATOMIC_ACQUIRE, "agent");
            asm volatile("s_waitcnt vmcnt(0)" ::: "memory");
        }
    }
    __syncthreads();
}

struct Frame {
    LAS unsigned char* lds;
    volatile LAS unsigned* MISC;
    gu32* ctl;
    int tid, lane, wave;
    int vcu, G;
    __device__ __forceinline__ void refresh() { tid = fresh_tid(); lane = tid & 63; wave = __builtin_amdgcn_readfirstlane(tid >> 6); }
};
__device__ __forceinline__ float wave_sum(float v) {
#pragma unroll
    for (int o = 1; o < 64; o <<= 1) v += __shfl_xor(v, o);
    return v;
}
__device__ __forceinline__ void p0_transpose_item(const float* W, int K, int N, bf16* WT, LAS float* scr, int item, int lane) {
    const int nblk = N / 32, kb = item / nblk, nb = item % nblk, k0 = 64 * kb, n0 = 32 * nb;
#pragma unroll 8
    for (int i = 0; i < 32; ++i) { const int kk = 2 * i + (lane >> 5); scr[kk * 33 + (lane & 31)] = W[(size_t)(k0 + kk) * N + n0 + (lane & 31)]; }
    LDS_WAIT(); asm volatile("" ::: "memory");
    const int c = lane & 7;
#pragma unroll
    for (int j = 0; j < 4; ++j) { const int n = (lane >> 3) + 8 * j; const LAS float* s = scr + (8 * c) * 33 + n;
        v4u o; o.x = pk2(s[0 * 33], s[1 * 33]); o.y = pk2(s[2 * 33], s[3 * 33]); o.z = pk2(s[4 * 33], s[5 * 33]); o.w = pk2(s[6 * 33], s[7 * 33]);
        *(GAS v4u*)(WT + (size_t)(n0 + n) * K + k0 + 8 * c) = o; }
    LDS_WAIT(); asm volatile("" ::: "memory");
}
__device__ __forceinline__ void p0_mod(Frame& F, const float* cvec, const float* w_ada, const float* b_ada, float* mod) {
    LAS float* sc = (LAS float*)(F.lds + RING_OFF);
    LAS float* red = (LAS float*)(F.lds + RING_OFF + 32768);
    for (int i = F.tid; i < BATCH * D; i += NWAVES * 64) { const float v = cvec[i]; sc[i] = v / (1.0f + __expf(-v)); }
    LDS_WAIT(); __syncthreads();
    const int col = blockIdx.x * 64 + F.lane, kbase = F.wave * 256;
    const float* wp = w_ada + (size_t)kbase * (NMOD * D) + col;
    float a0 = 0.f, a1 = 0.f, a2 = 0.f, a3 = 0.f;
#pragma unroll 16
    for (int k = 0; k < 256; ++k) { const float w = wp[(size_t)k * (NMOD * D)];
        a0 += sc[kbase + k] * w; a1 += sc[D + kbase + k] * w; a2 += sc[2 * D + kbase + k] * w; a3 += sc[3 * D + kbase + k] * w; }
    red[(F.wave * 4 + 0) * 64 + F.lane] = a0; red[(F.wave * 4 + 1) * 64 + F.lane] = a1; red[(F.wave * 4 + 2) * 64 + F.lane] = a2; red[(F.wave * 4 + 3) * 64 + F.lane] = a3;
    LDS_WAIT(); __syncthreads();
    if (F.tid < 256) { const int b = F.tid >> 6, l = F.tid & 63; float s = 0.f;
#pragma unroll
        for (int w = 0; w < 8; ++w) s += red[(w * 4 + b) * 64 + l];
        mod[(size_t)b * (NMOD * D) + blockIdx.x * 64 + l] = s + b_ada[blockIdx.x * 64 + l]; }
    LDS_WAIT(); __syncthreads();
}
struct RowStats { float mean, rstd; };
__device__ __forceinline__ RowStats row_stats(f32x4 (&v)[8]) {
    float s = 0.f;
#pragma unroll
    for (int j = 0; j < 8; ++j) s += (v[j].x + v[j].y) + (v[j].z + v[j].w);
    const float mean = wave_sum(s) * (1.f / D); float s2 = 0.f;
#pragma unroll
    for (int j = 0; j < 8; ++j) { const f32x4 d = v[j] - mean; s2 += (d.x * d.x + d.y * d.y) + (d.z * d.z + d.w * d.w); }
    RowStats r; r.mean = mean; r.rstd = 1.f / sqrtf(wave_sum(s2) * (1.f / D) + LN_EPS); return r;
}
__device__ __forceinline__ void p1_xn(Frame& F, const float* x, const float* mod, bf16* XN) {
    const int gw = F.vcu * NWAVES + F.wave, NGW = F.G * NWAVES;
    for (int m = gw; m < M; m += NGW) {
        const GAS f32x4* xr = (const GAS f32x4*)(x + (size_t)m * D) + F.lane;
        const float* mb = mod + (size_t)(m >> 12) * (NMOD * D);
        f32x4 v[8];
#pragma unroll
        for (int j = 0; j < 8; ++j) v[j] = xr[64 * j];
        const RowStats st = row_stats(v);
        GAS unsigned long long* o8 = (GAS unsigned long long*)(XN + (size_t)m * D) + F.lane;
#pragma unroll
        for (int j = 0; j < 8; ++j) { const f32x4 sh = *((const f32x4*)(mb + 0 * D) + F.lane + 64 * j), sc = *((const f32x4*)(mb + 1 * D) + F.lane + 64 * j);
            const f32x4 y = (v[j] - st.mean) * st.rstd * (sc + 1.0f) + sh;
            o8[64 * j] = (unsigned long long)pk2(y.x, y.y) | ((unsigned long long)pk2(y.z, y.w) << 32); }
    }
}
__device__ __forceinline__ void add_bf16x4(f32x4& v, unsigned long long w, float alpha) {
    const unsigned lo = (unsigned)w, hi = (unsigned)(w >> 32);
    v.x = v.x * alpha + __uint_as_float(lo << 16); v.y = v.y * alpha + __uint_as_float(lo & 0xffff0000u);
    v.z = v.z * alpha + __uint_as_float(hi << 16); v.w = v.w * alpha + __uint_as_float(hi & 0xffff0000u);
}
__device__ __forceinline__ void p5_ln(Frame& F, const float* X, const bf16* G, float* H, const float* lg, const float* lb, const float* mod, bf16* XN) {
    const int gw = F.vcu * NWAVES + F.wave, NGW = F.G * NWAVES;
    for (int m = gw; m < M; m += NGW) {
        const GAS f32x4* xr = (const GAS f32x4*)(X + (size_t)m * D) + F.lane;
        const GAS unsigned long long* gr = (const GAS unsigned long long*)(G + (size_t)m * D) + F.lane;
        GAS f32x4* hr = (GAS f32x4*)(H + (size_t)m * D) + F.lane;
        const float* mb = mod + (size_t)(m >> 12) * (NMOD * D);
        f32x4 v[8]; unsigned long long gq[8];
#pragma unroll
        for (int j = 0; j < 8; ++j) { v[j] = xr[64 * j]; gq[j] = gr[64 * j]; }
#pragma unroll
        for (int j = 0; j < 8; ++j) add_bf16x4(v[j], gq[j], DN_ALPHA);
        const RowStats st = row_stats(v);
#pragma unroll
        for (int j = 0; j < 8; ++j) { const f32x4 g = *((const f32x4*)lg + F.lane + 64 * j), b = *((const f32x4*)lb + F.lane + 64 * j);
            v[j] = (v[j] - st.mean) * st.rstd * g + b; hr[64 * j] = v[j]; }
        const RowStats s2 = row_stats(v);
        GAS unsigned long long* o8 = (GAS unsigned long long*)(XN + (size_t)m * D) + F.lane;
#pragma unroll
        for (int j = 0; j < 8; ++j) { const f32x4 sh = *((const f32x4*)(mb + 3 * D) + F.lane + 64 * j), sc = *((const f32x4*)(mb + 4 * D) + F.lane + 64 * j);
            const f32x4 y = (v[j] - s2.mean) * s2.rstd * (sc + 1.0f) + sh;
            o8[64 * j] = (unsigned long long)pk2(y.x, y.y) | ((unsigned long long)pk2(y.z, y.w) << 32); }
    }
}
__device__ __forceinline__ void p8_ln(Frame& F, float* H, const bf16* G, const float* lg, const float* lb) {
    const int gw = F.vcu * NWAVES + F.wave, NGW = F.G * NWAVES;
    for (int m = gw; m < M; m += NGW) {
        GAS f32x4* yr = (GAS f32x4*)(H + (size_t)m * D) + F.lane;
        const GAS unsigned long long* gr = (const GAS unsigned long long*)(G + (size_t)m * D) + F.lane;
        f32x4 v[8]; unsigned long long gq[8];
#pragma unroll
        for (int j = 0; j < 8; ++j) { v[j] = yr[64 * j]; gq[j] = gr[64 * j]; }
#pragma unroll
        for (int j = 0; j < 8; ++j) add_bf16x4(v[j], gq[j], DN_ALPHA);
        const RowStats st = row_stats(v);
#pragma unroll
        for (int j = 0; j < 8; ++j) { const f32x4 g = *((const f32x4*)lg + F.lane + 64 * j), b = *((const f32x4*)lb + F.lane + 64 * j);
            yr[64 * j] = (v[j] - st.mean) * st.rstd * g + b; }
    }
}

#define REP_P0 1
#define REP_P1 1
#define REP_P2 1
#define REP_P3A 1
#define REP_P3G 1
#define REP_P4 1
#define REP_P6 1
#define REP_P7X 0
constexpr size_t WS_SCRATCH = 414 * MiB;
struct Args { const float* in[21]; float* out; unsigned char* ws; };
__global__ void __launch_bounds__(NWAVES * 64, 2) fwd_megakernel(Args args) {
    extern __shared__ __attribute__((aligned(16))) unsigned char lds[];
    Frame F;
    F.lds = (LAS unsigned char*)lds;
    F.MISC = (volatile LAS unsigned*)(F.lds + MISC_OFF);
    F.refresh();
    F.G = gridDim.x; { const int bx = blockIdx.x; F.vcu = (F.G % 8 == 0) ? (bx % 8) * (F.G / 8) + bx / 8 : bx; }
    unsigned char* ws = args.ws;
    F.ctl = (gu32*)(ws + WS_CTL);
    const float* x = args.in[0]; const float* cvec = args.in[1]; const float* w_ada = args.in[2]; const float* b_ada = args.in[3]; const float* w_in = args.in[4];
    const float* lq1 = args.in[5]; const float* lk1 = args.in[6]; const float* lq2 = args.in[7]; const float* lk2 = args.in[8]; const float* subg = args.in[9];
    const float* gln_g = args.in[10]; const float* gln_b = args.in[11]; const float* g_ws = args.in[12]; const float* g_bs = args.in[13]; const float* w_out = args.in[14];
    const float* ln1_g = args.in[15]; const float* ln1_b = args.in[16]; const float* w_ff1 = args.in[17]; const float* w_ff2 = args.in[18]; const float* ln2_g = args.in[19]; const float* ln2_b = args.in[20];
    float* out = args.out;
    float* MOD = (float*)(ws + WS_MOD);
    bf16* Win_t = (bf16*)(ws + WS_WIN); bf16* Wout_t = (bf16*)(ws + WS_WOUT); bf16* W1_t = (bf16*)(ws + WS_W1); bf16* W2_t = (bf16*)(ws + WS_W2);
    bf16* XN = (bf16*)(ws + WS_XN); bf16* PROJ = (bf16*)(ws + WS_PROJ); bf16* MIXB = (bf16*)(ws + WS_MIX); bf16* HID = (bf16*)(ws + WS_HID);
    bf16* GMIX = (bf16*)(ws + WS_PROJ);
    for (int u = F.tid; u < (LDS_BYTES - LDSCTL_OFF) / 4; u += NWAVES * 64) ((LAS unsigned*)(F.lds + LDSCTL_OFF))[u] = 0u;
    __syncthreads();
    XcdBarrier bar = xcd_barrier_post((unsigned*)(F.ctl + CW_BAR), F.MISC + 8);
#define GRID_BAR() xcd_barrier(bar)

    for (int rep = 0; rep < REP_P0; ++rep) {
        if (blockIdx.x < (NMOD * D) / 64) p0_mod(F, cvec, w_ada, b_ada, MOD);
        F.refresh();
        LAS float* scr = (LAS float*)(F.lds + RING_OFF + F.wave * 16384);
        const int gw = F.vcu * NWAVES + F.wave, NGW = F.G * NWAVES;
        constexpr int I_IN = (D / 64) * (INW / 32), I_O = (D / 64) * (D / 32), I_1 = (D / 64) * (FF / 32), I_2 = (FF / 64) * (D / 32);
        constexpr int NITEMS = I_IN + I_O + I_1 + I_2;
        for (int it = gw; it < NITEMS; it += NGW) {
            int r = it;
            if (r < I_IN) { p0_transpose_item(w_in, D, INW, Win_t, scr, r, F.lane); continue; } r -= I_IN;
            if (r < I_O) { p0_transpose_item(w_out, D, D, Wout_t, scr, r, F.lane); continue; } r -= I_O;
            if (r < I_1) { p0_transpose_item(w_ff1, D, FF, W1_t, scr, r, F.lane); continue; } r -= I_1;
            p0_transpose_item(w_ff2, FF, D, W2_t, scr, r, F.lane);
        }
        GRID_BAR();
    }
    for (int rep = 0; rep < REP_P1; ++rep) { F.refresh(); p1_xn(F, x, MOD, XN);
    GRID_BAR(); }
    for (int rep = 0; rep < REP_P2; ++rep) {
        pg8::Gemm g{XN, Win_t, M, INW, D}; pg8::StaticOrder S; S.init(M, INW, F.G, (int)blockIdx.x);
        pg8::EpiProj E{PROJ, INW};
        pg8::gemm_phase<pg8::EpiProj, pg8::StaticOrder, true, true>(F.lds + RING_OFF, g, S, E);
        GRID_BAR();
    }
    {
        F.refresh();
        float lam;
        { const float a = lq1[F.lane] * lk1[F.lane], b = lq2[F.lane] * lk2[F.lane];
          lam = __expf(wave_sum(a)) - __expf(wave_sum(b)) + 0.2f; }
        LAS float* wsf = (LAS float*)(F.lds + WSF_OFF);
        const int bh = F.vcu >> 3, s = F.vcu & 7;
        for (int rep = 0; rep < REP_P3A; ++rep)
        for (int i = 0; i < 4; ++i) { const int qb = (i == 0) ? s : (i == 1) ? 15 - s : (i == 2) ? 16 + s : 31 - s;
            mix::attn_unit(bh >> 3, bh & 7, qb, PROJ, MIXB, F.lds + RING_OFF, wsf, lam, subg); }
        const int gg = F.vcu >> 5;
        for (int rep = 0; rep < REP_P3G; ++rep) {
        mix::gmlp_load_wm(g_ws + (size_t)gg * 128 * 128, F.lds + RING_OFF);
        for (int i = 0; i < 4; ++i) { const int idx = (F.vcu & 31) * 4 + i;
            mix::gmlp_item(idx >> 5, idx & 31, gg, PROJ, MIXB, F.lds + RING_OFF, gln_g, gln_b, g_bs); } }
        GRID_BAR();
    }
    for (int rep = 0; rep < REP_P4; ++rep) {
        pg8::Gemm g{MIXB, Wout_t, M, D, D}; pg8::StaticOrder S; S.init(M, D, F.G, (int)blockIdx.x);
        pg8::EpiGate E{GMIX, D, MOD + 2 * D, NMOD * D};
        pg8::gemm_phase<pg8::EpiGate, pg8::StaticOrder, true, true>(F.lds + RING_OFF, g, S, E);
        GRID_BAR();
    }
    F.refresh(); p5_ln(F, x, GMIX, out, ln1_g, ln1_b, MOD, XN);
    GRID_BAR();
    for (int rep = 0; rep < REP_P6; ++rep) {
        pg8::Gemm g{XN, W1_t, M, FF, D}; pg8::StaticOrder S; S.init(M, FF, F.G, (int)blockIdx.x);
        pg8::EpiRelu2 E{HID, FF};
        pg8::gemm_phase<pg8::EpiRelu2, pg8::StaticOrder, true, true>(F.lds + RING_OFF, g, S, E);
        GRID_BAR();
    }
    for (int rep = 0; rep < REP_P7X; ++rep) {
        pg8::Gemm g{HID, W2_t, M, D, FF}; pg8::StaticOrder S; S.init(M, D, F.G, (int)blockIdx.x);
        pg8::EpiRelu2 E{(bf16*)(ws + WS_SCRATCH), D};
        pg8::gemm_phase<pg8::EpiRelu2, pg8::StaticOrder, true, true>(F.lds + RING_OFF, g, S, E);
        GRID_BAR();
    }
    {
        pg8::Gemm g{HID, W2_t, M, D, FF}; pg8::StaticOrder S; S.init(M, D, F.G, (int)blockIdx.x);
        pg8::EpiGate E{XN, D, MOD + 5 * D, NMOD * D};
        pg8::gemm_phase<pg8::EpiGate, pg8::StaticOrder, true, true>(F.lds + RING_OFF, g, S, E);
        GRID_BAR();
    }
    F.refresh(); p8_ln(F, out, XN, ln2_g, ln2_b);
#undef GRID_BAR
}

extern "C" void kernel_launch(void* const* d_in, const int* in_sizes, int n_in, void* d_out, int out_size, void* d_ws, size_t ws_size, hipStream_t stream) {
    static int grid = 0;
    if (grid == 0) {
        if (n_in != 21 || in_sizes[0] != M * D || out_size != M * D || ws_size < WS_END + 64 * MiB) { fprintf(stderr, "kernel_launch: built for 21 inputs, x and out of %d floats, >= %zu bytes of workspace; got n_in %d, in0 %d, out %d, ws %zu; nothing launched\n", M * D, (size_t)WS_END, n_in, n_in > 0 ? in_sizes[0] : -1, out_size, ws_size); grid = -1; return; }
        int dev = 0, cus = 0, per_cu = 0;
        if (hipGetDevice(&dev) != hipSuccess || hipDeviceGetAttribute(&cus, hipDeviceAttributeMultiprocessorCount, dev) != hipSuccess) { fprintf(stderr, "kernel_launch: hipGetDevice / hipDeviceGetAttribute failed\n"); grid = -1; return; }
        if (hipFuncSetAttribute((const void*)fwd_megakernel, hipFuncAttributeMaxDynamicSharedMemorySize, LDS_BYTES) != hipSuccess) { fprintf(stderr, "kernel_launch: hipFuncSetAttribute failed\n"); grid = -1; return; }
        if (hipOccupancyMaxActiveBlocksPerMultiprocessor(&per_cu, (const void*)fwd_megakernel, NWAVES * 64, LDS_BYTES) != hipSuccess || per_cu < 1)
            fprintf(stderr, "kernel_launch: note: the occupancy query reports %d workgroups per CU\n", per_cu);
        (void)hipGetLastError();
        grid = cus;
        if (grid != 256) fprintf(stderr, "kernel_launch: launching %d workgroups (built for 256 CUs)\n", grid);
    }
    if (grid < 0) return;
    if (hipMemsetAsync((char*)d_ws + WS_CTL, 0, CTL_ZERO_BYTES, stream) != hipSuccess) { fprintf(stderr, "kernel_launch: hipMemsetAsync of the control words failed\n"); return; }
    Args a{};
    for (int i = 0; i < 21; ++i) a.in[i] = (const float*)d_in[i];
    a.out = (float*)d_out; a.ws = (unsigned char*)d_ws;
    hipLaunchKernelGGL(fwd_megakernel, dim3(grid), dim3(NWAVES * 64), LDS_BYTES, stream, a);
    const hipError_t le = hipPeekAtLastError();
    if (le != hipSuccess) fprintf(stderr, "kernel_launch: launch failed: %s (grid %d x %d threads, %d B LDS)\n", hipGetErrorName(le), grid, NWAVES * 64, LDS_BYTES);
}
```

```cpp
#include <hip/hip_runtime.h>
#include <hip/hip_bf16.h>
#include <cstdio>
#include <cstdint>
#include <cmath>
__device__ __forceinline__ int fresh_tid() { int t = threadIdx.x; asm volatile("" : "+v"(t)); return t; }
namespace pg8 {
#define PG8_LAS __attribute__((address_space(3)))
typedef unsigned short bf16_t;
typedef short bf16x8 __attribute__((ext_vector_type(8)));
typedef float f32x4 __attribute__((ext_vector_type(4)));
typedef unsigned u32x4 __attribute__((ext_vector_type(4)));
constexpr int BM = 256, BK = 64, HALF = 128, HTB = HALF * BK * 2  , STAGE_BYTES = 8 * HTB, NXCD = 8, WGM = 8;

__host__ __device__ __forceinline__ int lds_byte(int r, int c) { const int st = (r >> 4) * 2 + (c >> 5), rr = r & 15, cc = c & 31, ob = rr * 64 + cc * 2; return st * 1024 + (ob ^ (((ob >> 9) & 1) << 5)); }
__host__ __device__ __forceinline__ void stage_rc(int b, int& R, int& C) { const int st = b / 1024, sb = b % 1024, swz = sb ^ (((sb >> 9) & 1) << 5); R = (st >> 1) * 16 + swz / 64; C = (st & 1) * 32 + (swz % 64) / 2; }
__host__ __device__ __forceinline__ int perm32(int rho) { const int n = rho >> 4, i = rho & 15; return 8 * (i >> 2) + 4 * n + (i & 3); }

struct Unit { int pm, pn; };
struct Gemm { const bf16_t* A; const bf16_t* Bt; int M, N, K; };

struct StaticOrder {
    int nM, nN, nwg, G, c;
    __host__ __device__ void init(int M, int N, int G_, int c_) { nM = M / BM; nN = N / BM; nwg = nM * nN; G = G_; c = c_; }
    __host__ __device__ bool next(int i, Unit& u) const {
        const long L = (long)i * G + c; if (L >= nwg) return false;
        int wgid = (int)L; { const int q = nwg / NXCD, r = nwg % NXCD, xcd = wgid % NXCD, off = wgid / NXCD; wgid = (xcd < r ? xcd * (q + 1) : r * (q + 1) + (xcd - r) * q) + off; }
        const int nig = WGM * nN, gid = wgid / nig, fm = gid * WGM, gsz = (nM - fm) < WGM ? (nM - fm) : WGM;
        u.pm = fm + ((wgid % nig) % gsz); u.pn = (wgid % nig) / gsz; return true;
    }
    __device__ __forceinline__ void a_ready(const Unit&) const {}
    __device__ __forceinline__ void done(const Unit&) const {}
};


typedef float f32x2 __attribute__((ext_vector_type(2)));
typedef __bf16 bf16x2_t __attribute__((ext_vector_type(2)));
__device__ __forceinline__ unsigned cvt_pk_bf16(float lo, float hi) { f32x2 v = {lo, hi}; bf16x2_t b = __builtin_convertvector(v, bf16x2_t); return __builtin_bit_cast(unsigned, b); }
__device__ __forceinline__ float gelu_tanh(float x) {
    const float c1 = 2.0f * 0.7978845608028654f * 1.4426950408889634f, c2 = c1 * 0.044715f;
    const float z2 = x * (c1 + c2 * x * x);
    const float e = __builtin_amdgcn_exp2f(-z2);
    return x * __builtin_amdgcn_rcpf(1.0f + e);
}
constexpr float ATT_C2 = 0.125f * 1.4426950408889634f;

struct EpiProj {
    static constexpr bool PERM = true, AFTER_DRAIN = false;
    bf16_t* O; int ldc;
    __device__ __forceinline__ void operator()(const f32x4 (&acc)[2][2][4][2], const Unit& u, int wr, int wc, int fr, int fq) const {
        const int row0 = u.pm * BM + wr * 64 + fr, col0 = u.pn * BM + wc * 32 + 8 * fq;
        const int mode = u.pn < 4 ? 0 : (u.pn < 12 ? 1 : 2);
#pragma unroll
        for (int ai = 0; ai < 2; ++ai)
#pragma unroll
            for (int m = 0; m < 4; ++m) { bf16_t* rowp = O + (size_t)(row0 + ai * HALF + m * 16) * ldc + col0;
#pragma unroll
                for (int bj = 0; bj < 2; ++bj) { f32x4 v0 = acc[ai][bj][m][0], v1 = acc[ai][bj][m][1];
                    if (mode == 0) { v0 = v0 * ATT_C2; v1 = v1 * ATT_C2; }
                    else if (mode == 2) {
#pragma unroll
                        for (int j = 0; j < 4; ++j) { v0[j] = gelu_tanh(v0[j]); v1[j] = gelu_tanh(v1[j]); } }
                    u32x4 w; w.x = cvt_pk_bf16(v0[0], v0[1]); w.y = cvt_pk_bf16(v0[2], v0[3]); w.z = cvt_pk_bf16(v1[0], v1[1]); w.w = cvt_pk_bf16(v1[2], v1[3]);
                    *(u32x4*)(rowp + bj * HALF) = w; } }
    }
};
struct EpiRelu2 {
    static constexpr bool PERM = true, AFTER_DRAIN = false;
    bf16_t* O; int ldc;
    __device__ __forceinline__ void operator()(const f32x4 (&acc)[2][2][4][2], const Unit& u, int wr, int wc, int fr, int fq) const {
        const int row0 = u.pm * BM + wr * 64 + fr, col0 = u.pn * BM + wc * 32 + 8 * fq;
#pragma unroll
        for (int ai = 0; ai < 2; ++ai)
#pragma unroll
            for (int m = 0; m < 4; ++m) { bf16_t* rowp = O + (size_t)(row0 + ai * HALF + m * 16) * ldc + col0;
#pragma unroll
                for (int bj = 0; bj < 2; ++bj) { f32x4 v0 = acc[ai][bj][m][0], v1 = acc[ai][bj][m][1];
#pragma unroll
                    for (int j = 0; j < 4; ++j) { const float a = __builtin_fmaxf(v0[j], 0.f), b = __builtin_fmaxf(v1[j], 0.f); v0[j] = a * a; v1[j] = b * b; }
                    u32x4 w; w.x = cvt_pk_bf16(v0[0], v0[1]); w.y = cvt_pk_bf16(v0[2], v0[3]); w.z = cvt_pk_bf16(v1[0], v1[1]); w.w = cvt_pk_bf16(v1[2], v1[3]);
                    *(u32x4*)(rowp + bj * HALF) = w; } }
    }
};
struct EpiGate {
    static constexpr bool PERM = true, AFTER_DRAIN = false;
    bf16_t* O; int ldc; const float* gate; int gate_stride;
    __device__ __forceinline__ void operator()(const f32x4 (&acc)[2][2][4][2], const Unit& u, int wr, int wc, int fr, int fq) const {
        const int row0 = u.pm * BM + wr * 64 + fr, col0 = u.pn * BM + wc * 32 + 8 * fq;
        const float* gp = gate + (size_t)(u.pm >> 4) * gate_stride + col0;
        f32x4 gv[2][2];
#pragma unroll
        for (int bj = 0; bj < 2; ++bj)
#pragma unroll
            for (int n = 0; n < 2; ++n) gv[bj][n] = *(const f32x4*)(gp + bj * HALF + n * 4) + 1.0f;
#pragma unroll
        for (int ai = 0; ai < 2; ++ai)
#pragma unroll
            for (int m = 0; m < 4; ++m) { bf16_t* rowp = O + (size_t)(row0 + ai * HALF + m * 16) * ldc + col0;
#pragma unroll
                for (int bj = 0; bj < 2; ++bj) { const f32x4 v0 = acc[ai][bj][m][0] * gv[bj][0], v1 = acc[ai][bj][m][1] * gv[bj][1];
                    u32x4 w; w.x = cvt_pk_bf16(v0[0], v0[1]); w.y = cvt_pk_bf16(v0[2], v0[3]); w.z = cvt_pk_bf16(v1[0], v1[1]); w.w = cvt_pk_bf16(v1[2], v1[3]);
                    *(u32x4*)(rowp + bj * HALF) = w; } }
    }
};
struct EpiRes {
    static constexpr bool PERM = false, AFTER_DRAIN = false;
    const float* base; float* out; const float* gate; int gate_stride; float alpha; int ldc;
    __device__ __forceinline__ void operator()(const f32x4 (&acc)[2][2][4][2], const Unit& u, int wr, int wc, int fr, int fq) const {
        const int row0 = u.pm * BM + wr * 64 + fr, col0 = u.pn * BM + wc * 32 + 4 * fq;
        const float* gp = gate + (size_t)(u.pm >> 4) * gate_stride + col0;
        f32x4 gv[2][2];
#pragma unroll
        for (int bj = 0; bj < 2; ++bj)
#pragma unroll
            for (int n = 0; n < 2; ++n) gv[bj][n] = *(const f32x4*)(gp + bj * HALF + n * 16) + 1.0f;
        f32x4 cur[2][2], nxt[2][2];
#pragma unroll
        for (int bj = 0; bj < 2; ++bj)
#pragma unroll
            for (int n = 0; n < 2; ++n) cur[bj][n] = *(const f32x4*)(base + (size_t)row0 * ldc + col0 + bj * HALF + n * 16);
#pragma unroll
        for (int idx = 0; idx < 8; ++idx) { const int ai = idx >> 2, m = idx & 3; const size_t off = (size_t)(row0 + ai * HALF + m * 16) * ldc + col0;
            if (idx + 1 < 8) { const size_t offn = (size_t)(row0 + ((idx + 1) >> 2) * HALF + ((idx + 1) & 3) * 16) * ldc + col0;
#pragma unroll
                for (int bj = 0; bj < 2; ++bj)
#pragma unroll
                    for (int n = 0; n < 2; ++n) nxt[bj][n] = *(const f32x4*)(base + offn + bj * HALF + n * 16); }
#pragma unroll
            for (int bj = 0; bj < 2; ++bj)
#pragma unroll
                for (int n = 0; n < 2; ++n) { *(f32x4*)(out + off + bj * HALF + n * 16) = cur[bj][n] * alpha + gv[bj][n] * acc[ai][bj][m][n]; cur[bj][n] = nxt[bj][n]; }
        }
    }
};

template <class Epi, class Sched, bool ALIGN_EPI = false, bool SP2 = false>
__device__ __forceinline__ void gemm_phase(PG8_LAS unsigned char* lds, const Gemm g, const Sched& S, const Epi& E) {
    const int tid = fresh_tid(), wid = __builtin_amdgcn_readfirstlane(tid >> 6), lane = tid & 63, wr = wid >> 2, wc = wid & 3, fr = lane & 15, fq = lane >> 4;
    const int K = g.K, nt = K / BK;
    unsigned voffA[2], voffB[2];
#pragma unroll
    for (int i = 0; i < 2; ++i) { int R, C; stage_rc(tid * 16 + i * 8192, R, C); const int Rb = Epi::PERM ? ((R & ~31) + perm32(R & 31)) : R;
        voffA[i] = (unsigned)(R * K + C) * 2u; voffB[i] = (unsigned)(Rb * K + C) * 2u; }
    const size_t kstep = (size_t)(BK * 2);
    const size_t hstep = (size_t)HALF * K * 2;
    const size_t tstep = 2 * hstep;
    const unsigned ldsw = (unsigned)wid * 1024u;
    const int aoff = lds_byte(wr * 64 + fr, fq * 8), boff = lds_byte(wc * 32 + fr, fq * 8);
#define PG8_SA(b, h) (((b) * 2 + (h)) * HTB)
#define PG8_SB(b, h) ((4 + (b) * 2 + (h)) * HTB)
#define PG8_STAGE(bufoff, gbase, voff) do { _Pragma("unroll") for (int _i = 0; _i < 2; ++_i) \
        __builtin_amdgcn_global_load_lds((const unsigned*)((const char*)(gbase) + (voff)[_i]), (PG8_LAS unsigned*)(lds + (bufoff) + ldsw + _i * 8192), 16, 0, 0); } while (0)
#define PG8_LDA(dst, b, h) do { _Pragma("unroll") for (int m = 0; m < 4; ++m) _Pragma("unroll") for (int k = 0; k < 2; ++k) dst[m][k] = *(const PG8_LAS bf16x8*)(lds + PG8_SA(b, h) + aoff + m * 2048 + k * 1024); } while (0)
#define PG8_LDB(dst, b, h) do { _Pragma("unroll") for (int n = 0; n < 2; ++n) _Pragma("unroll") for (int k = 0; k < 2; ++k) dst[n][k] = *(const PG8_LAS bf16x8*)(lds + PG8_SB(b, h) + boff + n * 2048 + k * 1024); } while (0)
#define PG8_MMA(ai, bj, At, Bt) do { __builtin_amdgcn_s_setprio(1); _Pragma("unroll") for (int m = 0; m < 4; ++m) _Pragma("unroll") for (int n = 0; n < 2; ++n) _Pragma("unroll") for (int k = 0; k < 2; ++k) \
        acc[ai][bj][m][n] = __builtin_amdgcn_mfma_f32_16x16x32_bf16(Bt[n][k], At[m][k], acc[ai][bj][m][n], 0, 0, 0); __builtin_amdgcn_s_setprio(0); } while (0)
#define PG8_WAIT_V(n) asm volatile("s_waitcnt vmcnt(" #n ")" ::: "memory")
#define PG8_WAIT_L(n) asm volatile("s_waitcnt lgkmcnt(" #n ")" ::: "memory")
#define PG8_BAR __builtin_amdgcn_s_barrier()
#define PG8_SCHED __builtin_amdgcn_sched_barrier(0)
    Unit cur, nxt; int ui = 0;
    if (!S.next(0, cur)) return;
    f32x4 acc[2][2][4][2];
#pragma unroll
    for (int a = 0; a < 2; ++a)
#pragma unroll
        for (int b = 0; b < 2; ++b)
#pragma unroll
            for (int m = 0; m < 4; ++m)
#pragma unroll
                for (int n = 0; n < 2; ++n) acc[a][b][m][n] = (f32x4){0.f, 0.f, 0.f, 0.f};
    bf16x8 At[4][2], B0[2][2], B1[2][2];
    const char* cA = (const char*)g.A + (size_t)cur.pm * tstep; const char* cB = (const char*)g.Bt + (size_t)cur.pn * tstep;
    S.a_ready(cur);
    if constexpr (SP2) {
        PG8_STAGE(PG8_SB(0, 0), cB, voffB); PG8_STAGE(PG8_SB(0, 1), cB + hstep, voffB); PG8_STAGE(PG8_SA(0, 0), cA, voffA); PG8_STAGE(PG8_SA(0, 1), cA + hstep, voffA);
        if (wr == 1) PG8_BAR;
        PG8_WAIT_V(2); PG8_BAR;
        PG8_STAGE(PG8_SB(1, 0), cB + kstep, voffB); PG8_STAGE(PG8_SA(1, 0), cA + kstep, voffA); PG8_STAGE(PG8_SB(1, 1), cB + hstep + kstep, voffB);
        PG8_WAIT_V(6); PG8_BAR;
    } else {
        PG8_STAGE(PG8_SB(0, 0), cB, voffB); PG8_STAGE(PG8_SA(0, 0), cA, voffA); PG8_STAGE(PG8_SB(0, 1), cB + hstep, voffB); PG8_STAGE(PG8_SA(0, 1), cA + hstep, voffA);
        if (wr == 1) PG8_BAR;
        PG8_WAIT_V(4); PG8_BAR;
        PG8_STAGE(PG8_SB(1, 0), cB + kstep, voffB); PG8_STAGE(PG8_SA(1, 0), cA + kstep, voffA); PG8_STAGE(PG8_SB(1, 1), cB + hstep + kstep, voffB);
        PG8_WAIT_V(6); PG8_BAR;
    }
    for (;;) {
        const bool has_next = S.next(ui + 1, nxt);
        const char* nA = has_next ? (const char*)g.A + (size_t)nxt.pm * tstep : cA; const char* nB = has_next ? (const char*)g.Bt + (size_t)nxt.pn * tstep : cB;
        for (int t = 0; t < nt; t += 2) {
            const bool last = (t == nt - 2);
            const char* a1 = cA + (size_t)(t + 1) * kstep;
            const char* a2 = last ? nA : cA + (size_t)(t + 2) * kstep; const char* b2 = last ? nB : cB + (size_t)(t + 2) * kstep;
            const char* a3 = a2 + kstep; const char* b3 = b2 + kstep;
            if (last && has_next) S.a_ready(nxt);
            if constexpr (SP2) {
            PG8_LDB(B0, 0, 0); PG8_LDB(B1, 0, 1); PG8_SCHED; PG8_LDA(At, 0, 0); PG8_STAGE(PG8_SA(1, 1), a1 + hstep, voffA);
            PG8_WAIT_V(8); PG8_WAIT_L(0); PG8_BAR; PG8_MMA(0, 0, At, B0); PG8_MMA(0, 1, At, B1); PG8_BAR; PG8_SCHED;
            PG8_LDA(At, 0, 1); PG8_STAGE(PG8_SB(0, 0), b2, voffB); PG8_STAGE(PG8_SB(0, 1), b2 + hstep, voffB); PG8_STAGE(PG8_SA(0, 0), a2, voffA);
            PG8_WAIT_V(8); PG8_WAIT_L(0); PG8_BAR; PG8_MMA(1, 0, At, B0); PG8_MMA(1, 1, At, B1); PG8_BAR; PG8_SCHED;
            PG8_LDB(B0, 1, 0); PG8_LDB(B1, 1, 1); PG8_SCHED; PG8_LDA(At, 1, 0); PG8_STAGE(PG8_SA(0, 1), a2 + hstep, voffA);
            PG8_WAIT_V(8); PG8_WAIT_L(0); PG8_BAR; PG8_MMA(0, 0, At, B0); PG8_MMA(0, 1, At, B1); PG8_BAR; PG8_SCHED;
            PG8_LDA(At, 1, 1); PG8_STAGE(PG8_SB(1, 0), b3, voffB); PG8_STAGE(PG8_SB(1, 1), b3 + hstep, voffB); PG8_STAGE(PG8_SA(1, 0), a3, voffA);
            PG8_WAIT_V(8); PG8_WAIT_L(0); PG8_BAR; PG8_MMA(1, 0, At, B0); PG8_MMA(1, 1, At, B1); PG8_BAR; PG8_SCHED;
            } else {
            PG8_LDB(B0, 0, 0); PG8_SCHED; PG8_LDA(At, 0, 0); PG8_STAGE(PG8_SA(1, 1), a1 + hstep, voffA);
            PG8_WAIT_L(8); PG8_BAR; PG8_WAIT_L(0); PG8_MMA(0, 0, At, B0); PG8_BAR; PG8_SCHED;
            PG8_LDB(B1, 0, 1); PG8_STAGE(PG8_SB(0, 0), b2, voffB);
            PG8_BAR; PG8_WAIT_L(0); PG8_MMA(0, 1, At, B1); PG8_BAR;
            PG8_LDA(At, 0, 1); PG8_STAGE(PG8_SA(0, 0), a2, voffA);
            PG8_BAR; PG8_WAIT_L(0); PG8_MMA(1, 0, At, B0); PG8_BAR; PG8_SCHED;
            PG8_STAGE(PG8_SB(0, 1), b2 + hstep, voffB);
            PG8_WAIT_V(6); PG8_BAR; PG8_MMA(1, 1, At, B1); PG8_BAR;
            PG8_LDB(B0, 1, 0); PG8_SCHED; PG8_LDA(At, 1, 0); PG8_STAGE(PG8_SA(0, 1), a2 + hstep, voffA);
            PG8_WAIT_L(8); PG8_BAR; PG8_WAIT_L(0); PG8_MMA(0, 0, At, B0); PG8_BAR; PG8_SCHED;
            PG8_LDB(B1, 1, 1); PG8_STAGE(PG8_SB(1, 0), b3, voffB);
            PG8_BAR; PG8_WAIT_L(0); PG8_MMA(0, 1, At, B1); PG8_BAR;
            PG8_LDA(At, 1, 1); PG8_STAGE(PG8_SA(1, 0), a3, voffA);
            PG8_BAR; PG8_WAIT_L(0); PG8_MMA(1, 0, At, B0); PG8_BAR; PG8_SCHED;
            PG8_STAGE(PG8_SB(1, 1), b3 + hstep, voffB);
            PG8_WAIT_V(6); PG8_BAR; PG8_MMA(1, 1, At, B1); PG8_BAR;
            }
        }
        if constexpr (ALIGN_EPI) { if (wr == 0) PG8_BAR; }
        if constexpr (!Epi::AFTER_DRAIN) { E(acc, cur, wr, wc, fr, fq); S.done(cur); }
        if (!has_next) break;
#pragma unroll
        for (int a = 0; a < 2; ++a)
#pragma unroll
            for (int b = 0; b < 2; ++b)
#pragma unroll
                for (int m = 0; m < 4; ++m)
#pragma unroll
                    for (int n = 0; n < 2; ++n) acc[a][b][m][n] = (f32x4){0.f, 0.f, 0.f, 0.f};
        cur = nxt; cA = nA; cB = nB; ++ui;
        if constexpr (ALIGN_EPI) { if (wr == 1) PG8_BAR; }
    }
    PG8_WAIT_V(0);
    if constexpr (!ALIGN_EPI) { if (wr == 0) PG8_BAR; }
    PG8_BAR;
    if constexpr (Epi::AFTER_DRAIN) { E.fused(acc, cur, wr, wc, fr, fq, lds, wid, lane); S.done(cur); }
#undef PG8_SA
#undef PG8_SB
#undef PG8_STAGE
#undef PG8_LDA
#undef PG8_LDB
#undef PG8_MMA
#undef PG8_WAIT_V
#undef PG8_WAIT_L
#undef PG8_BAR
#undef PG8_SCHED
}
}

#define LAS __attribute__((address_space(3)))
#define GAS __attribute__((address_space(1)))
namespace mix {
typedef unsigned short bf16;
typedef short bf16x8 __attribute__((ext_vector_type(8)));
typedef short s16x4 __attribute__((ext_vector_type(4)));
typedef short v4i16_t __attribute__((ext_vector_type(4)));
typedef float f32x16 __attribute__((ext_vector_type(16)));
typedef float f32x4 __attribute__((ext_vector_type(4)));
typedef unsigned u32x4 __attribute__((ext_vector_type(4)));
typedef LAS const char* lds_cptr;
constexpr int PITCH = 5120, SEQ = 4096, MIXP = 2048;
constexpr int COL_K = 1024, COL_V = 2048, COL_U = 3072, COL_G = 4096;
__device__ __forceinline__ int crow(int r, int hi) { return (r & 3) + 8 * (r >> 2) + 4 * hi; }
__device__ __forceinline__ unsigned cvtpk(float lo, float hi) { return pg8::cvt_pk_bf16(lo, hi); }
__device__ __forceinline__ float bf2f(unsigned short v) { return __uint_as_float((unsigned)v << 16); }
__device__ __forceinline__ void glds16(const void* gsrc, unsigned lds_dst) { unsigned keep;
    asm volatile("s_mov_b32 %0, m0\n\ts_mov_b32 m0, %2\n\ts_nop 0\n\tglobal_load_lds_dwordx4 %1, off\n\ts_mov_b32 m0, %0" : "=&s"(keep) : "v"(gsrc), "s"(lds_dst) : "memory"); }
__device__ __forceinline__ s16x4 vtr(lds_cptr p) { return __builtin_bit_cast(s16x4, __builtin_amdgcn_ds_read_tr16_b64_v4i16((LAS v4i16_t*)p)); }
#define MIX_MX3(a, b, c) __builtin_fmaxf(__builtin_fmaxf((a), (b)), (c))
__device__ __forceinline__ float rowmax(const f32x16& p0, const f32x16& p1) {
    float a = MIX_MX3(p0[0], p0[1], p1[0]), b = MIX_MX3(p0[2], p0[3], p1[1]); a = MIX_MX3(a, p1[2], p1[3]);
#pragma unroll
    for (int r = 4; r < 16; r += 4) { a = MIX_MX3(a, p0[r], p0[r + 1]); b = MIX_MX3(b, p0[r + 2], p0[r + 3]); a = MIX_MX3(a, p1[r], p1[r + 1]); b = MIX_MX3(b, p1[r + 2], p1[r + 3]); }
    float m = __builtin_fmaxf(a, b); auto rr = __builtin_amdgcn_permlane32_swap(__float_as_uint(m), __float_as_uint(m), false, false);
    return __builtin_fmaxf(__uint_as_float(rr[0]), __uint_as_float(rr[1])); }
#define MIX_MFMA(a, b, c) __builtin_amdgcn_mfma_f32_32x32x16_bf16(a, b, c, 0, 0, 0)

constexpr int SLOTB = 16384, A_NSLOT = 3, A_LDS_K = 0, A_LDS_V = A_NSLOT * SLOTB;
#define MIX_SBAR() __builtin_amdgcn_sched_barrier(0)
#define MIX_PIN(x) asm volatile("" : "+v"(x))
#define ATT_THRL 2.0f
__device__ __forceinline__ void attn_unit(int b, int h, int qb, const bf16* P, bf16* MIXO, LAS unsigned char* lds, LAS float* wsf_all, float lam, const float* subg) {
    const int tid = fresh_tid(), lane = tid & 63, r32 = lane & 31, hi = lane >> 5; const int wid = __builtin_amdgcn_readfirstlane(tid >> 6);
    const int c = wid >> 2, g = wid & 3;
    const long rowbase = (long)b * SEQ; const int q0 = qb * 128;
    const int NT = 2 * qb + 2;
    const bf16* Qw = P + (rowbase + q0 + g * 32) * PITCH + h * 128 + c * 64;
    const bf16* Kh = P + rowbase * PITCH + COL_K + h * 128;
    const bf16* Vh = P + rowbase * PITCH + COL_V + h * 128;
    const unsigned lds0 = (unsigned)(uintptr_t)lds;
    LAS float* wsf = wsf_all + wid * 64;
    const bf16* ksrc = Kh + (long)(8 * wid + (lane >> 3)) * PITCH + (((lane & 7) ^ ((4 * (wid & 1) + (lane >> 4)) & 7)) * 8);
    const bf16* vsrc = Vh + (long)(16 * (wid & 3) + (lane >> 2)) * PITCH + (wid >> 2) * 32 + (lane & 3) * 8;
    const unsigned kdst = lds0 + A_LDS_K + wid * 1024, vdst = lds0 + A_LDS_V + wid * 1024;
#define DMA_K(t, slot) do { const bf16* ks_ = ksrc + (long)(t) * 64 * PITCH; \
        glds16(ks_, (unsigned)__builtin_amdgcn_readfirstlane(kdst + (slot))); glds16(ks_ + 64, (unsigned)__builtin_amdgcn_readfirstlane(kdst + (slot) + 8192)); } while (0)
#define DMA_V(t, slot) do { const bf16* vs_ = vsrc + (long)(t) * 64 * PITCH; \
        glds16(vs_, (unsigned)__builtin_amdgcn_readfirstlane(vdst + (slot))); glds16(vs_ + 64, (unsigned)__builtin_amdgcn_readfirstlane(vdst + (slot) + 8192)); } while (0)
    const lds_cptr kpr = (lds_cptr)lds + A_LDS_K + c * 8192 + r32 * 128;
    const int ksw = (r32 >> 1) & 7;
    const int kq0 = ((0 + hi) ^ ksw) * 16, kq1 = ((2 + hi) ^ ksw) * 16, kq2 = ((4 + hi) ^ ksw) * 16, kq3 = ((6 + hi) ^ ksw) * 16;
    const lds_cptr vp0 = (lds_cptr)lds + A_LDS_V + ((lane >> 4) & 1) * 32 + (lane & 3) * 8 + (4 * hi + ((lane & 15) >> 2)) * 64;
    DMA_K(0, 0); DMA_V(0, 0); DMA_K(1, SLOTB);
    bf16x8 qr[4];
#pragma unroll
    for (int d0 = 0; d0 < 4; ++d0) qr[d0] = *reinterpret_cast<const bf16x8*>(Qw + (long)r32 * PITCH + d0 * 16 + hi * 8);
    float mhat = 0.f, l_reg = 0.f;
    f32x16 o[4];
#pragma unroll
    for (int d0 = 0; d0 < 4; ++d0) o[d0] = f32x16{};
    const f32x16 zero16 = f32x16{};
    bool resc = false;
    f32x16 pA0, pA1, pB0, pB1; bf16x8 kf[8]; s16x4 vlo[4], vhi[4]; u32x4 pw0, pw1, pw2, pw3;
    int sl_prev = 0, sl_cur = 0, sl_next = SLOTB;
#define ROT() do { sl_prev = sl_cur; sl_cur = sl_next; sl_next = (sl_next == (A_NSLOT - 1) * SLOTB) ? 0 : sl_next + SLOTB; } while (0)
#define WAIT_BAR(N) asm volatile("s_waitcnt vmcnt(" #N ") lgkmcnt(0)\n\ts_barrier" ::: "memory")
#define KRD1(so_, d0_, kq_) do { kf[2 * (d0_)] = *(const LAS bf16x8*)(kpr + (so_) + (kq_)); kf[2 * (d0_) + 1] = *(const LAS bf16x8*)(kpr + (so_) + (kq_) + 4096); } while (0)
#define RESC() do { if (resc) { asm volatile("s_waitcnt lgkmcnt(0)" ::: "memory"); \
        _Pragma("unroll") for (int r = 0; r < 16; ++r) { const float f_ = wsf[crow(r, hi)]; _Pragma("unroll") for (int d_ = 0; d_ < 4; ++d_) o[d_][r] *= f_; } } } while (0)
    DMA_K(2, 2 * SLOTB);
    WAIT_BAR(6);
    KRD1(0, 0, kq0); KRD1(0, 1, kq1); KRD1(0, 2, kq2); KRD1(0, 3, kq3);
    pA0 = MIX_MFMA(kf[0], qr[0], zero16); pA1 = MIX_MFMA(kf[1], qr[0], zero16);
#pragma unroll
    for (int d0 = 1; d0 < 4; ++d0) { pA0 = MIX_MFMA(kf[2 * d0], qr[d0], pA0); pA1 = MIX_MFMA(kf[2 * d0 + 1], qr[d0], pA1); }
    { const float rm = rowmax(pA0, pA1); mhat = rm;
#pragma unroll
      for (int r = 0; r < 16; ++r) { pA0[r] = __builtin_amdgcn_exp2f(pA0[r] - rm); pA1[r] = __builtin_amdgcn_exp2f(pA1[r] - rm); } }
    WAIT_BAR(0);
    DMA_K(3, 0); DMA_V(1, SLOTB); ROT();
    KRD1(sl_cur, 0, kq0); KRD1(sl_cur, 1, kq1); KRD1(sl_cur, 2, kq2); KRD1(sl_cur, 3, kq3);
    if (NT > 2) { WAIT_BAR(4); } else { WAIT_BAR(0); }
#define PKW(Pp, B) cvtpk(Pp[B], Pp[B + 1])
#define PAF(k) __builtin_bit_cast(bf16x8, pw##k)
#define VFR(i) (bf16x8){vlo[i][0], vlo[i][1], vlo[i][2], vlo[i][3], vhi[i][0], vhi[i][1], vhi[i][2], vhi[i][3]}
#define VRD(i, f) do { vlo[i] = vtr(vp_ + (((f) >> 2) * 4096 + ((f) & 3) * 1024)); vhi[i] = vtr(vp_ + (((f) >> 2) * 4096 + ((f) & 3) * 1024 + 512)); } while (0)
#define GAPA(MF, A0, A1, A2, A3, W0, W1, PW) do { MF; sacc += A0; sacc += A1; sacc += A2; sacc += A3; MIX_PIN(sacc); W0; W1; MIX_PIN(PW); MIX_SBAR(); } while (0)
#define EX(v) __builtin_amdgcn_exp2f((v) - mhat)
#define GAPB(MF, X, B) do { MF; X[B] = EX(X[B]); X[B + 1] = EX(X[B + 1]); MIX_PIN(X); MIX_SBAR(); } while (0)
#define STEP(C0, C1, P0, P1, t, GK, GV, GL, LAST) do { MIX_SBAR(); \
    const lds_cptr vp_ = vp0 + sl_prev; \
    float sacc = (P0[0] + P0[1]); \
    GAPA(C0 = MIX_MFMA(kf[0], qr[0], zero16), P0[2], P0[3], P0[4], P0[5],     pw0[0] = PKW(P0, 0),  pw0[1] = PKW(P0, 2),  pw0); \
    GAPA(C1 = MIX_MFMA(kf[1], qr[0], zero16), P0[6], P0[7], P0[8], P0[9],     pw0[2] = PKW(P0, 4),  pw0[3] = PKW(P0, 6),  pw0); \
    GAPA(C0 = MIX_MFMA(kf[2], qr[1], C0),   P0[10], P0[11], P0[12], P0[13], pw1[0] = PKW(P0, 8),  pw1[1] = PKW(P0, 10), pw1); \
    GAPA(C1 = MIX_MFMA(kf[3], qr[1], C1),   P0[14], P0[15], P1[0], P1[1],   pw1[2] = PKW(P0, 12), pw1[3] = PKW(P0, 14), pw1); \
    VRD(0, 0); MIX_SBAR(); GAPA(C0 = MIX_MFMA(kf[4], qr[2], C0),   P1[2], P1[3], P1[4], P1[5],     pw2[0] = PKW(P1, 0),  pw2[1] = PKW(P1, 2),  pw2); \
    VRD(1, 1); MIX_SBAR(); GAPA(C1 = MIX_MFMA(kf[5], qr[2], C1),   P1[6], P1[7], P1[8], P1[9],     pw2[2] = PKW(P1, 4),  pw2[3] = PKW(P1, 6),  pw2); \
    VRD(2, 2); MIX_SBAR(); GAPA(C0 = MIX_MFMA(kf[6], qr[3], C0),   P1[10], P1[11], P1[12], P1[13], pw3[0] = PKW(P1, 8),  pw3[1] = PKW(P1, 10), pw3); \
    VRD(3, 3); MIX_SBAR(); GAPA(C1 = MIX_MFMA(kf[7], qr[3], C1),   P1[14], P1[15], 0.f, 0.f,       pw3[2] = PKW(P1, 12), pw3[3] = PKW(P1, 14), pw3); \
    l_reg += sacc; \
    if (GK) { DMA_K((t) + 3, sl_cur); } if (GV) { DMA_V((t) + 1, sl_next); } \
    if (LAST) { if (g < 2) { _Pragma("unroll") for (int r = 0; r < 16; ++r) { C0[r] = -INFINITY; C1[r] = -INFINITY; } } } \
    { const float rm = rowmax(C0, C1) - mhat; \
      resc = false; \
      if (__builtin_expect(__any(rm > ATT_THRL), 0)) { const float dl = __builtin_fmaxf(rm, 0.f); mhat += dl; \
        const float f = __builtin_amdgcn_exp2f(-dl); l_reg *= f; if (hi == 0) wsf[r32] = f; resc = true; } } \
    MIX_SBAR(); \
    GAPB(o[0] = MIX_MFMA(PAF(0), VFR(0), o[0]), C0, 0);  VRD(0, 4);  MIX_SBAR(); \
    GAPB(o[0] = MIX_MFMA(PAF(1), VFR(1), o[0]), C0, 2);  VRD(1, 5);  MIX_SBAR(); \
    GAPB(o[0] = MIX_MFMA(PAF(2), VFR(2), o[0]), C0, 4);  VRD(2, 6);  MIX_SBAR(); \
    GAPB(o[0] = MIX_MFMA(PAF(3), VFR(3), o[0]), C0, 6);  VRD(3, 7);  MIX_SBAR(); \
    GAPB(o[1] = MIX_MFMA(PAF(0), VFR(0), o[1]), C0, 8);  VRD(0, 8);  MIX_SBAR(); \
    GAPB(o[1] = MIX_MFMA(PAF(1), VFR(1), o[1]), C0, 10); VRD(1, 9);  MIX_SBAR(); \
    GAPB(o[1] = MIX_MFMA(PAF(2), VFR(2), o[1]), C0, 12); VRD(2, 10); MIX_SBAR(); \
    GAPB(o[1] = MIX_MFMA(PAF(3), VFR(3), o[1]), C0, 14); VRD(3, 11); MIX_SBAR(); \
    GAPB(o[2] = MIX_MFMA(PAF(0), VFR(0), o[2]), C1, 0);  VRD(0, 12); MIX_SBAR(); \
    GAPB(o[2] = MIX_MFMA(PAF(1), VFR(1), o[2]), C1, 2);  VRD(1, 13); MIX_SBAR(); \
    GAPB(o[2] = MIX_MFMA(PAF(2), VFR(2), o[2]), C1, 4);  VRD(2, 14); MIX_SBAR(); \
    GAPB(o[2] = MIX_MFMA(PAF(3), VFR(3), o[2]), C1, 6);  VRD(3, 15); MIX_SBAR(); \
    GAPB(o[3] = MIX_MFMA(PAF(0), VFR(0), o[3]), C1, 8);  if (GL) { KRD1(sl_next, 0, kq0); } MIX_SBAR(); \
    GAPB(o[3] = MIX_MFMA(PAF(1), VFR(1), o[3]), C1, 10); if (GL) { KRD1(sl_next, 1, kq1); } MIX_SBAR(); \
    GAPB(o[3] = MIX_MFMA(PAF(2), VFR(2), o[3]), C1, 12); if (GL) { KRD1(sl_next, 2, kq2); } MIX_SBAR(); \
    GAPB(o[3] = MIX_MFMA(PAF(3), VFR(3), o[3]), C1, 14); if (GL) { KRD1(sl_next, 3, kq3); } MIX_SBAR(); \
    } while (0)
#define ENDW(tt) do { if ((tt) + 3 < NT) { WAIT_BAR(4); } else if ((tt) + 2 < NT) { WAIT_BAR(2); } else { WAIT_BAR(0); } } while (0)
    int t = 1;
    for (; t + 5 < NT; t += 2) {
        STEP(pB0, pB1, pA0, pA1, t, true, true, true, false);     WAIT_BAR(4); RESC(); ROT();
        STEP(pA0, pA1, pB0, pB1, t + 1, true, true, true, false); WAIT_BAR(4); RESC(); ROT();
    }
    for (; t + 1 < NT; t += 2) {
        STEP(pB0, pB1, pA0, pA1, t, (t + 3 < NT), (t + 1 < NT), (t + 1 < NT), false);       ENDW(t);     RESC(); ROT();
        STEP(pA0, pA1, pB0, pB1, t + 1, (t + 4 < NT), (t + 2 < NT), (t + 2 < NT), false);   ENDW(t + 1); RESC(); ROT();
    }
    STEP(pB0, pB1, pA0, pA1, NT - 1, false, false, false, true); RESC();
    { float sacc = 0.f;
#pragma unroll
      for (int r = 0; r < 16; ++r) sacc += pB0[r] + pB1[r];
      l_reg += sacc;
      pw0 = (u32x4){PKW(pB0, 0), PKW(pB0, 2), PKW(pB0, 4), PKW(pB0, 6)}; pw1 = (u32x4){PKW(pB0, 8), PKW(pB0, 10), PKW(pB0, 12), PKW(pB0, 14)};
      pw2 = (u32x4){PKW(pB1, 0), PKW(pB1, 2), PKW(pB1, 4), PKW(pB1, 6)}; pw3 = (u32x4){PKW(pB1, 8), PKW(pB1, 10), PKW(pB1, 12), PKW(pB1, 14)};
      const lds_cptr vp_ = vp0 + sl_cur;
#pragma unroll
      for (int d0 = 0; d0 < 4; ++d0) {
          VRD(0, 4 * d0); VRD(1, 4 * d0 + 1); VRD(2, 4 * d0 + 2); VRD(3, 4 * d0 + 3);
          o[d0] = MIX_MFMA(PAF(0), VFR(0), o[d0]); o[d0] = MIX_MFMA(PAF(1), VFR(1), o[d0]); o[d0] = MIX_MFMA(PAF(2), VFR(2), o[d0]); o[d0] = MIX_MFMA(PAF(3), VFR(3), o[d0]); } }
#undef DMA_K
#undef DMA_V
#undef ROT
#undef WAIT_BAR
#undef KRD1
#undef RESC
#undef PKW
#undef PAF
#undef VFR
#undef VRD
#undef GAPA
#undef GAPB
#undef EX
#undef STEP
#undef ENDW
    asm volatile("s_waitcnt vmcnt(0) lgkmcnt(0)\n\ts_barrier" ::: "memory");
    { auto rr = __builtin_amdgcn_permlane32_swap(__float_as_uint(l_reg), __float_as_uint(l_reg), false, false); l_reg = __uint_as_float(rr[0]) + __uint_as_float(rr[1]); }
    if (hi == 0) wsf[32 + r32] = l_reg;
    asm volatile("s_waitcnt lgkmcnt(0)" ::: "memory");
    LAS float* stg = (LAS float*)lds;
#pragma unroll
    for (int r = 0; r < 16; ++r) { const int row = 32 * g + crow(r, hi); const float rl = __builtin_amdgcn_rcpf(wsf[32 + crow(r, hi)]);
#pragma unroll
        for (int d0 = 0; d0 < 4; ++d0) { const int e = 32 * d0 + r32; stg[((c * 128 + row) * 32 + ((e >> 2) ^ (row & 7))) * 4 + (e & 3)] = o[d0][r] * rl; } }
    asm volatile("s_waitcnt lgkmcnt(0)\n\ts_barrier" ::: "memory");
    {
        const int row = tid >> 2, qd = tid & 3;
        f32x4 a[8]; float ss = 0.f;
#pragma unroll
        for (int i = 0; i < 8; ++i) { const int ph = (row * 32 + ((8 * qd + i) ^ (row & 7))) * 4;
            const f32x4 v0 = *(const LAS f32x4*)(stg + ph), v1 = *(const LAS f32x4*)(stg + 128 * 128 + ph);
            a[i] = v0 - v1 * lam; ss += (a[i][0] * a[i][0] + a[i][1] * a[i][1]) + (a[i][2] * a[i][2] + a[i][3] * a[i][3]); }
        ss += __shfl_xor(ss, 1); ss += __shfl_xor(ss, 2);
        const float rs = 0.8f / sqrtf(ss * (1.0f / 128.0f) + 1e-5f);
        bf16* op = MIXO + (rowbase + q0 + row) * MIXP + h * 128 + 32 * qd;
        const float* gp = subg + 32 * qd;
#pragma unroll
        for (int i = 0; i < 8; i += 2) { const f32x4 g0 = *(const f32x4*)(gp + 4 * i), g1 = *(const f32x4*)(gp + 4 * i + 4);
            const f32x4 x0 = a[i] * g0 * rs, x1 = a[i + 1] * g1 * rs;
            u32x4 w; w.x = cvtpk(x0[0], x0[1]); w.y = cvtpk(x0[2], x0[3]); w.z = cvtpk(x1[0], x1[1]); w.w = cvtpk(x1[2], x1[3]);
            *(u32x4*)(op + 4 * i) = w; }
    }
    asm volatile("s_waitcnt lgkmcnt(0)\n\ts_barrier" ::: "memory");
}

constexpr int G_WM = 0, G_WMP = 136, G_VN = 36864;
__device__ __forceinline__ void gmlp_load_wm(const float* ws_g, LAS unsigned char* lds) {
    const int tid = fresh_tid(), t = tid >> 2, s0 = (tid & 3) * 32;
#pragma unroll
    for (int i = 0; i < 4; ++i) { const f32x4 a = *(const f32x4*)(ws_g + t * 128 + s0 + 8 * i), b = *(const f32x4*)(ws_g + t * 128 + s0 + 8 * i + 4);
        const bool keep = (t >> 6) >= ((s0 + 8 * i) >> 6);
        u32x4 w; w.x = cvtpk(a[0], a[1]); w.y = cvtpk(a[2], a[3]); w.z = cvtpk(b[0], b[1]); w.w = cvtpk(b[2], b[3]);
        if (!keep) w = (u32x4){0u, 0u, 0u, 0u};
        *(LAS u32x4*)(lds + G_WM + (t * G_WMP + s0 + 8 * i) * 2) = w; }
}
__device__ __forceinline__ void gmlp_item(int b, int nb, int g, const bf16* P, bf16* MIXO, LAS unsigned char* lds, const float* lng, const float* lnb, const float* bsg) {
    const int tid = fresh_tid(), lane = tid & 63, r32 = lane & 31, hi = lane >> 5; const int wid = __builtin_amdgcn_readfirstlane(tid >> 6);
    const long rowbase = (long)b * SEQ + nb * 128;
    {
        const int s = tid >> 2, qd = tid & 3;
        const bf16* vp = P + (rowbase + s) * PITCH + COL_G + g * 128 + qd * 32;
        float v[32]; float sum = 0.f;
#pragma unroll
        for (int i = 0; i < 4; ++i) { const u32x4 w = *(const u32x4*)(vp + 8 * i);
#pragma unroll
            for (int j = 0; j < 4; ++j) { v[8 * i + 2 * j] = __uint_as_float(w[j] << 16); v[8 * i + 2 * j + 1] = __uint_as_float(w[j] & 0xffff0000u); } }
#pragma unroll
        for (int i = 0; i < 32; ++i) sum += v[i];
        sum += __shfl_xor(sum, 1); sum += __shfl_xor(sum, 2);
        const float mean = sum * (1.0f / 128.0f); float sq = 0.f;
#pragma unroll
        for (int i = 0; i < 32; ++i) { v[i] -= mean; sq += v[i] * v[i]; }
        sq += __shfl_xor(sq, 1); sq += __shfl_xor(sq, 2);
        const float rstd = 1.0f / sqrtf(sq * (1.0f / 128.0f) + 1e-5f);
        const float* gg = lng + g * 128 + qd * 32; const float* gb = lnb + g * 128 + qd * 32;
        LAS unsigned char* dst = lds + G_VN + ((qd * 8 + (s >> 4)) * 16 + (s & 15)) * 64;
#pragma unroll
        for (int i = 0; i < 4; ++i) { float y[8];
#pragma unroll
            for (int j = 0; j < 8; ++j) y[j] = v[8 * i + j] * rstd * gg[8 * i + j] + gb[8 * i + j];
            u32x4 w; w.x = cvtpk(y[0], y[1]); w.y = cvtpk(y[2], y[3]); w.z = cvtpk(y[4], y[5]); w.w = cvtpk(y[6], y[7]);
            *(LAS u32x4*)(dst + 16 * i) = w; }
    }
    asm volatile("s_waitcnt lgkmcnt(0)" ::: "memory"); __builtin_amdgcn_s_barrier(); asm volatile("" ::: "memory");
    const int tm = wid >> 1;
    const lds_cptr ap = (lds_cptr)lds + G_WM + ((32 * tm + r32) * G_WMP + 8 * hi) * 2;
    const lds_cptr vb = (lds_cptr)lds + G_VN + (8 * hi + ((lane & 15) >> 2)) * 64 + ((lane >> 4) & 1) * 32 + (lane & 3) * 8;
#pragma unroll
    for (int dd = 0; dd < 2; ++dd) { const int dn = (wid & 1) * 2 + dd;
        f32x16 acc = f32x16{};
#pragma unroll
        for (int ks = 0; ks < 8; ++ks) {
            const bf16x8 af = *(const LAS bf16x8*)(ap + ks * 32);
            const s16x4 lo = vtr(vb + (dn * 8 + ks) * 1024), hh = vtr(vb + (dn * 8 + ks) * 1024 + 256);
            const bf16x8 vf = (bf16x8){lo[0], lo[1], lo[2], lo[3], hh[0], hh[1], hh[2], hh[3]};
            acc = MIX_MFMA(af, vf, acc); }
        const int d = 32 * dn + r32;
#pragma unroll
        for (int r = 0; r < 16; ++r) { const int t = 32 * tm + crow(r, hi);
            const float uu = bf2f(P[(rowbase + t) * PITCH + COL_U + g * 128 + d]);
            const float val = uu * (acc[r] + bsg[g * 128 + t]);
            MIXO[(rowbase + t) * MIXP + 1024 + g * 128 + d] = (bf16)(cvtpk(val, val) & 0xffffu); }
    }
    asm volatile("s_waitcnt lgkmcnt(0)" ::: "memory"); __builtin_amdgcn_s_barrier(); asm volatile("" ::: "memory");
}
}

constexpr int NWAVES = 8;
constexpr int BATCH = 4, SEQ = 4096, D = 2048, M = BATCH * SEQ, INW = 5120, FF = 8192, NMOD = 6;
constexpr float LN_EPS = 1e-5f;
constexpr float DN_ALPHA = 1.189207115002721f;
constexpr size_t MiB = 1u << 20;
constexpr size_t WS_CTL = 0, CTL_ZERO_BYTES = 64 * 1024;
constexpr size_t WS_MOD = 1 * MiB;
constexpr size_t WS_WIN = 2 * MiB, WS_WOUT = 22 * MiB, WS_W1 = 30 * MiB, WS_W2 = 62 * MiB;
constexpr size_t WS_XN = 94 * MiB;
constexpr size_t WS_PROJ = 158 * MiB;
constexpr size_t WS_MIX = 318 * MiB;
constexpr size_t WS_HID = 158 * MiB;
constexpr size_t WS_END = 414 * MiB;
static_assert(WS_WIN + (size_t)INW * D * 2 <= WS_WOUT && WS_WOUT + (size_t)D * D * 2 <= WS_W1 && WS_W1 + (size_t)FF * D * 2 <= WS_W2 && WS_W2 + (size_t)D * FF * 2 <= WS_XN &&
              WS_XN + (size_t)M * D * 2 <= WS_PROJ && WS_PROJ + (size_t)M * INW * 2 <= WS_MIX && WS_MIX + (size_t)M * D * 2 <= WS_END && WS_HID + (size_t)M * FF * 2 <= WS_END, "d_ws map");
constexpr int CW_BAR = 4096;
constexpr int RING_OFF = 0, RING_BYTES = 131072;
constexpr int LDSCTL_OFF = RING_BYTES, MISC_OFF = LDSCTL_OFF + 320;
constexpr int WSF_OFF = RING_BYTES + 1024;
constexpr int LDS_BYTES = 147456;
static_assert(MISC_OFF + 128 <= WSF_OFF && WSF_OFF + 2048 <= LDS_BYTES, "LDS map");

typedef unsigned short bf16;
typedef unsigned v4u __attribute__((ext_vector_type(4)));
typedef float f32x4 __attribute__((ext_vector_type(4)));
typedef GAS unsigned gu32;
#define RLX_AGENT __ATOMIC_RELAXED, __HIP_MEMORY_SCOPE_AGENT
#define LDS_WAIT() asm volatile("s_waitcnt lgkmcnt(0)" ::: "memory")
#define VM_WAIT() asm volatile("s_waitcnt vmcnt(0)" ::: "memory")
__device__ __forceinline__ unsigned pk2(float lo, float hi) { return pg8::cvt_pk_bf16(lo, hi); }

#define XB_TMO      128
#define XB_XCNT(j)  (256  + 64 * (j))
#define XB_XSUB(j)  (1280 + 64 * (j))
#define XB_XGEN(j)  (2304 + 64 * (j))
#define XB_TOP      3328
#define XB_TOPGEN   3392
#define XCD_BAR_WORDS 3456
#define XB_SPIN_CAP (1u << 18)

__device__ __forceinline__ unsigned xb_ld(unsigned* p)              { return __hip_atomic_load(p, __ATOMIC_RELAXED, __HIP_MEMORY_SCOPE_AGENT); }
__device__ __forceinline__ unsigned xb_add(unsigned* p, unsigned v) { return __hip_atomic_fetch_add(p, v, __ATOMIC_RELAXED, __HIP_MEMORY_SCOPE_AGENT); }
__device__ __forceinline__ unsigned xb_xcc_id() { return (unsigned)__builtin_amdgcn_s_getreg((3 << 11) | 20) & 0xFu; }
#define XB_SPIN(cond, bar) do { unsigned _sp = 0; while (cond) { __builtin_amdgcn_s_sleep(1); \
    if ((++_sp & 255u) == 0u) { if (xb_ld(&(bar)[XB_TMO])) break; if (_sp > XB_SPIN_CAP) { atomicAdd(&(bar)[XB_TMO], 1u); break; } } } } while (0)

struct XcdBarrier {
    unsigned* bar; unsigned x;
    volatile LAS unsigned* st;
};

__device__ __forceinline__ XcdBarrier xcd_barrier_post(unsigned* bar, volatile LAS unsigned* st) {
    XcdBarrier b; b.bar = bar; b.x = xb_xcc_id(); b.st = st;
    if (threadIdx.x == 0) (void)xb_add(&bar[XB_XCNT(b.x)], 1u);
    return b;
}
__device__ __forceinline__ void xcd_barrier_complete(unsigned* bar, unsigned x, unsigned& nloc, unsigned& nx) {
    const unsigned G = gridDim.x * gridDim.y * gridDim.z;
    unsigned sum, cnt, mine, sp = 0u;
    for (;;) {
        sum = 0u; cnt = 0u; mine = 0u;
#pragma unroll
        for (unsigned j = 0; j < 16; ++j) { const unsigned c = xb_ld(&bar[XB_XCNT(j)]); sum += c; cnt += (c > 0u) ? 1u : 0u; mine = (j == x) ? c : mine; }
        if (sum == G) break;
        __builtin_amdgcn_s_sleep(1);
        if ((++sp & 255u) == 0u) { if (xb_ld(&bar[XB_TMO])) break; if (sp > XB_SPIN_CAP) { atomicAdd(&bar[XB_TMO], 1u); break; } }
    }
    nloc = mine > 0u ? mine : 1u; nx = cnt > 0u ? cnt : 1u;
}

__device__ __forceinline__ void xcd_barrier(const XcdBarrier& b) {
    asm volatile("s_waitcnt vmcnt(0)" ::: "memory");
    __syncthreads();
    if (threadIdx.x == 0) {
        unsigned* bar = b.bar;
        __builtin_amdgcn_s_waitcnt(0);
        unsigned nloc = b.st[0], nx = b.st[1];
        if (nloc == 0u) { xcd_barrier_complete(bar, b.x, nloc, nx); b.st[0] = nloc; b.st[1] = nx; }
        const unsigned old = xb_add(&bar[XB_XSUB(b.x)], 1u);
        const unsigned gen = old / nloc;
        if (old + 1u == (gen + 1u) * nloc) {
            __builtin_amdgcn_fence(__ATOMIC_RELEASE, "agent");
            asm volatile("s_waitcnt vmcnt(0)" ::: "memory");
            const unsigned og = xb_add(&bar[XB_TOP], 1u);
            const unsigned tg = og / nx;
            if (og + 1u == (tg + 1u) * nx) xb_add(&bar[XB_TOPGEN], 1u);
            else XB_SPIN(xb_ld(&bar[XB_TOPGEN]) == tg, bar);
            __builtin_amdgcn_fence(__ATOMIC_ACQUIRE, "agent");
            xb_add(&bar[XB_XGEN(b.x)], 1u);
            asm volatile("s_waitcnt vmcnt(0)" ::: "memory");
        } else {
            XB_SPIN(xb_ld(&bar[XB_XGEN(b.x)]) == gen, bar);
            __builtin_amdgcn_fence(__ATOMIC_ACQUIRE, "agent");
            asm volatile("s_waitcnt vmcnt(0)" ::: "memory");
        }
    }
    __syncthreads();
}

struct Frame {
    LAS unsigned char* lds;
    volatile LAS unsigned* MISC;
    gu32* ctl;
    int tid, lane, wave;
    int vcu, G;
    __device__ __forceinline__ void refresh() { tid = fresh_tid(); lane = tid & 63; wave = __builtin_amdgcn_readfirstlane(tid >> 6); }
};
__device__ __forceinline__ float wave_sum(float v) {
#pragma unroll
    for (int o = 1; o < 64; o <<= 1) v += __shfl_xor(v, o);
    return v;
}
__device__ __forceinline__ void p0_transpose_item(const float* W, int K, int N, bf16* WT, LAS float* scr, int item, int lane) {
    const int nblk = N / 32, kb = item / nblk, nb = item % nblk, k0 = 64 * kb, n0 = 32 * nb;
#pragma unroll 8
    for (int i = 0; i < 32; ++i) { const int kk = 2 * i + (lane >> 5); scr[kk * 33 + (lane & 31)] = W[(size_t)(k0 + kk) * N + n0 + (lane & 31)]; }
    LDS_WAIT(); asm volatile("" ::: "memory");
    const int c = lane & 7;
#pragma unroll
    for (int j = 0; j < 4; ++j) { const int n = (lane >> 3) + 8 * j; const LAS float* s = scr + (8 * c) * 33 + n;
        v4u o; o.x = pk2(s[0 * 33], s[1 * 33]); o.y = pk2(s[2 * 33], s[3 * 33]); o.z = pk2(s[4 * 33], s[5 * 33]); o.w = pk2(s[6 * 33], s[7 * 33]);
        *(GAS v4u*)(WT + (size_t)(n0 + n) * K + k0 + 8 * c) = o; }
    LDS_WAIT(); asm volatile("" ::: "memory");
}
__device__ __forceinline__ void p0_mod(Frame& F, const float* cvec, const float* w_ada, const float* b_ada, float* mod) {
    LAS float* sc = (LAS float*)(F.lds + RING_OFF);
    LAS float* red = (LAS float*)(F.lds + RING_OFF + 32768);
    for (int i = F.tid; i < BATCH * D; i += NWAVES * 64) { const float v = cvec[i]; sc[i] = v / (1.0f + __expf(-v)); }
    LDS_WAIT(); __syncthreads();
    const int col = blockIdx.x * 64 + F.lane, kbase = F.wave * 256;
    const float* wp = w_ada + (size_t)kbase * (NMOD * D) + col;
    float a0 = 0.f, a1 = 0.f, a2 = 0.f, a3 = 0.f;
#pragma unroll 16
    for (int k = 0; k < 256; ++k) { const float w = wp[(size_t)k * (NMOD * D)];
        a0 += sc[kbase + k] * w; a1 += sc[D + kbase + k] * w; a2 += sc[2 * D + kbase + k] * w; a3 += sc[3 * D + kbase + k] * w; }
    red[(F.wave * 4 + 0) * 64 + F.lane] = a0; red[(F.wave * 4 + 1) * 64 + F.lane] = a1; red[(F.wave * 4 + 2) * 64 + F.lane] = a2; red[(F.wave * 4 + 3) * 64 + F.lane] = a3;
    LDS_WAIT(); __syncthreads();
    if (F.tid < 256) { const int b = F.tid >> 6, l = F.tid & 63; float s = 0.f;
#pragma unroll
        for (int w = 0; w < 8; ++w) s += red[(w * 4 + b) * 64 + l];
        mod[(size_t)b * (NMOD * D) + blockIdx.x * 64 + l] = s + b_ada[blockIdx.x * 64 + l]; }
    LDS_WAIT(); __syncthreads();
}
struct RowStats { float mean, rstd; };
__device__ __forceinline__ RowStats row_stats(f32x4 (&v)[8]) {
    float s = 0.f;
#pragma unroll
    for (int j = 0; j < 8; ++j) s += (v[j].x + v[j].y) + (v[j].z + v[j].w);
    const float mean = wave_sum(s) * (1.f / D); float s2 = 0.f;
#pragma unroll
    for (int j = 0; j < 8; ++j) { const f32x4 d = v[j] - mean; s2 += (d.x * d.x + d.y * d.y) + (d.z * d.z + d.w * d.w); }
    RowStats r; r.mean = mean; r.rstd = 1.f / sqrtf(wave_sum(s2) * (1.f / D) + LN_EPS); return r;
}
__device__ __forceinline__ void p1_xn(Frame& F, const float* x, const float* mod, bf16* XN) {
    const int gw = F.vcu * NWAVES + F.wave, NGW = F.G * NWAVES;
    for (int m = gw; m < M; m += NGW) {
        const GAS f32x4* xr = (const GAS f32x4*)(x + (size_t)m * D) + F.lane;
        const float* mb = mod + (size_t)(m >> 12) * (NMOD * D);
        f32x4 v[8];
#pragma unroll
        for (int j = 0; j < 8; ++j) v[j] = xr[64 * j];
        const RowStats st = row_stats(v);
        GAS unsigned long long* o8 = (GAS unsigned long long*)(XN + (size_t)m * D) + F.lane;
#pragma unroll
        for (int j = 0; j < 8; ++j) { const f32x4 sh = *((const f32x4*)(mb + 0 * D) + F.lane + 64 * j), sc = *((const f32x4*)(mb + 1 * D) + F.lane + 64 * j);
            const f32x4 y = (v[j] - st.mean) * st.rstd * (sc + 1.0f) + sh;
            o8[64 * j] = (unsigned long long)pk2(y.x, y.y) | ((unsigned long long)pk2(y.z, y.w) << 32); }
    }
}
__device__ __forceinline__ void add_bf16x4(f32x4& v, unsigned long long w, float alpha) {
    const unsigned lo = (unsigned)w, hi = (unsigned)(w >> 32);
    v.x = v.x * alpha + __uint_as_float(lo << 16); v.y = v.y * alpha + __uint_as_float(lo & 0xffff0000u);
    v.z = v.z * alpha + __uint_as_float(hi << 16); v.w = v.w * alpha + __uint_as_float(hi & 0xffff0000u);
}
__device__ __forceinline__ void p5_ln(Frame& F, const float* X, const bf16* G, bf16* H, const float* lg, const float* lb, const float* mod, bf16* XN) {
    const int gw = F.vcu * NWAVES + F.wave, NGW = F.G * NWAVES;
    for (int m = gw; m < M; m += NGW) {
        const GAS f32x4* xr = (const GAS f32x4*)(X + (size_t)m * D) + F.lane;
        const GAS unsigned long long* gr = (const GAS unsigned long long*)(G + (size_t)m * D) + F.lane;
        GAS unsigned long long* hr = (GAS unsigned long long*)(H + (size_t)m * D) + F.lane;
        const float* mb = mod + (size_t)(m >> 12) * (NMOD * D);
        f32x4 v[8]; unsigned long long gq[8];
#pragma unroll
        for (int j = 0; j < 8; ++j) { v[j] = xr[64 * j]; gq[j] = gr[64 * j]; }
#pragma unroll
        for (int j = 0; j < 8; ++j) add_bf16x4(v[j], gq[j], DN_ALPHA);
        const RowStats st = row_stats(v);
#pragma unroll
        for (int j = 0; j < 8; ++j) { const f32x4 g = *((const f32x4*)lg + F.lane + 64 * j), b = *((const f32x4*)lb + F.lane + 64 * j);
            v[j] = (v[j] - st.mean) * st.rstd * g + b; hr[64 * j] = (unsigned long long)pk2(v[j].x, v[j].y) | ((unsigned long long)pk2(v[j].z, v[j].w) << 32); }
        const RowStats s2 = row_stats(v);
        GAS unsigned long long* o8 = (GAS unsigned long long*)(XN + (size_t)m * D) + F.lane;
#pragma unroll
        for (int j = 0; j < 8; ++j) { const f32x4 sh = *((const f32x4*)(mb + 3 * D) + F.lane + 64 * j), sc = *((const f32x4*)(mb + 4 * D) + F.lane + 64 * j);
            const f32x4 y = (v[j] - s2.mean) * s2.rstd * (sc + 1.0f) + sh;
            o8[64 * j] = (unsigned long long)pk2(y.x, y.y) | ((unsigned long long)pk2(y.z, y.w) << 32); }
    }
}
__device__ __forceinline__ void p8_ln(Frame& F, const bf16* H, const bf16* G, float* OUT, const float* lg, const float* lb) {
    const int gw = F.vcu * NWAVES + F.wave, NGW = F.G * NWAVES;
    for (int m = gw; m < M; m += NGW) {
        GAS f32x4* yr = (GAS f32x4*)(OUT + (size_t)m * D) + F.lane;
        const GAS unsigned long long* hr = (const GAS unsigned long long*)(H + (size_t)m * D) + F.lane;
        const GAS unsigned long long* gr = (const GAS unsigned long long*)(G + (size_t)m * D) + F.lane;
        f32x4 v[8]; unsigned long long hq[8], gq[8];
#pragma unroll
        for (int j = 0; j < 8; ++j) { hq[j] = hr[64 * j]; gq[j] = gr[64 * j]; }
#pragma unroll
        for (int j = 0; j < 8; ++j) { v[j] = (f32x4){0.f, 0.f, 0.f, 0.f}; add_bf16x4(v[j], hq[j], 1.0f); add_bf16x4(v[j], gq[j], DN_ALPHA); }
        const RowStats st = row_stats(v);
#pragma unroll
        for (int j = 0; j < 8; ++j) { const f32x4 g = *((const f32x4*)lg + F.lane + 64 * j), b = *((const f32x4*)lb + F.lane + 64 * j);
            yr[64 * j] = (v[j] - st.mean) * st.rstd * g + b; }
    }
}

#define REP_P0 1
#define REP_P1 1
#define REP_P2 1
#define REP_P3A 1
#define REP_P3G 1
#define REP_P4 1
#define REP_P6 1
#define REP_P7X 0
constexpr size_t WS_SCRATCH = 414 * MiB;
struct Args { const float* in[21]; float* out; unsigned char* ws; };
__global__ void __launch_bounds__(NWAVES * 64, 2) fwd_megakernel(Args args) {
    extern __shared__ __attribute__((aligned(16))) unsigned char lds[];
    Frame F;
    F.lds = (LAS unsigned char*)lds;
    F.MISC = (volatile LAS unsigned*)(F.lds + MISC_OFF);
    F.refresh();
    F.G = gridDim.x; { const int bx = blockIdx.x; F.vcu = (F.G % 8 == 0) ? (bx % 8) * (F.G / 8) + bx / 8 : bx; }
    unsigned char* ws = args.ws;
    F.ctl = (gu32*)(ws + WS_CTL);
    const float* x = args.in[0]; const float* cvec = args.in[1]; const float* w_ada = args.in[2]; const float* b_ada = args.in[3]; const float* w_in = args.in[4];
    const float* lq1 = args.in[5]; const float* lk1 = args.in[6]; const float* lq2 = args.in[7]; const float* lk2 = args.in[8]; const float* subg = args.in[9];
    const float* gln_g = args.in[10]; const float* gln_b = args.in[11]; const float* g_ws = args.in[12]; const float* g_bs = args.in[13]; const float* w_out = args.in[14];
    const float* ln1_g = args.in[15]; const float* ln1_b = args.in[16]; const float* w_ff1 = args.in[17]; const float* w_ff2 = args.in[18]; const float* ln2_g = args.in[19]; const float* ln2_b = args.in[20];
    float* out = args.out;
    float* MOD = (float*)(ws + WS_MOD);
    bf16* Win_t = (bf16*)(ws + WS_WIN); bf16* Wout_t = (bf16*)(ws + WS_WOUT); bf16* W1_t = (bf16*)(ws + WS_W1); bf16* W2_t = (bf16*)(ws + WS_W2);
    bf16* XN = (bf16*)(ws + WS_XN); bf16* PROJ = (bf16*)(ws + WS_PROJ); bf16* MIXB = (bf16*)(ws + WS_MIX); bf16* HID = (bf16*)(ws + WS_HID);
    bf16* H1B = (bf16*)(ws + WS_SCRATCH);
    bf16* GMIX = (bf16*)(ws + WS_PROJ);
    for (int u = F.tid; u < (LDS_BYTES - LDSCTL_OFF) / 4; u += NWAVES * 64) ((LAS unsigned*)(F.lds + LDSCTL_OFF))[u] = 0u;
    __syncthreads();
    XcdBarrier bar = xcd_barrier_post((unsigned*)(F.ctl + CW_BAR), F.MISC + 8);
#define GRID_BAR() xcd_barrier(bar)

    for (int rep = 0; rep < REP_P0; ++rep) {
        if (blockIdx.x < (NMOD * D) / 64) p0_mod(F, cvec, w_ada, b_ada, MOD);
        F.refresh();
        LAS float* scr = (LAS float*)(F.lds + RING_OFF + F.wave * 16384);
        const int gw = F.vcu * NWAVES + F.wave, NGW = F.G * NWAVES;
        constexpr int I_IN = (D / 64) * (INW / 32), I_O = (D / 64) * (D / 32), I_1 = (D / 64) * (FF / 32), I_2 = (FF / 64) * (D / 32);
        constexpr int NITEMS = I_IN + I_O + I_1 + I_2;
        constexpr int NMODWG = (NMOD * D) / 64, N1 = (256 - NMODWG) * NWAVES * 5;
        const bool free_wg = (int)blockIdx.x >= NMODWG;
        const int nm = ((int)blockIdx.x - NMODWG) * NWAVES + F.wave, NNM = ((int)F.G - NMODWG) * NWAVES;
        for (int pass = 0; pass < 2; ++pass) {
            if (pass == 0 && !free_wg) continue;
            const int it0 = pass == 0 ? nm : N1 + gw, it1 = pass == 0 ? N1 : NITEMS, step = pass == 0 ? NNM : NGW;
            for (int it = it0; it < it1; it += step) {
                int r = it;
                if (r < I_IN) { p0_transpose_item(w_in, D, INW, Win_t, scr, r, F.lane); continue; } r -= I_IN;
                if (r < I_O) { p0_transpose_item(w_out, D, D, Wout_t, scr, r, F.lane); continue; } r -= I_O;
                if (r < I_1) { p0_transpose_item(w_ff1, D, FF, W1_t, scr, r, F.lane); continue; } r -= I_1;
                p0_transpose_item(w_ff2, FF, D, W2_t, scr, r, F.lane);
            }
        }
        GRID_BAR();
    }
    for (int rep = 0; rep < REP_P1; ++rep) { F.refresh(); p1_xn(F, x, MOD, XN);
    GRID_BAR(); }
    for (int rep = 0; rep < REP_P2; ++rep) {
        pg8::Gemm g{XN, Win_t, M, INW, D}; pg8::StaticOrder S; S.init(M, INW, F.G, (int)blockIdx.x);
        pg8::EpiProj E{PROJ, INW};
        pg8::gemm_phase<pg8::EpiProj, pg8::StaticOrder, true, true>(F.lds + RING_OFF, g, S, E);
        GRID_BAR();
    }
    {
        F.refresh();
        float lam;
        { const float a = lq1[F.lane] * lk1[F.lane], b = lq2[F.lane] * lk2[F.lane];
          lam = __expf(wave_sum(a)) - __expf(wave_sum(b)) + 0.2f; }
        LAS float* wsf = (LAS float*)(F.lds + WSF_OFF);
        const int bh = F.vcu >> 3, s = F.vcu & 7;
        for (int rep = 0; rep < REP_P3A; ++rep)
        for (int i = 0; i < 4; ++i) { const int qb = (i == 0) ? s : (i == 1) ? 15 - s : (i == 2) ? 16 + s : 31 - s;
            mix::attn_unit(bh >> 3, bh & 7, qb, PROJ, MIXB, F.lds + RING_OFF, wsf, lam, subg); }
        const int gg = F.vcu >> 5;
        for (int rep = 0; rep < REP_P3G; ++rep) {
        mix::gmlp_load_wm(g_ws + (size_t)gg * 128 * 128, F.lds + RING_OFF);
        for (int i = 0; i < 4; ++i) { const int idx = (F.vcu & 31) * 4 + i;
            mix::gmlp_item(idx >> 5, idx & 31, gg, PROJ, MIXB, F.lds + RING_OFF, gln_g, gln_b, g_bs); } }
        GRID_BAR();
    }
    for (int rep = 0; rep < REP_P4; ++rep) {
        pg8::Gemm g{MIXB, Wout_t, M, D, D}; pg8::StaticOrder S; S.init(M, D, F.G, (int)blockIdx.x);
        pg8::EpiGate E{GMIX, D, MOD + 2 * D, NMOD * D};
        pg8::gemm_phase<pg8::EpiGate, pg8::StaticOrder, true, true>(F.lds + RING_OFF, g, S, E);
        GRID_BAR();
    }
    F.refresh(); p5_ln(F, x, GMIX, H1B, ln1_g, ln1_b, MOD, XN);
    GRID_BAR();
    for (int rep = 0; rep < REP_P6; ++rep) {
        pg8::Gemm g{XN, W1_t, M, FF, D}; pg8::StaticOrder S; S.init(M, FF, F.G, (int)blockIdx.x);
        pg8::EpiRelu2 E{HID, FF};
        pg8::gemm_phase<pg8::EpiRelu2, pg8::StaticOrder, true, true>(F.lds + RING_OFF, g, S, E);
        GRID_BAR();
    }
    for (int rep = 0; rep < REP_P7X; ++rep) {
        pg8::Gemm g{HID, W2_t, M, D, FF}; pg8::StaticOrder S; S.init(M, D, F.G, (int)blockIdx.x);
        pg8::EpiRelu2 E{(bf16*)(ws + WS_SCRATCH), D};
        pg8::gemm_phase<pg8::EpiRelu2, pg8::StaticOrder, true, true>(F.lds + RING_OFF, g, S, E);
        GRID_BAR();
    }
    {
        pg8::Gemm g{HID, W2_t, M, D, FF}; pg8::StaticOrder S; S.init(M, D, F.G, (int)blockIdx.x);
        pg8::EpiGate E{XN, D, MOD + 5 * D, NMOD * D};
        pg8::gemm_phase<pg8::EpiGate, pg8::StaticOrder, true, true>(F.lds + RING_OFF, g, S, E);
        GRID_BAR();
    }
    F.refresh(); p8_ln(F, H1B, XN, out, ln2_g, ln2_b);
#undef GRID_BAR
}

extern "C" void kernel_launch(void* const* d_in, const int* in_sizes, int n_in, void* d_out, int out_size, void* d_ws, size_t ws_size, hipStream_t stream) {
    static int grid = 0;
    if (grid == 0) {
        if (n_in != 21 || in_sizes[0] != M * D || out_size != M * D || ws_size < WS_END + 64 * MiB) { fprintf(stderr, "kernel_launch: built for 21 inputs, x and out of %d floats, >= %zu bytes of workspace; got n_in %d, in0 %d, out %d, ws %zu; nothing launched\n", M * D, (size_t)WS_END, n_in, n_in > 0 ? in_sizes[0] : -1, out_size, ws_size); grid = -1; return; }
        int dev = 0, cus = 0, per_cu = 0;
        if (hipGetDevice(&dev) != hipSuccess || hipDeviceGetAttribute(&cus, hipDeviceAttributeMultiprocessorCount, dev) != hipSuccess) { fprintf(stderr, "kernel_launch: hipGetDevice / hipDeviceGetAttribute failed\n"); grid = -1; return; }
        if (hipFuncSetAttribute((const void*)fwd_megakernel, hipFuncAttributeMaxDynamicSharedMemorySize, LDS_BYTES) != hipSuccess) { fprintf(stderr, "kernel_launch: hipFuncSetAttribute failed\n"); grid = -1; return; }
        if (hipOccupancyMaxActiveBlocksPerMultiprocessor(&per_cu, (const void*)fwd_megakernel, NWAVES * 64, LDS_BYTES) != hipSuccess || per_cu < 1)
            fprintf(stderr, "kernel_launch: note: the occupancy query reports %d workgroups per CU\n", per_cu);
        (void)hipGetLastError();
        grid = cus;
        if (grid != 256) fprintf(stderr, "kernel_launch: launching %d workgroups (built for 256 CUs)\n", grid);
    }
    if (grid < 0) return;
    if (hipMemsetAsync((char*)d_ws + WS_CTL, 0, CTL_ZERO_BYTES, stream) != hipSuccess) { fprintf(stderr, "kernel_launch: hipMemsetAsync of the control words failed\n"); return; }
    Args a{};
    for (int i = 0; i < 21; ++i) a.in[i] = (const float*)d_in[i];
    a.out = (float*)d_out; a.ws = (unsigned char*)d_ws;
    hipLaunchKernelGGL(fwd_megakernel, dim3(grid), dim3(NWAVES * 64), LDS_BYTES, stream, a);
    const hipError_t le = hipPeekAtLastError();
    if (le != hipSuccess) fprintf(stderr, "kernel_launch: launch failed: %s (grid %d x %d threads, %d B LDS)\n", hipGetErrorName(le), grid, NWAVES * 64, LDS_BYTES);
}
```

```cpp
#include <hip/hip_runtime.h>
#include <hip/hip_bf16.h>
#include <cstdio>
#include <cstdint>
#include <cmath>
__device__ __forceinline__ int fresh_tid() { int t = threadIdx.x; asm volatile("" : "+v"(t)); return t; }
namespace pg8 {
#define PG8_LAS __attribute__((address_space(3)))
typedef unsigned short bf16_t;
typedef short bf16x8 __attribute__((ext_vector_type(8)));
typedef float f32x4 __attribute__((ext_vector_type(4)));
typedef unsigned u32x4 __attribute__((ext_vector_type(4)));
constexpr int BM = 256, BK = 64, HALF = 128, HTB = HALF * BK * 2  , STAGE_BYTES = 8 * HTB, NXCD = 8, WGM = 8;

__host__ __device__ __forceinline__ int lds_byte(int r, int c) { const int st = (r >> 4) * 2 + (c >> 5), rr = r & 15, cc = c & 31, ob = rr * 64 + cc * 2; return st * 1024 + (ob ^ (((ob >> 9) & 1) << 5)); }
__host__ __device__ __forceinline__ void stage_rc(int b, int& R, int& C) { const int st = b / 1024, sb = b % 1024, swz = sb ^ (((sb >> 9) & 1) << 5); R = (st >> 1) * 16 + swz / 64; C = (st & 1) * 32 + (swz % 64) / 2; }
__host__ __device__ __forceinline__ int perm32(int rho) { const int n = rho >> 4, i = rho & 15; return 8 * (i >> 2) + 4 * n + (i & 3); }

struct Unit { int pm, pn; };
struct Gemm { const bf16_t* A; const bf16_t* Bt; int M, N, K; };

struct StaticOrder {
    int nM, nN, nwg, G, c;
    __host__ __device__ void init(int M, int N, int G_, int c_) { nM = M / BM; nN = N / BM; nwg = nM * nN; G = G_; c = c_; }
    __host__ __device__ bool next(int i, Unit& u) const {
        const long L = (long)i * G + c; if (L >= nwg) return false;
        int wgid = (int)L; { const int q = nwg / NXCD, r = nwg % NXCD, xcd = wgid % NXCD, off = wgid / NXCD; wgid = (xcd < r ? xcd * (q + 1) : r * (q + 1) + (xcd - r) * q) + off; }
        const int nig = WGM * nN, gid = wgid / nig, fm = gid * WGM, gsz = (nM - fm) < WGM ? (nM - fm) : WGM;
        u.pm = fm + ((wgid % nig) % gsz); u.pn = (wgid % nig) / gsz; return true;
    }
    __device__ __forceinline__ void a_ready(const Unit&) const {}
    __device__ __forceinline__ void done(const Unit&) const {}
};


typedef float f32x2 __attribute__((ext_vector_type(2)));
typedef __bf16 bf16x2_t __attribute__((ext_vector_type(2)));
__device__ __forceinline__ unsigned cvt_pk_bf16(float lo, float hi) { f32x2 v = {lo, hi}; bf16x2_t b = __builtin_convertvector(v, bf16x2_t); return __builtin_bit_cast(unsigned, b); }
__device__ __forceinline__ float gelu_tanh(float x) {
    const float c1 = 2.0f * 0.7978845608028654f * 1.4426950408889634f, c2 = c1 * 0.044715f;
    const float z2 = x * (c1 + c2 * x * x);
    const float e = __builtin_amdgcn_exp2f(-z2);
    return x * __builtin_amdgcn_rcpf(1.0f + e);
}
constexpr float ATT_C2 = 0.125f * 1.4426950408889634f;

struct EpiProj {
    static constexpr bool PERM = true, AFTER_DRAIN = false;
    bf16_t* O; int ldc;
    __device__ __forceinline__ void operator()(const f32x4 (&acc)[2][2][4][2], const Unit& u, int wr, int wc, int fr, int fq) const {
        const int row0 = u.pm * BM + wr * 64 + fr, col0 = u.pn * BM + wc * 32 + 8 * fq;
        const int mode = u.pn < 4 ? 0 : (u.pn < 12 ? 1 : 2);
#pragma unroll
        for (int ai = 0; ai < 2; ++ai)
#pragma unroll
            for (int m = 0; m < 4; ++m) { bf16_t* rowp = O + (size_t)(row0 + ai * HALF + m * 16) * ldc + col0;
#pragma unroll
                for (int bj = 0; bj < 2; ++bj) { f32x4 v0 = acc[ai][bj][m][0], v1 = acc[ai][bj][m][1];
                    if (mode == 0) { v0 = v0 * ATT_C2; v1 = v1 * ATT_C2; }
                    else if (mode == 2) {
#pragma unroll
                        for (int j = 0; j < 4; ++j) { v0[j] = gelu_tanh(v0[j]); v1[j] = gelu_tanh(v1[j]); } }
                    u32x4 w; w.x = cvt_pk_bf16(v0[0], v0[1]); w.y = cvt_pk_bf16(v0[2], v0[3]); w.z = cvt_pk_bf16(v1[0], v1[1]); w.w = cvt_pk_bf16(v1[2], v1[3]);
                    *(u32x4*)(rowp + bj * HALF) = w; } }
    }
};
struct EpiRelu2 {
    static constexpr bool PERM = true, AFTER_DRAIN = false;
    bf16_t* O; int ldc;
    __device__ __forceinline__ void operator()(const f32x4 (&acc)[2][2][4][2], const Unit& u, int wr, int wc, int fr, int fq) const {
        const int row0 = u.pm * BM + wr * 64 + fr, col0 = u.pn * BM + wc * 32 + 8 * fq;
#pragma unroll
        for (int ai = 0; ai < 2; ++ai)
#pragma unroll
            for (int m = 0; m < 4; ++m) { bf16_t* rowp = O + (size_t)(row0 + ai * HALF + m * 16) * ldc + col0;
#pragma unroll
                for (int bj = 0; bj < 2; ++bj) { f32x4 v0 = acc[ai][bj][m][0], v1 = acc[ai][bj][m][1];
#pragma unroll
                    for (int j = 0; j < 4; ++j) { const float a = __builtin_fmaxf(v0[j], 0.f), b = __builtin_fmaxf(v1[j], 0.f); v0[j] = a * a; v1[j] = b * b; }
                    u32x4 w; w.x = cvt_pk_bf16(v0[0], v0[1]); w.y = cvt_pk_bf16(v0[2], v0[3]); w.z = cvt_pk_bf16(v1[0], v1[1]); w.w = cvt_pk_bf16(v1[2], v1[3]);
                    *(u32x4*)(rowp + bj * HALF) = w; } }
    }
};
struct EpiGate {
    static constexpr bool PERM = true, AFTER_DRAIN = false;
    bf16_t* O; int ldc; const float* gate; int gate_stride;
    __device__ __forceinline__ void operator()(const f32x4 (&acc)[2][2][4][2], const Unit& u, int wr, int wc, int fr, int fq) const {
        const int row0 = u.pm * BM + wr * 64 + fr, col0 = u.pn * BM + wc * 32 + 8 * fq;
        const float* gp = gate + (size_t)(u.pm >> 4) * gate_stride + col0;
        f32x4 gv[2][2];
#pragma unroll
        for (int bj = 0; bj < 2; ++bj)
#pragma unroll
            for (int n = 0; n < 2; ++n) gv[bj][n] = *(const f32x4*)(gp + bj * HALF + n * 4) + 1.0f;
#pragma unroll
        for (int ai = 0; ai < 2; ++ai)
#pragma unroll
            for (int m = 0; m < 4; ++m) { bf16_t* rowp = O + (size_t)(row0 + ai * HALF + m * 16) * ldc + col0;
#pragma unroll
                for (int bj = 0; bj < 2; ++bj) { const f32x4 v0 = acc[ai][bj][m][0] * gv[bj][0], v1 = acc[ai][bj][m][1] * gv[bj][1];
                    u32x4 w; w.x = cvt_pk_bf16(v0[0], v0[1]); w.y = cvt_pk_bf16(v0[2], v0[3]); w.z = cvt_pk_bf16(v1[0], v1[1]); w.w = cvt_pk_bf16(v1[2], v1[3]);
                    *(u32x4*)(rowp + bj * HALF) = w; } }
    }
};
struct EpiRes {
    static constexpr bool PERM = false, AFTER_DRAIN = false;
    const float* base; float* out; const float* gate; int gate_stride; float alpha; int ldc;
    __device__ __forceinline__ void operator()(const f32x4 (&acc)[2][2][4][2], const Unit& u, int wr, int wc, int fr, int fq) const {
        const int row0 = u.pm * BM + wr * 64 + fr, col0 = u.pn * BM + wc * 32 + 4 * fq;
        const float* gp = gate + (size_t)(u.pm >> 4) * gate_stride + col0;
        f32x4 gv[2][2];
#pragma unroll
        for (int bj = 0; bj < 2; ++bj)
#pragma unroll
            for (int n = 0; n < 2; ++n) gv[bj][n] = *(const f32x4*)(gp + bj * HALF + n * 16) + 1.0f;
        f32x4 cur[2][2], nxt[2][2];
#pragma unroll
        for (int bj = 0; bj < 2; ++bj)
#pragma unroll
            for (int n = 0; n < 2; ++n) cur[bj][n] = *(const f32x4*)(base + (size_t)row0 * ldc + col0 + bj * HALF + n * 16);
#pragma unroll
        for (int idx = 0; idx < 8; ++idx) { const int ai = idx >> 2, m = idx & 3; const size_t off = (size_t)(row0 + ai * HALF + m * 16) * ldc + col0;
            if (idx + 1 < 8) { const size_t offn = (size_t)(row0 + ((idx + 1) >> 2) * HALF + ((idx + 1) & 3) * 16) * ldc + col0;
#pragma unroll
                for (int bj = 0; bj < 2; ++bj)
#pragma unroll
                    for (int n = 0; n < 2; ++n) nxt[bj][n] = *(const f32x4*)(base + offn + bj * HALF + n * 16); }
#pragma unroll
            for (int bj = 0; bj < 2; ++bj)
#pragma unroll
                for (int n = 0; n < 2; ++n) { *(f32x4*)(out + off + bj * HALF + n * 16) = cur[bj][n] * alpha + gv[bj][n] * acc[ai][bj][m][n]; cur[bj][n] = nxt[bj][n]; }
        }
    }
};

template <class Epi, class Sched, bool ALIGN_EPI = false, bool SP2 = false>
__device__ __forceinline__ void gemm_phase(PG8_LAS unsigned char* lds, const Gemm g, const Sched& S, const Epi& E) {
    const int tid = fresh_tid(), wid = __builtin_amdgcn_readfirstlane(tid >> 6), lane = tid & 63, wr = wid >> 2, wc = wid & 3, fr = lane & 15, fq = lane >> 4;
    const int K = g.K, nt = K / BK;
    unsigned voffA[2], voffB[2];
#pragma unroll
    for (int i = 0; i < 2; ++i) { int R, C; stage_rc(tid * 16 + i * 8192, R, C); const int Rb = Epi::PERM ? ((R & ~31) + perm32(R & 31)) : R;
        voffA[i] = (unsigned)(R * K + C) * 2u; voffB[i] = (unsigned)(Rb * K + C) * 2u; }
    const size_t kstep = (size_t)(BK * 2);
    const size_t hstep = (size_t)HALF * K * 2;
    const size_t tstep = 2 * hstep;
    const unsigned ldsw = (unsigned)wid * 1024u;
    const int aoff = lds_byte(wr * 64 + fr, fq * 8), boff = lds_byte(wc * 32 + fr, fq * 8);
#define PG8_SA(b, h) (((b) * 2 + (h)) * HTB)
#define PG8_SB(b, h) ((4 + (b) * 2 + (h)) * HTB)
#define PG8_STAGE(bufoff, gbase, voff) do { _Pragma("unroll") for (int _i = 0; _i < 2; ++_i) \
        __builtin_amdgcn_global_load_lds((const unsigned*)((const char*)(gbase) + (voff)[_i]), (PG8_LAS unsigned*)(lds + (bufoff) + ldsw + _i * 8192), 16, 0, 0); } while (0)
#define PG8_LDA(dst, b, h) do { _Pragma("unroll") for (int m = 0; m < 4; ++m) _Pragma("unroll") for (int k = 0; k < 2; ++k) dst[m][k] = *(const PG8_LAS bf16x8*)(lds + PG8_SA(b, h) + aoff + m * 2048 + k * 1024); } while (0)
#define PG8_LDB(dst, b, h) do { _Pragma("unroll") for (int n = 0; n < 2; ++n) _Pragma("unroll") for (int k = 0; k < 2; ++k) dst[n][k] = *(const PG8_LAS bf16x8*)(lds + PG8_SB(b, h) + boff + n * 2048 + k * 1024); } while (0)
#define PG8_MMA(ai, bj, At, Bt) do { __builtin_amdgcn_s_setprio(1); _Pragma("unroll") for (int m = 0; m < 4; ++m) _Pragma("unroll") for (int n = 0; n < 2; ++n) _Pragma("unroll") for (int k = 0; k < 2; ++k) \
        acc[ai][bj][m][n] = __builtin_amdgcn_mfma_f32_16x16x32_bf16(Bt[n][k], At[m][k], acc[ai][bj][m][n], 0, 0, 0); __builtin_amdgcn_s_setprio(0); } while (0)
#define PG8_WAIT_V(n) asm volatile("s_waitcnt vmcnt(" #n ")" ::: "memory")
#define PG8_WAIT_L(n) asm volatile("s_waitcnt lgkmcnt(" #n ")" ::: "memory")
#define PG8_BAR __builtin_amdgcn_s_barrier()
#define PG8_SCHED __builtin_amdgcn_sched_barrier(0)
    Unit cur, nxt; int ui = 0;
    if (!S.next(0, cur)) return;
    f32x4 acc[2][2][4][2];
#pragma unroll
    for (int a = 0; a < 2; ++a)
#pragma unroll
        for (int b = 0; b < 2; ++b)
#pragma unroll
            for (int m = 0; m < 4; ++m)
#pragma unroll
                for (int n = 0; n < 2; ++n) acc[a][b][m][n] = (f32x4){0.f, 0.f, 0.f, 0.f};
    bf16x8 At[4][2], B0[2][2], B1[2][2];
    const char* cA = (const char*)g.A + (size_t)cur.pm * tstep; const char* cB = (const char*)g.Bt + (size_t)cur.pn * tstep;
    S.a_ready(cur);
    if constexpr (SP2) {
        PG8_STAGE(PG8_SB(0, 0), cB, voffB); PG8_STAGE(PG8_SB(0, 1), cB + hstep, voffB); PG8_STAGE(PG8_SA(0, 0), cA, voffA); PG8_STAGE(PG8_SA(0, 1), cA + hstep, voffA);
        if (wr == 1) PG8_BAR;
        PG8_WAIT_V(2); PG8_BAR;
        PG8_STAGE(PG8_SB(1, 0), cB + kstep, voffB); PG8_STAGE(PG8_SA(1, 0), cA + kstep, voffA); PG8_STAGE(PG8_SB(1, 1), cB + hstep + kstep, voffB);
        PG8_WAIT_V(6); PG8_BAR;
    } else {
        PG8_STAGE(PG8_SB(0, 0), cB, voffB); PG8_STAGE(PG8_SA(0, 0), cA, voffA); PG8_STAGE(PG8_SB(0, 1), cB + hstep, voffB); PG8_STAGE(PG8_SA(0, 1), cA + hstep, voffA);
        if (wr == 1) PG8_BAR;
        PG8_WAIT_V(4); PG8_BAR;
        PG8_STAGE(PG8_SB(1, 0), cB + kstep, voffB); PG8_STAGE(PG8_SA(1, 0), cA + kstep, voffA); PG8_STAGE(PG8_SB(1, 1), cB + hstep + kstep, voffB);
        PG8_WAIT_V(6); PG8_BAR;
    }
    for (;;) {
        const bool has_next = S.next(ui + 1, nxt);
        const char* nA = has_next ? (const char*)g.A + (size_t)nxt.pm * tstep : cA; const char* nB = has_next ? (const char*)g.Bt + (size_t)nxt.pn * tstep : cB;
        for (int t = 0; t < nt; t += 2) {
            const bool last = (t == nt - 2);
            const char* a1 = cA + (size_t)(t + 1) * kstep;
            const char* a2 = last ? nA : cA + (size_t)(t + 2) * kstep; const char* b2 = last ? nB : cB + (size_t)(t + 2) * kstep;
            const char* a3 = a2 + kstep; const char* b3 = b2 + kstep;
            if (last && has_next) S.a_ready(nxt);
            if constexpr (SP2) {
            PG8_LDB(B0, 0, 0); PG8_LDB(B1, 0, 1); PG8_SCHED; PG8_LDA(At, 0, 0); PG8_STAGE(PG8_SA(1, 1), a1 + hstep, voffA);
            PG8_WAIT_V(8); PG8_WAIT_L(0); PG8_BAR; PG8_MMA(0, 0, At, B0); PG8_MMA(0, 1, At, B1); PG8_BAR; PG8_SCHED;
            PG8_LDA(At, 0, 1); PG8_STAGE(PG8_SB(0, 0), b2, voffB); PG8_STAGE(PG8_SB(0, 1), b2 + hstep, voffB); PG8_STAGE(PG8_SA(0, 0), a2, voffA);
            PG8_WAIT_V(8); PG8_WAIT_L(0); PG8_BAR; PG8_MMA(1, 0, At, B0); PG8_MMA(1, 1, At, B1); PG8_BAR; PG8_SCHED;
            PG8_LDB(B0, 1, 0); PG8_LDB(B1, 1, 1); PG8_SCHED; PG8_LDA(At, 1, 0); PG8_STAGE(PG8_SA(0, 1), a2 + hstep, voffA);
            PG8_WAIT_V(8); PG8_WAIT_L(0); PG8_BAR; PG8_MMA(0, 0, At, B0); PG8_MMA(0, 1, At, B1); PG8_BAR; PG8_SCHED;
            PG8_LDA(At, 1, 1); PG8_STAGE(PG8_SB(1, 0), b3, voffB); PG8_STAGE(PG8_SB(1, 1), b3 + hstep, voffB); PG8_STAGE(PG8_SA(1, 0), a3, voffA);
            PG8_WAIT_V(8); PG8_WAIT_L(0); PG8_BAR; PG8_MMA(1, 0, At, B0); PG8_MMA(1, 1, At, B1); PG8_BAR; PG8_SCHED;
            } else {
            PG8_LDB(B0, 0, 0); PG8_SCHED; PG8_LDA(At, 0, 0); PG8_STAGE(PG8_SA(1, 1), a1 + hstep, voffA);
            PG8_WAIT_L(8); PG8_BAR; PG8_WAIT_L(0); PG8_MMA(0, 0, At, B0); PG8_BAR; PG8_SCHED;
            PG8_LDB(B1, 0, 1); PG8_STAGE(PG8_SB(0, 0), b2, voffB);
            PG8_BAR; PG8_WAIT_L(0); PG8_MMA(0, 1, At, B1); PG8_BAR;
            PG8_LDA(At, 0, 1); PG8_STAGE(PG8_SA(0, 0), a2, voffA);
            PG8_BAR; PG8_WAIT_L(0); PG8_MMA(1, 0, At, B0); PG8_BAR; PG8_SCHED;
            PG8_STAGE(PG8_SB(0, 1), b2 + hstep, voffB);
            PG8_WAIT_V(6); PG8_BAR; PG8_MMA(1, 1, At, B1); PG8_BAR;
            PG8_LDB(B0, 1, 0); PG8_SCHED; PG8_LDA(At, 1, 0); PG8_STAGE(PG8_SA(0, 1), a2 + hstep, voffA);
            PG8_WAIT_L(8); PG8_BAR; PG8_WAIT_L(0); PG8_MMA(0, 0, At, B0); PG8_BAR; PG8_SCHED;
            PG8_LDB(B1, 1, 1); PG8_STAGE(PG8_SB(1, 0), b3, voffB);
            PG8_BAR; PG8_WAIT_L(0); PG8_MMA(0, 1, At, B1); PG8_BAR;
            PG8_LDA(At, 1, 1); PG8_STAGE(PG8_SA(1, 0), a3, voffA);
            PG8_BAR; PG8_WAIT_L(0); PG8_MMA(1, 0, At, B0); PG8_BAR; PG8_SCHED;
            PG8_STAGE(PG8_SB(1, 1), b3 + hstep, voffB);
            PG8_WAIT_V(6); PG8_BAR; PG8_MMA(1, 1, At, B1); PG8_BAR;
            }
        }
        if constexpr (ALIGN_EPI) { if (wr == 0) PG8_BAR; }
        if constexpr (!Epi::AFTER_DRAIN) { E(acc, cur, wr, wc, fr, fq); S.done(cur); }
        if (!has_next) break;
#pragma unroll
        for (int a = 0; a < 2; ++a)
#pragma unroll
            for (int b = 0; b < 2; ++b)
#pragma unroll
                for (int m = 0; m < 4; ++m)
#pragma unroll
                    for (int n = 0; n < 2; ++n) acc[a][b][m][n] = (f32x4){0.f, 0.f, 0.f, 0.f};
        cur = nxt; cA = nA; cB = nB; ++ui;
        if constexpr (ALIGN_EPI) { if (wr == 1) PG8_BAR; }
    }
    PG8_WAIT_V(0);
    if constexpr (!ALIGN_EPI) { if (wr == 0) PG8_BAR; }
    PG8_BAR;
    if constexpr (Epi::AFTER_DRAIN) { E.fused(acc, cur, wr, wc, fr, fq, lds, wid, lane); S.done(cur); }
#undef PG8_SA
#undef PG8_SB
#undef PG8_STAGE
#undef PG8_LDA
#undef PG8_LDB
#undef PG8_MMA
#undef PG8_WAIT_V
#undef PG8_WAIT_L
#undef PG8_BAR
#undef PG8_SCHED
}
}

#define LAS __attribute__((address_space(3)))
#define GAS __attribute__((address_space(1)))
namespace mix {
typedef unsigned short bf16;
typedef short bf16x8 __attribute__((ext_vector_type(8)));
typedef short s16x4 __attribute__((ext_vector_type(4)));
typedef short v4i16_t __attribute__((ext_vector_type(4)));
typedef float f32x16 __attribute__((ext_vector_type(16)));
typedef float f32x4 __attribute__((ext_vector_type(4)));
typedef unsigned u32x4 __attribute__((ext_vector_type(4)));
typedef LAS const char* lds_cptr;
constexpr int PITCH = 5120, SEQ = 4096, MIXP = 2048;
constexpr int COL_K = 1024, COL_V = 2048, COL_U = 3072, COL_G = 4096;
__device__ __forceinline__ int crow(int r, int hi) { return (r & 3) + 8 * (r >> 2) + 4 * hi; }
__device__ __forceinline__ unsigned cvtpk(float lo, float hi) { return pg8::cvt_pk_bf16(lo, hi); }
__device__ __forceinline__ float bf2f(unsigned short v) { return __uint_as_float((unsigned)v << 16); }
__device__ __forceinline__ void glds16(const void* gsrc, unsigned lds_dst) { unsigned keep;
    asm volatile("s_mov_b32 %0, m0\n\ts_mov_b32 m0, %2\n\ts_nop 0\n\tglobal_load_lds_dwordx4 %1, off\n\ts_mov_b32 m0, %0" : "=&s"(keep) : "v"(gsrc), "s"(lds_dst) : "memory"); }
__device__ __forceinline__ s16x4 vtr(lds_cptr p) { return __builtin_bit_cast(s16x4, __builtin_amdgcn_ds_read_tr16_b64_v4i16((LAS v4i16_t*)p)); }
#define MIX_MX3(a, b, c) __builtin_fmaxf(__builtin_fmaxf((a), (b)), (c))
__device__ __forceinline__ float rowmax(const f32x16& p0, const f32x16& p1) {
    float a = MIX_MX3(p0[0], p0[1], p1[0]), b = MIX_MX3(p0[2], p0[3], p1[1]); a = MIX_MX3(a, p1[2], p1[3]);
#pragma unroll
    for (int r = 4; r < 16; r += 4) { a = MIX_MX3(a, p0[r], p0[r + 1]); b = MIX_MX3(b, p0[r + 2], p0[r + 3]); a = MIX_MX3(a, p1[r], p1[r + 1]); b = MIX_MX3(b, p1[r + 2], p1[r + 3]); }
    float m = __builtin_fmaxf(a, b); auto rr = __builtin_amdgcn_permlane32_swap(__float_as_uint(m), __float_as_uint(m), false, false);
    return __builtin_fmaxf(__uint_as_float(rr[0]), __uint_as_float(rr[1])); }
#define MIX_MFMA(a, b, c) __builtin_amdgcn_mfma_f32_32x32x16_bf16(a, b, c, 0, 0, 0)

constexpr int SLOTB = 16384, A_NSLOT = 3, A_LDS_K = 0, A_LDS_V = A_NSLOT * SLOTB;
#define MIX_SBAR() __builtin_amdgcn_sched_barrier(0)
#define MIX_PIN(x) asm volatile("" : "+v"(x))
#define ATT_THRL 2.0f
__device__ __forceinline__ void attn_unit(int b, int h, int qb, const bf16* P, bf16* MIXO, LAS unsigned char* lds, LAS float* wsf_all, float lam, const float* subg) {
    const int tid = fresh_tid(), lane = tid & 63, r32 = lane & 31, hi = lane >> 5; const int wid = __builtin_amdgcn_readfirstlane(tid >> 6);
    const int c = wid >> 2, g = wid & 3;
    const long rowbase = (long)b * SEQ; const int q0 = qb * 128;
    const int NT = 2 * qb + 2;
    const bf16* Qw = P + (rowbase + q0 + g * 32) * PITCH + h * 128 + c * 64;
    const bf16* Kh = P + rowbase * PITCH + COL_K + h * 128;
    const bf16* Vh = P + rowbase * PITCH + COL_V + h * 128;
    const unsigned lds0 = (unsigned)(uintptr_t)lds;
    LAS float* wsf = wsf_all + wid * 64;
    const bf16* ksrc = Kh + (long)(8 * wid + (lane >> 3)) * PITCH + (((lane & 7) ^ ((4 * (wid & 1) + (lane >> 4)) & 7)) * 8);
    const bf16* vsrc = Vh + (long)(16 * (wid & 3) + (lane >> 2)) * PITCH + (wid >> 2) * 32 + (lane & 3) * 8;
    const unsigned kdst = lds0 + A_LDS_K + wid * 1024, vdst = lds0 + A_LDS_V + wid * 1024;
#define DMA_K(t, slot) do { const bf16* ks_ = ksrc + (long)(t) * 64 * PITCH; \
        glds16(ks_, (unsigned)__builtin_amdgcn_readfirstlane(kdst + (slot))); glds16(ks_ + 64, (unsigned)__builtin_amdgcn_readfirstlane(kdst + (slot) + 8192)); } while (0)
#define DMA_V(t, slot) do { const bf16* vs_ = vsrc + (long)(t) * 64 * PITCH; \
        glds16(vs_, (unsigned)__builtin_amdgcn_readfirstlane(vdst + (slot))); glds16(vs_ + 64, (unsigned)__builtin_amdgcn_readfirstlane(vdst + (slot) + 8192)); } while (0)
    const lds_cptr kpr = (lds_cptr)lds + A_LDS_K + c * 8192 + r32 * 128;
    const int ksw = (r32 >> 1) & 7;
    const int kq0 = ((0 + hi) ^ ksw) * 16, kq1 = ((2 + hi) ^ ksw) * 16, kq2 = ((4 + hi) ^ ksw) * 16, kq3 = ((6 + hi) ^ ksw) * 16;
    const lds_cptr vp0 = (lds_cptr)lds + A_LDS_V + ((lane >> 4) & 1) * 32 + (lane & 3) * 8 + (4 * hi + ((lane & 15) >> 2)) * 64;
    DMA_K(0, 0); DMA_V(0, 0); DMA_K(1, SLOTB);
    bf16x8 qr[4];
#pragma unroll
    for (int d0 = 0; d0 < 4; ++d0) qr[d0] = *reinterpret_cast<const bf16x8*>(Qw + (long)r32 * PITCH + d0 * 16 + hi * 8);
    float mhat = 0.f, l_reg = 0.f;
    f32x16 o[4];
#pragma unroll
    for (int d0 = 0; d0 < 4; ++d0) o[d0] = f32x16{};
    const f32x16 zero16 = f32x16{};
    bool resc = false;
    f32x16 pA0, pA1, pB0, pB1; bf16x8 kf[8]; s16x4 vlo[4], vhi[4]; u32x4 pw0, pw1, pw2, pw3;
    int sl_prev = 0, sl_cur = 0, sl_next = SLOTB;
#define ROT() do { sl_prev = sl_cur; sl_cur = sl_next; sl_next = (sl_next == (A_NSLOT - 1) * SLOTB) ? 0 : sl_next + SLOTB; } while (0)
#define WAIT_BAR(N) asm volatile("s_waitcnt vmcnt(" #N ") lgkmcnt(0)\n\ts_barrier" ::: "memory")
#define KRD1(so_, d0_, kq_) do { kf[2 * (d0_)] = *(const LAS bf16x8*)(kpr + (so_) + (kq_)); kf[2 * (d0_) + 1] = *(const LAS bf16x8*)(kpr + (so_) + (kq_) + 4096); } while (0)
#define RESC() do { if (resc) { asm volatile("s_waitcnt lgkmcnt(0)" ::: "memory"); \
        _Pragma("unroll") for (int r = 0; r < 16; ++r) { const float f_ = wsf[crow(r, hi)]; _Pragma("unroll") for (int d_ = 0; d_ < 4; ++d_) o[d_][r] *= f_; } } } while (0)
    DMA_K(2, 2 * SLOTB);
    WAIT_BAR(6);
    KRD1(0, 0, kq0); KRD1(0, 1, kq1); KRD1(0, 2, kq2); KRD1(0, 3, kq3);
    pA0 = MIX_MFMA(kf[0], qr[0], zero16); pA1 = MIX_MFMA(kf[1], qr[0], zero16);
#pragma unroll
    for (int d0 = 1; d0 < 4; ++d0) { pA0 = MIX_MFMA(kf[2 * d0], qr[d0], pA0); pA1 = MIX_MFMA(kf[2 * d0 + 1], qr[d0], pA1); }
    { const float rm = rowmax(pA0, pA1); mhat = rm;
#pragma unroll
      for (int r = 0; r < 16; ++r) { pA0[r] = __builtin_amdgcn_exp2f(pA0[r] - rm); pA1[r] = __builtin_amdgcn_exp2f(pA1[r] - rm); } }
    WAIT_BAR(0);
    DMA_K(3, 0); DMA_V(1, SLOTB); ROT();
    KRD1(sl_cur, 0, kq0); KRD1(sl_cur, 1, kq1); KRD1(sl_cur, 2, kq2); KRD1(sl_cur, 3, kq3);
    if (NT > 2) { WAIT_BAR(4); } else { WAIT_BAR(0); }
#define PKW(Pp, B) cvtpk(Pp[B], Pp[B + 1])
#define PAF(k) __builtin_bit_cast(bf16x8, pw##k)
#define VFR(i) (bf16x8){vlo[i][0], vlo[i][1], vlo[i][2], vlo[i][3], vhi[i][0], vhi[i][1], vhi[i][2], vhi[i][3]}
#define VRD(i, f) do { vlo[i] = vtr(vp_ + (((f) >> 2) * 4096 + ((f) & 3) * 1024)); vhi[i] = vtr(vp_ + (((f) >> 2) * 4096 + ((f) & 3) * 1024 + 512)); } while (0)
#define GAPA(MF, A0, A1, A2, A3, W0, W1, PW) do { MF; sacc += A0; sacc += A1; sacc += A2; sacc += A3; MIX_PIN(sacc); W0; W1; MIX_PIN(PW); MIX_SBAR(); } while (0)
#define EX(v) __builtin_amdgcn_exp2f((v) - mhat)
#define GAPB(MF, X, B) do { MF; X[B] = EX(X[B]); X[B + 1] = EX(X[B + 1]); MIX_PIN(X); MIX_SBAR(); } while (0)
#define STEP(C0, C1, P0, P1, t, GK, GV, GL, LAST) do { MIX_SBAR(); \
    const lds_cptr vp_ = vp0 + sl_prev; \
    float sacc = (P0[0] + P0[1]); \
    GAPA(C0 = MIX_MFMA(kf[0], qr[0], zero16), P0[2], P0[3], P0[4], P0[5],     pw0[0] = PKW(P0, 0),  pw0[1] = PKW(P0, 2),  pw0); \
    GAPA(C1 = MIX_MFMA(kf[1], qr[0], zero16), P0[6], P0[7], P0[8], P0[9],     pw0[2] = PKW(P0, 4),  pw0[3] = PKW(P0, 6),  pw0); \
    GAPA(C0 = MIX_MFMA(kf[2], qr[1], C0),   P0[10], P0[11], P0[12], P0[13], pw1[0] = PKW(P0, 8),  pw1[1] = PKW(P0, 10), pw1); \
    GAPA(C1 = MIX_MFMA(kf[3], qr[1], C1),   P0[14], P0[15], P1[0], P1[1],   pw1[2] = PKW(P0, 12), pw1[3] = PKW(P0, 14), pw1); \
    VRD(0, 0); MIX_SBAR(); GAPA(C0 = MIX_MFMA(kf[4], qr[2], C0),   P1[2], P1[3], P1[4], P1[5],     pw2[0] = PKW(P1, 0),  pw2[1] = PKW(P1, 2),  pw2); \
    VRD(1, 1); MIX_SBAR(); GAPA(C1 = MIX_MFMA(kf[5], qr[2], C1),   P1[6], P1[7], P1[8], P1[9],     pw2[2] = PKW(P1, 4),  pw2[3] = PKW(P1, 6),  pw2); \
    VRD(2, 2); MIX_SBAR(); GAPA(C0 = MIX_MFMA(kf[6], qr[3], C0),   P1[10], P1[11], P1[12], P1[13], pw3[0] = PKW(P1, 8),  pw3[1] = PKW(P1, 10), pw3); \
    VRD(3, 3); MIX_SBAR(); GAPA(C1 = MIX_MFMA(kf[7], qr[3], C1),   P1[14], P1[15], 0.f, 0.f,       pw3[2] = PKW(P1, 12), pw3[3] = PKW(P1, 14), pw3); \
    l_reg += sacc; \
    if (GK) { DMA_K((t) + 3, sl_cur); } if (GV) { DMA_V((t) + 1, sl_next); } \
    if (LAST) { if (g < 2) { _Pragma("unroll") for (int r = 0; r < 16; ++r) { C0[r] = -INFINITY; C1[r] = -INFINITY; } } } \
    { const float rm = rowmax(C0, C1) - mhat; \
      resc = false; \
      if (__builtin_expect(__any(rm > ATT_THRL), 0)) { const float dl = __builtin_fmaxf(rm, 0.f); mhat += dl; \
        const float f = __builtin_amdgcn_exp2f(-dl); l_reg *= f; if (hi == 0) wsf[r32] = f; resc = true; } } \
    MIX_SBAR(); \
    GAPB(o[0] = MIX_MFMA(PAF(0), VFR(0), o[0]), C0, 0);  VRD(0, 4);  MIX_SBAR(); \
    GAPB(o[0] = MIX_MFMA(PAF(1), VFR(1), o[0]), C0, 2);  VRD(1, 5);  MIX_SBAR(); \
    GAPB(o[0] = MIX_MFMA(PAF(2), VFR(2), o[0]), C0, 4);  VRD(2, 6);  MIX_SBAR(); \
    GAPB(o[0] = MIX_MFMA(PAF(3), VFR(3), o[0]), C0, 6);  VRD(3, 7);  MIX_SBAR(); \
    GAPB(o[1] = MIX_MFMA(PAF(0), VFR(0), o[1]), C0, 8);  VRD(0, 8);  MIX_SBAR(); \
    GAPB(o[1] = MIX_MFMA(PAF(1), VFR(1), o[1]), C0, 10); VRD(1, 9);  MIX_SBAR(); \
    GAPB(o[1] = MIX_MFMA(PAF(2), VFR(2), o[1]), C0, 12); VRD(2, 10); MIX_SBAR(); \
    GAPB(o[1] = MIX_MFMA(PAF(3), VFR(3), o[1]), C0, 14); VRD(3, 11); MIX_SBAR(); \
    GAPB(o[2] = MIX_MFMA(PAF(0), VFR(0), o[2]), C1, 0);  VRD(0, 12); MIX_SBAR(); \
    GAPB(o[2] = MIX_MFMA(PAF(1), VFR(1), o[2]), C1, 2);  VRD(1, 13); MIX_SBAR(); \
    GAPB(o[2] = MIX_MFMA(PAF(2), VFR(2), o[2]), C1, 4);  VRD(2, 14); MIX_SBAR(); \
    GAPB(o[2] = MIX_MFMA(PAF(3), VFR(3), o[2]), C1, 6);  VRD(3, 15); MIX_SBAR(); \
    GAPB(o[3] = MIX_MFMA(PAF(0), VFR(0), o[3]), C1, 8);  if (GL) { KRD1(sl_next, 0, kq0); } MIX_SBAR(); \
    GAPB(o[3] = MIX_MFMA(PAF(1), VFR(1), o[3]), C1, 10); if (GL) { KRD1(sl_next, 1, kq1); } MIX_SBAR(); \
    GAPB(o[3] = MIX_MFMA(PAF(2), VFR(2), o[3]), C1, 12); if (GL) { KRD1(sl_next, 2, kq2); } MIX_SBAR(); \
    GAPB(o[3] = MIX_MFMA(PAF(3), VFR(3), o[3]), C1, 14); if (GL) { KRD1(sl_next, 3, kq3); } MIX_SBAR(); \
    } while (0)
#define ENDW(tt) do { if ((tt) + 3 < NT) { WAIT_BAR(4); } else if ((tt) + 2 < NT) { WAIT_BAR(2); } else { WAIT_BAR(0); } } while (0)
    int t = 1;
    for (; t + 5 < NT; t += 2) {
        STEP(pB0, pB1, pA0, pA1, t, true, true, true, false);     WAIT_BAR(4); RESC(); ROT();
        STEP(pA0, pA1, pB0, pB1, t + 1, true, true, true, false); WAIT_BAR(4); RESC(); ROT();
    }
    for (; t + 1 < NT; t += 2) {
        STEP(pB0, pB1, pA0, pA1, t, (t + 3 < NT), (t + 1 < NT), (t + 1 < NT), false);       ENDW(t);     RESC(); ROT();
        STEP(pA0, pA1, pB0, pB1, t + 1, (t + 4 < NT), (t + 2 < NT), (t + 2 < NT), false);   ENDW(t + 1); RESC(); ROT();
    }
    STEP(pB0, pB1, pA0, pA1, NT - 1, false, false, false, true); RESC();
    { float sacc = 0.f;
#pragma unroll
      for (int r = 0; r < 16; ++r) sacc += pB0[r] + pB1[r];
      l_reg += sacc;
      pw0 = (u32x4){PKW(pB0, 0), PKW(pB0, 2), PKW(pB0, 4), PKW(pB0, 6)}; pw1 = (u32x4){PKW(pB0, 8), PKW(pB0, 10), PKW(pB0, 12), PKW(pB0, 14)};
      pw2 = (u32x4){PKW(pB1, 0), PKW(pB1, 2), PKW(pB1, 4), PKW(pB1, 6)}; pw3 = (u32x4){PKW(pB1, 8), PKW(pB1, 10), PKW(pB1, 12), PKW(pB1, 14)};
      const lds_cptr vp_ = vp0 + sl_cur;
#pragma unroll
      for (int d0 = 0; d0 < 4; ++d0) {
          VRD(0, 4 * d0); VRD(1, 4 * d0 + 1); VRD(2, 4 * d0 + 2); VRD(3, 4 * d0 + 3);
          o[d0] = MIX_MFMA(PAF(0), VFR(0), o[d0]); o[d0] = MIX_MFMA(PAF(1), VFR(1), o[d0]); o[d0] = MIX_MFMA(PAF(2), VFR(2), o[d0]); o[d0] = MIX_MFMA(PAF(3), VFR(3), o[d0]); } }
#undef DMA_K
#undef DMA_V
#undef ROT
#undef WAIT_BAR
#undef KRD1
#undef RESC
#undef PKW
#undef PAF
#undef VFR
#undef VRD
#undef GAPA
#undef GAPB
#undef EX
#undef STEP
#undef ENDW
    asm volatile("s_waitcnt vmcnt(0) lgkmcnt(0)\n\ts_barrier" ::: "memory");
    { auto rr = __builtin_amdgcn_permlane32_swap(__float_as_uint(l_reg), __float_as_uint(l_reg), false, false); l_reg = __uint_as_float(rr[0]) + __uint_as_float(rr[1]); }
    if (hi == 0) wsf[32 + r32] = l_reg;
    asm volatile("s_waitcnt lgkmcnt(0)" ::: "memory");
    LAS float* stg = (LAS float*)lds;
#pragma unroll
    for (int r = 0; r < 16; ++r) { const int row = 32 * g + crow(r, hi); const float rl = __builtin_amdgcn_rcpf(wsf[32 + crow(r, hi)]);
#pragma unroll
        for (int d0 = 0; d0 < 4; ++d0) { const int e = 32 * d0 + r32; stg[((c * 128 + row) * 32 + ((e >> 2) ^ (row & 7))) * 4 + (e & 3)] = o[d0][r] * rl; } }
    asm volatile("s_waitcnt lgkmcnt(0)\n\ts_barrier" ::: "memory");
    {
        const int row = tid >> 2, qd = tid & 3;
        f32x4 a[8]; float ss = 0.f;
#pragma unroll
        for (int i = 0; i < 8; ++i) { const int ph = (row * 32 + ((8 * qd + i) ^ (row & 7))) * 4;
            const f32x4 v0 = *(const LAS f32x4*)(stg + ph), v1 = *(const LAS f32x4*)(stg + 128 * 128 + ph);
            a[i] = v0 - v1 * lam; ss += (a[i][0] * a[i][0] + a[i][1] * a[i][1]) + (a[i][2] * a[i][2] + a[i][3] * a[i][3]); }
        ss += __shfl_xor(ss, 1); ss += __shfl_xor(ss, 2);
        const float rs = 0.8f / sqrtf(ss * (1.0f / 128.0f) + 1e-5f);
        bf16* op = MIXO + (rowbase + q0 + row) * MIXP + h * 128 + 32 * qd;
        const float* gp = subg + 32 * qd;
#pragma unroll
        for (int i = 0; i < 8; i += 2) { const f32x4 g0 = *(const f32x4*)(gp + 4 * i), g1 = *(const f32x4*)(gp + 4 * i + 4);
            const f32x4 x0 = a[i] * g0 * rs, x1 = a[i + 1] * g1 * rs;
            u32x4 w; w.x = cvtpk(x0[0], x0[1]); w.y = cvtpk(x0[2], x0[3]); w.z = cvtpk(x1[0], x1[1]); w.w = cvtpk(x1[2], x1[3]);
            *(u32x4*)(op + 4 * i) = w; }
    }
    asm volatile("s_waitcnt lgkmcnt(0)\n\ts_barrier" ::: "memory");
}

constexpr int G_WM = 0, G_WMP = 136, G_VN = 36864;
__device__ __forceinline__ void gmlp_load_wm(const float* ws_g, LAS unsigned char* lds) {
    const int tid = fresh_tid(), t = tid >> 2, s0 = (tid & 3) * 32;
#pragma unroll
    for (int i = 0; i < 4; ++i) { const f32x4 a = *(const f32x4*)(ws_g + t * 128 + s0 + 8 * i), b = *(const f32x4*)(ws_g + t * 128 + s0 + 8 * i + 4);
        const bool keep = (t >> 6) >= ((s0 + 8 * i) >> 6);
        u32x4 w; w.x = cvtpk(a[0], a[1]); w.y = cvtpk(a[2], a[3]); w.z = cvtpk(b[0], b[1]); w.w = cvtpk(b[2], b[3]);
        if (!keep) w = (u32x4){0u, 0u, 0u, 0u};
        *(LAS u32x4*)(lds + G_WM + (t * G_WMP + s0 + 8 * i) * 2) = w; }
}
__device__ __forceinline__ void gmlp_items(int g, int idx0, const bf16* P, bf16* MIXO, LAS unsigned char* lds, const float* lng, const float* lnb, const float* bsg) {
    const int tid = fresh_tid(), lane = tid & 63, r32 = lane & 31, hi = lane >> 5; const int wid = __builtin_amdgcn_readfirstlane(tid >> 6);
    const int s = tid >> 2, qd = tid & 3;
    const int tm = wid >> 1;
    const lds_cptr ap = (lds_cptr)lds + G_WM + ((32 * tm + r32) * G_WMP + 8 * hi) * 2;
    const lds_cptr vb = (lds_cptr)lds + G_VN + (8 * hi + ((lane & 15) >> 2)) * 64 + ((lane >> 4) & 1) * 32 + (lane & 3) * 8;
    const float* gg = lng + g * 128 + qd * 32; const float* gb = lnb + g * 128 + qd * 32;
    u32x4 raw[4];
#define GM_ROWBASE(i_) ((long)(((idx0) + (i_)) >> 5) * SEQ + (((idx0) + (i_)) & 31) * 128)
#define GM_LOADVG(i_) do { const bf16* vp_ = P + (GM_ROWBASE(i_) + s) * PITCH + COL_G + g * 128 + qd * 32; _Pragma("unroll") for (int k_ = 0; k_ < 4; ++k_) raw[k_] = *(const u32x4*)(vp_ + 8 * k_); } while (0)
    GM_LOADVG(0);
    for (int it = 0; it < 4; ++it) {
        const long rowbase = GM_ROWBASE(it);
        {
            float v[32]; float sum = 0.f;
#pragma unroll
            for (int i = 0; i < 4; ++i)
#pragma unroll
                for (int j = 0; j < 4; ++j) { v[8 * i + 2 * j] = __uint_as_float(raw[i][j] << 16); v[8 * i + 2 * j + 1] = __uint_as_float(raw[i][j] & 0xffff0000u); }
#pragma unroll
            for (int i = 0; i < 32; ++i) sum += v[i];
            sum += __shfl_xor(sum, 1); sum += __shfl_xor(sum, 2);
            const float mean = sum * (1.0f / 128.0f); float sq = 0.f;
#pragma unroll
            for (int i = 0; i < 32; ++i) { v[i] -= mean; sq += v[i] * v[i]; }
            sq += __shfl_xor(sq, 1); sq += __shfl_xor(sq, 2);
            const float rstd = 1.0f / sqrtf(sq * (1.0f / 128.0f) + 1e-5f);
            LAS unsigned char* dst = lds + G_VN + ((qd * 8 + (s >> 4)) * 16 + (s & 15)) * 64;
#pragma unroll
            for (int i = 0; i < 4; ++i) { float y[8];
#pragma unroll
                for (int j = 0; j < 8; ++j) y[j] = v[8 * i + j] * rstd * gg[8 * i + j] + gb[8 * i + j];
                u32x4 w; w.x = cvtpk(y[0], y[1]); w.y = cvtpk(y[2], y[3]); w.z = cvtpk(y[4], y[5]); w.w = cvtpk(y[6], y[7]);
                *(LAS u32x4*)(dst + 16 * i) = w; }
        }
        if (it + 1 < 4) GM_LOADVG(it + 1);
        unsigned short uu[2][16];
#pragma unroll
        for (int dd = 0; dd < 2; ++dd)
#pragma unroll
            for (int r = 0; r < 16; ++r) uu[dd][r] = P[(rowbase + 32 * tm + crow(r, hi)) * PITCH + COL_U + g * 128 + 32 * ((wid & 1) * 2 + dd) + r32];
        asm volatile("s_waitcnt lgkmcnt(0)" ::: "memory"); __builtin_amdgcn_s_barrier(); asm volatile("" ::: "memory");
#pragma unroll
        for (int dd = 0; dd < 2; ++dd) { const int dn = (wid & 1) * 2 + dd;
            f32x16 acc = f32x16{};
#pragma unroll
            for (int ks = 0; ks < 8; ++ks) {
                const bf16x8 af = *(const LAS bf16x8*)(ap + ks * 32);
                const s16x4 lo = vtr(vb + (dn * 8 + ks) * 1024), hh = vtr(vb + (dn * 8 + ks) * 1024 + 256);
                const bf16x8 vf = (bf16x8){lo[0], lo[1], lo[2], lo[3], hh[0], hh[1], hh[2], hh[3]};
                acc = MIX_MFMA(af, vf, acc); }
            const int d = 32 * dn + r32;
#pragma unroll
            for (int r = 0; r < 16; ++r) { const int t = 32 * tm + crow(r, hi);
                const float val = bf2f(uu[dd][r]) * (acc[r] + bsg[g * 128 + t]);
                MIXO[(rowbase + t) * MIXP + 1024 + g * 128 + d] = (bf16)(cvtpk(val, val) & 0xffffu); }
        }
        asm volatile("s_waitcnt lgkmcnt(0)" ::: "memory"); __builtin_amdgcn_s_barrier(); asm volatile("" ::: "memory");
    }
#undef GM_ROWBASE
#undef GM_LOADVG
}
}

constexpr int NWAVES = 8;
constexpr int BATCH = 4, SEQ = 4096, D = 2048, M = BATCH * SEQ, INW = 5120, FF = 8192, NMOD = 6;
constexpr float LN_EPS = 1e-5f;
constexpr float DN_ALPHA = 1.189207115002721f;
constexpr size_t MiB = 1u << 20;
constexpr size_t WS_CTL = 0, CTL_ZERO_BYTES = 64 * 1024;
constexpr size_t WS_MOD = 1 * MiB;
constexpr size_t WS_WIN = 2 * MiB, WS_WOUT = 22 * MiB, WS_W1 = 30 * MiB, WS_W2 = 62 * MiB;
constexpr size_t WS_XN = 94 * MiB;
constexpr size_t WS_PROJ = 158 * MiB;
constexpr size_t WS_MIX = 318 * MiB;
constexpr size_t WS_HID = 158 * MiB;
constexpr size_t WS_END = 414 * MiB;
static_assert(WS_WIN + (size_t)INW * D * 2 <= WS_WOUT && WS_WOUT + (size_t)D * D * 2 <= WS_W1 && WS_W1 + (size_t)FF * D * 2 <= WS_W2 && WS_W2 + (size_t)D * FF * 2 <= WS_XN &&
              WS_XN + (size_t)M * D * 2 <= WS_PROJ && WS_PROJ + (size_t)M * INW * 2 <= WS_MIX && WS_MIX + (size_t)M * D * 2 <= WS_END && WS_HID + (size_t)M * FF * 2 <= WS_END, "d_ws map");
constexpr int CW_BAR = 4096;
constexpr int RING_OFF = 0, RING_BYTES = 131072;
constexpr int LDSCTL_OFF = RING_BYTES, MISC_OFF = LDSCTL_OFF + 320;
constexpr int WSF_OFF = RING_BYTES + 1024;
constexpr int LDS_BYTES = 147456;
static_assert(MISC_OFF + 128 <= WSF_OFF && WSF_OFF + 2048 <= LDS_BYTES, "LDS map");

typedef unsigned short bf16;
typedef unsigned v4u __attribute__((ext_vector_type(4)));
typedef float f32x4 __attribute__((ext_vector_type(4)));
typedef GAS unsigned gu32;
#define RLX_AGENT __ATOMIC_RELAXED, __HIP_MEMORY_SCOPE_AGENT
#define LDS_WAIT() asm volatile("s_waitcnt lgkmcnt(0)" ::: "memory")
#define VM_WAIT() asm volatile("s_waitcnt vmcnt(0)" ::: "memory")
__device__ __forceinline__ unsigned pk2(float lo, float hi) { return pg8::cvt_pk_bf16(lo, hi); }

#define XB_TMO      128
#define XB_XCNT(j)  (256  + 64 * (j))
#define XB_XSUB(j)  (1280 + 64 * (j))
#define XB_XGEN(j)  (2304 + 64 * (j))
#define XB_TOP      3328
#define XB_TOPGEN   3392
#define XCD_BAR_WORDS 3456
#define XB_SPIN_CAP (1u << 18)

__device__ __forceinline__ unsigned xb_ld(unsigned* p)              { return __hip_atomic_load(p, __ATOMIC_RELAXED, __HIP_MEMORY_SCOPE_AGENT); }
__device__ __forceinline__ unsigned xb_add(unsigned* p, unsigned v) { return __hip_atomic_fetch_add(p, v, __ATOMIC_RELAXED, __HIP_MEMORY_SCOPE_AGENT); }
__device__ __forceinline__ unsigned xb_xcc_id() { return (unsigned)__builtin_amdgcn_s_getreg((3 << 11) | 20) & 0xFu; }
#define XB_SPIN(cond, bar) do { unsigned _sp = 0; while (cond) { __builtin_amdgcn_s_sleep(1); \
    if ((++_sp & 255u) == 0u) { if (xb_ld(&(bar)[XB_TMO])) break; if (_sp > XB_SPIN_CAP) { atomicAdd(&(bar)[XB_TMO], 1u); break; } } } } while (0)

struct XcdBarrier {
    unsigned* bar; unsigned x;
    volatile LAS unsigned* st;
};

__device__ __forceinline__ XcdBarrier xcd_barrier_post(unsigned* bar, volatile LAS unsigned* st) {
    XcdBarrier b; b.bar = bar; b.x = xb_xcc_id(); b.st = st;
    if (threadIdx.x == 0) (void)xb_add(&bar[XB_XCNT(b.x)], 1u);
    return b;
}
__device__ __forceinline__ void xcd_barrier_complete(unsigned* bar, unsigned x, unsigned& nloc, unsigned& nx) {
    const unsigned G = gridDim.x * gridDim.y * gridDim.z;
    unsigned sum, cnt, mine, sp = 0u;
    for (;;) {
        sum = 0u; cnt = 0u; mine = 0u;
#pragma unroll
        for (unsigned j = 0; j < 16; ++j) { const unsigned c = xb_ld(&bar[XB_XCNT(j)]); sum += c; cnt += (c > 0u) ? 1u : 0u; mine = (j == x) ? c : mine; }
        if (sum == G) break;
        __builtin_amdgcn_s_sleep(1);
        if ((++sp & 255u) == 0u) { if (xb_ld(&bar[XB_TMO])) break; if (sp > XB_SPIN_CAP) { atomicAdd(&bar[XB_TMO], 1u); break; } }
    }
    nloc = mine > 0u ? mine : 1u; nx = cnt > 0u ? cnt : 1u;
}

__device__ __forceinline__ void xcd_barrier(const XcdBarrier& b) {
    asm volatile("s_waitcnt vmcnt(0)" ::: "memory");
    __syncthreads();
    if (threadIdx.x == 0) {
        unsigned* bar = b.bar;
        __builtin_amdgcn_s_waitcnt(0);
        unsigned nloc = b.st[0], nx = b.st[1];
        if (nloc == 0u) { xcd_barrier_complete(bar, b.x, nloc, nx); b.st[0] = nloc; b.st[1] = nx; }
        const unsigned old = xb_add(&bar[XB_XSUB(b.x)], 1u);
        const unsigned gen = old / nloc;
        if (old + 1u == (gen + 1u) * nloc) {
            __builtin_amdgcn_fence(__ATOMIC_RELEASE, "agent");
            asm volatile("s_waitcnt vmcnt(0)" ::: "memory");
            const unsigned og = xb_add(&bar[XB_TOP], 1u);
            const unsigned tg = og / nx;
            if (og + 1u == (tg + 1u) * nx) xb_add(&bar[XB_TOPGEN], 1u);
            else XB_SPIN(xb_ld(&bar[XB_TOPGEN]) == tg, bar);
            __builtin_amdgcn_fence(__ATOMIC_ACQUIRE, "agent");
            xb_add(&bar[XB_XGEN(b.x)], 1u);
            asm volatile("s_waitcnt vmcnt(0)" ::: "memory");
        } else {
            XB_SPIN(xb_ld(&bar[XB_XGEN(b.x)]) == gen, bar);
            __builtin_amdgcn_fence(__ATOMIC_ACQUIRE, "agent");
            asm volatile("s_waitcnt vmcnt(0)" ::: "memory");
        }
    }
    __syncthreads();
}

struct Frame {
    LAS unsigned char* lds;
    volatile LAS unsigned* MISC;
    gu32* ctl;
    int tid, lane, wave;
    int vcu, G;
    __device__ __forceinline__ void refresh() { tid = fresh_tid(); lane = tid & 63; wave = __builtin_amdgcn_readfirstlane(tid >> 6); }
};
__device__ __forceinline__ float wave_sum(float v) {
#pragma unroll
    for (int o = 1; o < 64; o <<= 1) v += __shfl_xor(v, o);
    return v;
}
__device__ __forceinline__ void p0_transpose_item(const float* W, int K, int N, bf16* WT, LAS float* scr, int item, int lane) {
    const int nblk = N / 32, kb = item / nblk, nb = item % nblk, k0 = 64 * kb, n0 = 32 * nb;
#pragma unroll 8
    for (int i = 0; i < 32; ++i) { const int kk = 2 * i + (lane >> 5); scr[kk * 33 + (lane & 31)] = W[(size_t)(k0 + kk) * N + n0 + (lane & 31)]; }
    LDS_WAIT(); asm volatile("" ::: "memory");
    const int c = lane & 7;
#pragma unroll
    for (int j = 0; j < 4; ++j) { const int n = (lane >> 3) + 8 * j; const LAS float* s = scr + (8 * c) * 33 + n;
        v4u o; o.x = pk2(s[0 * 33], s[1 * 33]); o.y = pk2(s[2 * 33], s[3 * 33]); o.z = pk2(s[4 * 33], s[5 * 33]); o.w = pk2(s[6 * 33], s[7 * 33]);
        *(GAS v4u*)(WT + (size_t)(n0 + n) * K + k0 + 8 * c) = o; }
    LDS_WAIT(); asm volatile("" ::: "memory");
}
__device__ __forceinline__ void p0_mod(Frame& F, const float* cvec, const float* w_ada, const float* b_ada, float* mod) {
    LAS float* sc = (LAS float*)(F.lds + RING_OFF);
    LAS float* red = (LAS float*)(F.lds + RING_OFF + 32768);
    for (int i = F.tid; i < BATCH * D; i += NWAVES * 64) { const float v = cvec[i]; sc[i] = v / (1.0f + __expf(-v)); }
    LDS_WAIT(); __syncthreads();
    const int col = blockIdx.x * 64 + F.lane, kbase = F.wave * 256;
    const float* wp = w_ada + (size_t)kbase * (NMOD * D) + col;
    float a0 = 0.f, a1 = 0.f, a2 = 0.f, a3 = 0.f;
#pragma unroll 16
    for (int k = 0; k < 256; ++k) { const float w = wp[(size_t)k * (NMOD * D)];
        a0 += sc[kbase + k] * w; a1 += sc[D + kbase + k] * w; a2 += sc[2 * D + kbase + k] * w; a3 += sc[3 * D + kbase + k] * w; }
    red[(F.wave * 4 + 0) * 64 + F.lane] = a0; red[(F.wave * 4 + 1) * 64 + F.lane] = a1; red[(F.wave * 4 + 2) * 64 + F.lane] = a2; red[(F.wave * 4 + 3) * 64 + F.lane] = a3;
    LDS_WAIT(); __syncthreads();
    if (F.tid < 256) { const int b = F.tid >> 6, l = F.tid & 63; float s = 0.f;
#pragma unroll
        for (int w = 0; w < 8; ++w) s += red[(w * 4 + b) * 64 + l];
        mod[(size_t)b * (NMOD * D) + blockIdx.x * 64 + l] = s + b_ada[blockIdx.x * 64 + l]; }
    LDS_WAIT(); __syncthreads();
}
struct RowStats { float mean, rstd; };
__device__ __forceinline__ RowStats row_stats(f32x4 (&v)[8]) {
    float s = 0.f;
#pragma unroll
    for (int j = 0; j < 8; ++j) s += (v[j].x + v[j].y) + (v[j].z + v[j].w);
    const float mean = wave_sum(s) * (1.f / D); float s2 = 0.f;
#pragma unroll
    for (int j = 0; j < 8; ++j) { const f32x4 d = v[j] - mean; s2 += (d.x * d.x + d.y * d.y) + (d.z * d.z + d.w * d.w); }
    RowStats r; r.mean = mean; r.rstd = 1.f / sqrtf(wave_sum(s2) * (1.f / D) + LN_EPS); return r;
}
__device__ __forceinline__ void ld_f32row(f32x4 (&v)[8], const float* p, int lane) { const GAS f32x4* r = (const GAS f32x4*)p + lane;
#pragma unroll
    for (int j = 0; j < 8; ++j) v[j] = r[64 * j]; }
__device__ __forceinline__ void ld_bf16row(unsigned long long (&q)[8], const bf16* p, int lane) { const GAS unsigned long long* r = (const GAS unsigned long long*)p + lane;
#pragma unroll
    for (int j = 0; j < 8; ++j) q[j] = r[64 * j]; }
__device__ __forceinline__ void st_bf16row(bf16* p, int lane, const f32x4 (&y)[8]) { GAS unsigned long long* o8 = (GAS unsigned long long*)p + lane;
#pragma unroll
    for (int j = 0; j < 8; ++j) o8[64 * j] = (unsigned long long)pk2(y[j].x, y[j].y) | ((unsigned long long)pk2(y[j].z, y[j].w) << 32); }
__device__ __forceinline__ void add_bf16x4(f32x4& v, unsigned long long w, float alpha) {
    const unsigned lo = (unsigned)w, hi = (unsigned)(w >> 32);
    v.x = v.x * alpha + __uint_as_float(lo << 16); v.y = v.y * alpha + __uint_as_float(lo & 0xffff0000u);
    v.z = v.z * alpha + __uint_as_float(hi << 16); v.w = v.w * alpha + __uint_as_float(hi & 0xffff0000u);
}
__device__ __forceinline__ void p1_row(int m, int lane, f32x4 (&v)[8], const float* mod, bf16* XN) {
    const float* mb = mod + (size_t)(m >> 12) * (NMOD * D);
    const RowStats st = row_stats(v);
#pragma unroll
    for (int j = 0; j < 8; ++j) { const f32x4 sh = *((const f32x4*)(mb + 0 * D) + lane + 64 * j), sc = *((const f32x4*)(mb + 1 * D) + lane + 64 * j);
        v[j] = (v[j] - st.mean) * st.rstd * (sc + 1.0f) + sh; }
    st_bf16row(XN + (size_t)m * D, lane, v);
}
__device__ __forceinline__ void p1_xn(Frame& F, const float* x, const float* mod, bf16* XN) {
    const int gw = F.vcu * NWAVES + F.wave, NGW = F.G * NWAVES, lane = F.lane;
    f32x4 vA[8], vB[8];
    int m = gw;
    if (m < M) ld_f32row(vA, x + (size_t)m * D, lane);
    if (m + NGW < M) ld_f32row(vB, x + (size_t)(m + NGW) * D, lane);
    for (; m < M; m += 2 * NGW) {
        p1_row(m, lane, vA, mod, XN);
        if (m + 2 * NGW < M) ld_f32row(vA, x + (size_t)(m + 2 * NGW) * D, lane);
        if (m + NGW < M) { p1_row(m + NGW, lane, vB, mod, XN);
            if (m + 3 * NGW < M) ld_f32row(vB, x + (size_t)(m + 3 * NGW) * D, lane); }
    }
}
__device__ __forceinline__ void p5_row(int m, int lane, f32x4 (&v)[8], const unsigned long long (&gq)[8], bf16* H, const float* lg, const float* lb, const float* mod, bf16* XN) {
    const float* mb = mod + (size_t)(m >> 12) * (NMOD * D);
#pragma unroll
    for (int j = 0; j < 8; ++j) add_bf16x4(v[j], gq[j], DN_ALPHA);
    const RowStats st = row_stats(v);
#pragma unroll
    for (int j = 0; j < 8; ++j) { const f32x4 g = *((const f32x4*)lg + lane + 64 * j), b = *((const f32x4*)lb + lane + 64 * j);
        v[j] = (v[j] - st.mean) * st.rstd * g + b; }
    st_bf16row(H + (size_t)m * D, lane, v);
    const RowStats s2 = row_stats(v);
#pragma unroll
    for (int j = 0; j < 8; ++j) { const f32x4 sh = *((const f32x4*)(mb + 3 * D) + lane + 64 * j), sc = *((const f32x4*)(mb + 4 * D) + lane + 64 * j);
        v[j] = (v[j] - s2.mean) * s2.rstd * (sc + 1.0f) + sh; }
    st_bf16row(XN + (size_t)m * D, lane, v);
}
__device__ __forceinline__ void p5_ln(Frame& F, const float* X, const bf16* G, bf16* H, const float* lg, const float* lb, const float* mod, bf16* XN) {
    const int gw = F.vcu * NWAVES + F.wave, NGW = F.G * NWAVES, lane = F.lane;
    f32x4 vA[8], vB[8]; unsigned long long gA[8], gB[8];
    int m = gw;
    if (m < M) { ld_f32row(vA, X + (size_t)m * D, lane); ld_bf16row(gA, G + (size_t)m * D, lane); }
    if (m + NGW < M) { ld_f32row(vB, X + (size_t)(m + NGW) * D, lane); ld_bf16row(gB, G + (size_t)(m + NGW) * D, lane); }
    for (; m < M; m += 2 * NGW) {
        p5_row(m, lane, vA, gA, H, lg, lb, mod, XN);
        if (m + 2 * NGW < M) { ld_f32row(vA, X + (size_t)(m + 2 * NGW) * D, lane); ld_bf16row(gA, G + (size_t)(m + 2 * NGW) * D, lane); }
        if (m + NGW < M) { p5_row(m + NGW, lane, vB, gB, H, lg, lb, mod, XN);
            if (m + 3 * NGW < M) { ld_f32row(vB, X + (size_t)(m + 3 * NGW) * D, lane); ld_bf16row(gB, G + (size_t)(m + 3 * NGW) * D, lane); } }
    }
}
__device__ __forceinline__ void p8_row(int m, int lane, const unsigned long long (&hq)[8], const unsigned long long (&gq)[8], float* OUT, const float* lg, const float* lb) {
    f32x4 v[8];
#pragma unroll
    for (int j = 0; j < 8; ++j) { v[j] = (f32x4){0.f, 0.f, 0.f, 0.f}; add_bf16x4(v[j], hq[j], 1.0f); add_bf16x4(v[j], gq[j], DN_ALPHA); }
    const RowStats st = row_stats(v);
    GAS f32x4* yr = (GAS f32x4*)(OUT + (size_t)m * D) + lane;
#pragma unroll
    for (int j = 0; j < 8; ++j) { const f32x4 g = *((const f32x4*)lg + lane + 64 * j), b = *((const f32x4*)lb + lane + 64 * j);
        yr[64 * j] = (v[j] - st.mean) * st.rstd * g + b; }
}
__device__ __forceinline__ void p8_ln(Frame& F, const bf16* H, const bf16* G, float* OUT, const float* lg, const float* lb) {
    const int gw = F.vcu * NWAVES + F.wave, NGW = F.G * NWAVES, lane = F.lane;
    unsigned long long hA[8], hB[8], gA[8], gB[8];
    int m = gw;
    if (m < M) { ld_bf16row(hA, H + (size_t)m * D, lane); ld_bf16row(gA, G + (size_t)m * D, lane); }
    if (m + NGW < M) { ld_bf16row(hB, H + (size_t)(m + NGW) * D, lane); ld_bf16row(gB, G + (size_t)(m + NGW) * D, lane); }
    for (; m < M; m += 2 * NGW) {
        p8_row(m, lane, hA, gA, OUT, lg, lb);
        if (m + 2 * NGW < M) { ld_bf16row(hA, H + (size_t)(m + 2 * NGW) * D, lane); ld_bf16row(gA, G + (size_t)(m + 2 * NGW) * D, lane); }
        if (m + NGW < M) { p8_row(m + NGW, lane, hB, gB, OUT, lg, lb);
            if (m + 3 * NGW < M) { ld_bf16row(hB, H + (size_t)(m + 3 * NGW) * D, lane); ld_bf16row(gB, G + (size_t)(m + 3 * NGW) * D, lane); } }
    }
}

#define REP_P0 1
#define REP_P1 1
#define REP_P2 1
#define REP_P3A 1
#define REP_P3G 1
#define REP_P4 1
#define REP_P6 1
#define REP_P5 1
#define REP_P7 1
#define REP_P8 1
constexpr size_t WS_SCRATCH = 414 * MiB;
struct Args { const float* in[21]; float* out; unsigned char* ws; };
__global__ void __launch_bounds__(NWAVES * 64, 2) fwd_megakernel(Args args) {
    extern __shared__ __attribute__((aligned(16))) unsigned char lds[];
    Frame F;
    F.lds = (LAS unsigned char*)lds;
    F.MISC = (volatile LAS unsigned*)(F.lds + MISC_OFF);
    F.refresh();
    F.G = gridDim.x; { const int bx = blockIdx.x; F.vcu = (F.G % 8 == 0) ? (bx % 8) * (F.G / 8) + bx / 8 : bx; }
    unsigned char* ws = args.ws;
    F.ctl = (gu32*)(ws + WS_CTL);
    const float* x = args.in[0]; const float* cvec = args.in[1]; const float* w_ada = args.in[2]; const float* b_ada = args.in[3]; const float* w_in = args.in[4];
    const float* lq1 = args.in[5]; const float* lk1 = args.in[6]; const float* lq2 = args.in[7]; const float* lk2 = args.in[8]; const float* subg = args.in[9];
    const float* gln_g = args.in[10]; const float* gln_b = args.in[11]; const float* g_ws = args.in[12]; const float* g_bs = args.in[13]; const float* w_out = args.in[14];
    const float* ln1_g = args.in[15]; const float* ln1_b = args.in[16]; const float* w_ff1 = args.in[17]; const float* w_ff2 = args.in[18]; const float* ln2_g = args.in[19]; const float* ln2_b = args.in[20];
    float* out = args.out;
    float* MOD = (float*)(ws + WS_MOD);
    bf16* Win_t = (bf16*)(ws + WS_WIN); bf16* Wout_t = (bf16*)(ws + WS_WOUT); bf16* W1_t = (bf16*)(ws + WS_W1); bf16* W2_t = (bf16*)(ws + WS_W2);
    bf16* XN = (bf16*)(ws + WS_XN); bf16* PROJ = (bf16*)(ws + WS_PROJ); bf16* MIXB = (bf16*)(ws + WS_MIX); bf16* HID = (bf16*)(ws + WS_HID);
    bf16* H1B = (bf16*)(ws + WS_SCRATCH);
    bf16* GMIX = (bf16*)(ws + WS_PROJ);
    for (int u = F.tid; u < (LDS_BYTES - LDSCTL_OFF) / 4; u += NWAVES * 64) ((LAS unsigned*)(F.lds + LDSCTL_OFF))[u] = 0u;
    __syncthreads();
    XcdBarrier bar = xcd_barrier_post((unsigned*)(F.ctl + CW_BAR), F.MISC + 8);
#define GRID_BAR() xcd_barrier(bar)

    for (int rep = 0; rep < REP_P0; ++rep) {
        if (blockIdx.x < (NMOD * D) / 64) p0_mod(F, cvec, w_ada, b_ada, MOD);
        F.refresh();
        LAS float* scr = (LAS float*)(F.lds + RING_OFF + F.wave * 16384);
        const int gw = F.vcu * NWAVES + F.wave, NGW = F.G * NWAVES;
        constexpr int I_IN = (D / 64) * (INW / 32), I_O = (D / 64) * (D / 32), I_1 = (D / 64) * (FF / 32), I_2 = (FF / 64) * (D / 32);
        constexpr int NITEMS = I_IN + I_O + I_1 + I_2;
        constexpr int NMODWG = (NMOD * D) / 64, N1 = (256 - NMODWG) * NWAVES * 5;
        const bool free_wg = (int)blockIdx.x >= NMODWG;
        const int nm = ((int)blockIdx.x - NMODWG) * NWAVES + F.wave, NNM = ((int)F.G - NMODWG) * NWAVES;
        for (int pass = 0; pass < 2; ++pass) {
            if (pass == 0 && !free_wg) continue;
            const int it0 = pass == 0 ? nm : N1 + gw, it1 = pass == 0 ? N1 : NITEMS, step = pass == 0 ? NNM : NGW;
            for (int it = it0; it < it1; it += step) {
                int r = it;
                if (r < I_IN) { p0_transpose_item(w_in, D, INW, Win_t, scr, r, F.lane); continue; } r -= I_IN;
                if (r < I_O) { p0_transpose_item(w_out, D, D, Wout_t, scr, r, F.lane); continue; } r -= I_O;
                if (r < I_1) { p0_transpose_item(w_ff1, D, FF, W1_t, scr, r, F.lane); continue; } r -= I_1;
                p0_transpose_item(w_ff2, FF, D, W2_t, scr, r, F.lane);
            }
        }
        GRID_BAR();
    }
    for (int rep = 0; rep < REP_P1; ++rep) { F.refresh(); p1_xn(F, x, MOD, XN);
    GRID_BAR(); }
    for (int rep = 0; rep < REP_P2; ++rep) {
        pg8::Gemm g{XN, Win_t, M, INW, D}; pg8::StaticOrder S; S.init(M, INW, F.G, (int)blockIdx.x);
        pg8::EpiProj E{PROJ, INW};
        pg8::gemm_phase<pg8::EpiProj, pg8::StaticOrder, true, true>(F.lds + RING_OFF, g, S, E);
        GRID_BAR();
    }
    {
        F.refresh();
        float lam;
        { const float a = lq1[F.lane] * lk1[F.lane], b = lq2[F.lane] * lk2[F.lane];
          lam = __expf(wave_sum(a)) - __expf(wave_sum(b)) + 0.2f; }
        LAS float* wsf = (LAS float*)(F.lds + WSF_OFF);
        const int bh = F.vcu >> 3, s = F.vcu & 7;
        for (int rep = 0; rep < REP_P3A; ++rep)
        for (int i = 0; i < 4; ++i) { const int qb = (i == 0) ? s : (i == 1) ? 15 - s : (i == 2) ? 16 + s : 31 - s;
            mix::attn_unit(bh >> 3, bh & 7, qb, PROJ, MIXB, F.lds + RING_OFF, wsf, lam, subg); }
        const int gg = F.vcu >> 5;
        for (int rep = 0; rep < REP_P3G; ++rep) {
        mix::gmlp_load_wm(g_ws + (size_t)gg * 128 * 128, F.lds + RING_OFF);
        mix::gmlp_items(gg, (F.vcu & 31) * 4, PROJ, MIXB, F.lds + RING_OFF, gln_g, gln_b, g_bs); }
        GRID_BAR();
    }
    for (int rep = 0; rep < REP_P4; ++rep) {
        pg8::Gemm g{MIXB, Wout_t, M, D, D}; pg8::StaticOrder S; S.init(M, D, F.G, (int)blockIdx.x);
        pg8::EpiGate E{GMIX, D, MOD + 2 * D, NMOD * D};
        pg8::gemm_phase<pg8::EpiGate, pg8::StaticOrder, true, true>(F.lds + RING_OFF, g, S, E);
        GRID_BAR();
    }
    for (int rep = 0; rep < REP_P5; ++rep) { F.refresh(); p5_ln(F, x, GMIX, H1B, ln1_g, ln1_b, MOD, XN);
    GRID_BAR(); }
    for (int rep = 0; rep < REP_P6; ++rep) {
        pg8::Gemm g{XN, W1_t, M, FF, D}; pg8::StaticOrder S; S.init(M, FF, F.G, (int)blockIdx.x);
        pg8::EpiRelu2 E{HID, FF};
        pg8::gemm_phase<pg8::EpiRelu2, pg8::StaticOrder, true, true>(F.lds + RING_OFF, g, S, E);
        GRID_BAR();
    }
    for (int rep = 0; rep < REP_P7; ++rep)
    {
        pg8::Gemm g{HID, W2_t, M, D, FF}; pg8::StaticOrder S; S.init(M, D, F.G, (int)blockIdx.x);
        pg8::EpiGate E{XN, D, MOD + 5 * D, NMOD * D};
        pg8::gemm_phase<pg8::EpiGate, pg8::StaticOrder, true, true>(F.lds + RING_OFF, g, S, E);
        GRID_BAR();
    }
    for (int rep = 0; rep < REP_P8; ++rep) { F.refresh(); p8_ln(F, H1B, XN, out, ln2_g, ln2_b); if (rep + 1 < REP_P8) GRID_BAR(); }
#undef GRID_BAR
}

extern "C" void kernel_launch(void* const* d_in, const int* in_sizes, int n_in, void* d_out, int out_size, void* d_ws, size_t ws_size, hipStream_t stream) {
    static int grid = 0;
    if (grid == 0) {
        if (n_in != 21 || in_sizes[0] != M * D || out_size != M * D || ws_size < WS_END + 64 * MiB) { fprintf(stderr, "kernel_launch: built for 21 inputs, x and out of %d floats, >= %zu bytes of workspace; got n_in %d, in0 %d, out %d, ws %zu; nothing launched\n", M * D, (size_t)WS_END, n_in, n_in > 0 ? in_sizes[0] : -1, out_size, ws_size); grid = -1; return; }
        int dev = 0, cus = 0, per_cu = 0;
        if (hipGetDevice(&dev) != hipSuccess || hipDeviceGetAttribute(&cus, hipDeviceAttributeMultiprocessorCount, dev) != hipSuccess) { fprintf(stderr, "kernel_launch: hipGetDevice / hipDeviceGetAttribute failed\n"); grid = -1; return; }
        if (hipFuncSetAttribute((const void*)fwd_megakernel, hipFuncAttributeMaxDynamicSharedMemorySize, LDS_BYTES) != hipSuccess) { fprintf(stderr, "kernel_launch: hipFuncSetAttribute failed\n"); grid = -1; return; }
        if (hipOccupancyMaxActiveBlocksPerMultiprocessor(&per_cu, (const void*)fwd_megakernel, NWAVES * 64, LDS_BYTES) != hipSuccess || per_cu < 1)
            fprintf(stderr, "kernel_launch: note: the occupancy query reports %d workgroups per CU\n", per_cu);
        (void)hipGetLastError();
        grid = cus;
        if (grid != 256) fprintf(stderr, "kernel_launch: launching %d workgroups (built for 256 CUs)\n", grid);
    }
    if (grid < 0) return;
    if (hipMemsetAsync((char*)d_ws + WS_CTL, 0, CTL_ZERO_BYTES, stream) != hipSuccess) { fprintf(stderr, "kernel_launch: hipMemsetAsync of the control words failed\n"); return; }
    Args a{};
    for (int i = 0; i < 21; ++i) a.in[i] = (const float*)d_in[i];
    a.out = (float*)d_out; a.ws = (unsigned char*)d_ws;
    hipLaunchKernelGGL(fwd_megakernel, dim3(grid), dim3(NWAVES * 64), LDS_BYTES, stream, a);
    const hipError_t le = hipPeekAtLastError();
    if (le != hipSuccess) fprintf(stderr, "kernel_launch: launch failed: %s (grid %d x %d threads, %d B LDS)\n", hipGetErrorName(le), grid, NWAVES * 64, LDS_BYTES);
}
```
